# Optimizing an MI355X kernel written in HIP

```python
import math
import jax
import jax.numpy as jnp
from jax import lax
import numpy as np

D_MODEL = 1024
BATCH = 8
SEQ = 4096
DEPTH = 4

GRID_W = 64
CTX_LEN = 256
N_EVEN = (DEPTH + 1) // 2
N_ODD = DEPTH // 2
EPS = 1e-6
NEG_INF = -1e30

MLA_HEADS = D_MODEL // 128
MLA_NOPE = 64
MLA_ROPE = 32
MLA_V = 64
MLA_QK = MLA_NOPE + MLA_ROPE
MLA_Q_RANK = 256
MLA_KV_RANK = 128
MLA_WIDTH = MLA_HEADS * MLA_V
MLA_SCALE = 1.0 / math.sqrt(MLA_QK)
ROPE_BASE = 10000.0
Q_BLOCK = 128

S5_CH = 16
S5_GROUPS = D_MODEL // 32
S5_WIDTH = S5_GROUPS * S5_CH
S5_STATE = 64
S5_DT_MIN = 0.001
S5_DT_MAX = 0.1

EV_S1 = MLA_Q_RANK
EV_S2 = EV_S1 + MLA_KV_RANK
EV_S3 = EV_S2 + MLA_ROPE
EV_S4 = EV_S3 + MLA_WIDTH
EV_S5 = EV_S4 + S5_WIDTH
EVEN_IN = EV_S5 + S5_WIDTH

NA_HEADS = D_MODEL // 64
NA_DH = 64
NA_WIDTH = NA_HEADS * NA_DH
NA_KH = 8
NA_KW = 16
NA_SCALE = 1.0 / math.sqrt(NA_DH)
ODD_IN = 4 * NA_WIDTH

kernel_name = "hybrid_mla_s5_natten_ctxprefix"


def rmsnorm(x, g):
    xf = x.astype(jnp.float32)
    y = xf * lax.rsqrt(jnp.mean(xf * xf, axis=-1, keepdims=True) + EPS)
    return (y * g.astype(jnp.float32)).astype(x.dtype)


def softmax_f32(s):
    return jax.nn.softmax(s.astype(jnp.float32), axis=-1)


def axial_rope_tables(n_tok):
    t = jnp.arange(n_tok, dtype=jnp.int32)
    row = (t // GRID_W).astype(jnp.float32)
    col = (t % GRID_W).astype(jnp.float32)
    nf = MLA_ROPE // 4
    freqs = ROPE_BASE ** (-jnp.arange(nf, dtype=jnp.float32) / nf)
    ar = row[:, None] * freqs
    ac = col[:, None] * freqs
    cos = jnp.concatenate([jnp.cos(ar), jnp.cos(ar), jnp.cos(ac), jnp.cos(ac)], axis=-1)
    sin = jnp.concatenate([jnp.sin(ar), jnp.sin(ar), jnp.sin(ac), jnp.sin(ac)], axis=-1)
    return cos, sin


def apply_axial_rope(x, cos, sin):
    x4 = x.reshape(x.shape[:-1] + (2, 2, MLA_ROPE // 4))
    rot = jnp.stack([-x4[..., 1, :], x4[..., 0, :]], axis=-2).reshape(x.shape)
    return (x * cos + rot * sin).astype(x.dtype)


def mla_project(z, q_norm, kv_norm, w_uq, w_ukv):
    B, L, _ = z.shape
    q = (rmsnorm(z[..., :EV_S1], q_norm) @ w_uq).reshape(B, L, MLA_HEADS, MLA_QK)
    kv = (rmsnorm(z[..., EV_S1:EV_S2], kv_norm) @ w_ukv).reshape(B, L, MLA_HEADS, MLA_NOPE + MLA_V)
    k_rope = z[..., EV_S2:EV_S3]
    return q[..., :MLA_NOPE], q[..., MLA_NOPE:], kv[..., :MLA_NOPE], k_rope, kv[..., MLA_NOPE:]


def mla_scores(qn, qr, kn, kr):
    return (jnp.einsum('bqhd,bkhd->bhqk', qn, kn) + jnp.einsum('bqhr,bkr->bhqk', qr, kr)) * MLA_SCALE


def mla_latent_attention(qn, qr, kn_all, kr_all, v_all):
    B, L, H, _ = qn.shape
    nblk = L // Q_BLOCK
    qn_b = qn.reshape(B, nblk, Q_BLOCK, H, MLA_NOPE).transpose(1, 0, 2, 3, 4)
    qr_b = qr.reshape(B, nblk, Q_BLOCK, H, MLA_ROPE).transpose(1, 0, 2, 3, 4)

    def step(args):
        qn_i, qr_i = args
        p = softmax_f32(mla_scores(qn_i, qr_i, kn_all, kr_all)).astype(v_all.dtype)
        return jnp.einsum('bhqk,bkhd->bqhd', p, v_all)

    o = lax.map(step, (qn_b, qr_b))
    return o.transpose(1, 0, 2, 3, 4).reshape(B, L, MLA_WIDTH)


def s5_discretise(lam_re, lam_im, log_dt, b_re, b_im):
    dt = jnp.exp(log_dt)[:, None]
    lr = jnp.minimum(lam_re, -1e-4)
    li = lam_im
    mag = jnp.exp(lr * dt)
    lbr = mag * jnp.cos(li * dt)
    lbi = mag * jnp.sin(li * dt)
    den = lr * lr + li * li
    nr = lbr - 1.0
    k_re = (nr * lr + lbi * li) / den
    k_im = (lbi * lr - nr * li) / den
    bb_re = k_re[..., None] * b_re - k_im[..., None] * b_im
    bb_im = k_re[..., None] * b_im + k_im[..., None] * b_re
    return lbr, lbi, bb_re, bb_im


def _complex_affine_combine(e1, e2):
    a1r, a1i, b1r, b1i = e1
    a2r, a2i, b2r, b2i = e2
    return (a1r * a2r - a1i * a2i,
            a1r * a2i + a1i * a2r,
            a2r * b1r - a2i * b1i + b2r,
            a2r * b1i + a2i * b1r + b2i)


def s5_scan(u, lbr, lbi, bb_re, bb_im, h0):
    bu_re = jnp.einsum('blgh,gph->blgp', u, bb_re)
    bu_im = jnp.einsum('blgh,gph->blgp', u, bb_im)
    if h0 is not None:
        h0r, h0i = h0
        bu_re = bu_re.at[:, 0].add(lbr * h0r - lbi * h0i)
        bu_im = bu_im.at[:, 0].add(lbr * h0i + lbi * h0r)
    L = u.shape[1]
    a_re = jnp.broadcast_to(lbr[None, None], (1, L) + lbr.shape)
    a_im = jnp.broadcast_to(lbi[None, None], (1, L) + lbi.shape)
    _, _, x_re, x_im = lax.associative_scan(_complex_affine_combine, (a_re, a_im, bu_re, bu_im), axis=1)
    return x_re, x_im


def s5_readout(x_re, x_im, c_re, c_im):
    return jnp.einsum('blgp,ghp->blgh', x_re, c_re) - jnp.einsum('blgp,ghp->blgh', x_im, c_im)


def s5_bidirectional(u_lat, u_ctx, need_ctx, lam_re, lam_im, log_dt, b_re, b_im, c_re, c_im, d_skip):
    f32 = jnp.float32
    B, L, _ = u_lat.shape
    Lc = u_ctx.shape[1]
    ul = u_lat.astype(f32).reshape(B, L, S5_GROUPS, S5_CH)
    uc = u_ctx.astype(f32).reshape(B, Lc, S5_GROUPS, S5_CH)
    d = d_skip.astype(f32).reshape(S5_GROUPS, S5_CH)
    y_lat = ul * d
    y_ctx = uc * d
    for di in range(2):
        rev = di == 1
        lbr, lbi, bbr, bbi = s5_discretise(lam_re[di].astype(f32), lam_im[di].astype(f32),
                                           log_dt[di].astype(f32), b_re[di].astype(f32), b_im[di].astype(f32))
        ucd = jnp.flip(uc, axis=1) if rev else uc
        uld = jnp.flip(ul, axis=1) if rev else ul
        xc_re, xc_im = s5_scan(ucd, lbr, lbi, bbr, bbi, None)
        xl_re, xl_im = s5_scan(uld, lbr, lbi, bbr, bbi, (xc_re[:, -1], xc_im[:, -1]))
        cr = c_re[di].astype(f32)
        ci = c_im[di].astype(f32)
        yl = s5_readout(xl_re, xl_im, cr, ci)
        y_lat = y_lat + (jnp.flip(yl, axis=1) if rev else yl)
        if need_ctx:
            yc = s5_readout(xc_re, xc_im, cr, ci)
            y_ctx = y_ctx + (jnp.flip(yc, axis=1) if rev else yc)
    y_lat = y_lat.reshape(B, L, S5_WIDTH).astype(u_lat.dtype)
    y_ctx = y_ctx.reshape(B, Lc, S5_WIDTH).astype(u_ctx.dtype) if need_ctx else None
    return y_lat, y_ctx


def s5_glu(y, w_glu, b_glu):
    a = jax.nn.gelu(y) @ w_glu + b_glu
    return a[..., :S5_WIDTH] * jax.nn.sigmoid(a[..., S5_WIDTH:])


def even_mixer(h, hc, need_ctx, cos, sin, w_in, q_norm, kv_norm, w_uq, w_ukv,
               lam_re, lam_im, log_dt, b_re, b_im, c_re, c_im, d_skip, w_glu, b_glu, w_out):
    B, L, _ = h.shape
    Lc = hc.shape[1]
    z = h @ w_in
    zc = hc @ w_in
    qn, qr, kn, kr, v = mla_project(z, q_norm, kv_norm, w_uq, w_ukv)
    qn_c, qr_c, kn_c, kr_c, v_c = mla_project(zc, q_norm, kv_norm, w_uq, w_ukv)
    qr = apply_axial_rope(qr, cos[None, :, None, :], sin[None, :, None, :])
    kr = apply_axial_rope(kr, cos[None], sin[None])
    kn_all = jnp.concatenate([kn_c, kn], axis=1)
    kr_all = jnp.concatenate([kr_c, kr], axis=1)
    v_all = jnp.concatenate([v_c, v], axis=1)
    o_mla = mla_latent_attention(qn, qr, kn_all, kr_all, v_all)
    y_s5, y_s5_c = s5_bidirectional(z[..., EV_S4:EV_S5], zc[..., EV_S4:EV_S5], need_ctx,
                                    lam_re, lam_im, log_dt, b_re, b_im, c_re, c_im, d_skip)
    branch = jnp.concatenate([o_mla * jax.nn.silu(z[..., EV_S3:EV_S4]),
                              s5_glu(y_s5, w_glu, b_glu) * jax.nn.silu(z[..., EV_S5:])], axis=-1)
    out = branch @ w_out
    if not need_ctx:
        return out, None
    p_c = softmax_f32(mla_scores(qn_c, qr_c, kn_c, kr_c)).astype(v_c.dtype)
    o_c = jnp.einsum('bhqk,bkhd->bqhd', p_c, v_c).reshape(B, Lc, MLA_WIDTH)
    branch_c = jnp.concatenate([o_c * jax.nn.silu(zc[..., EV_S3:EV_S4]),
                                s5_glu(y_s5_c, w_glu, b_glu) * jax.nn.silu(zc[..., EV_S5:])], axis=-1)
    return out, branch_c @ w_out


def odd_mixer(h, hc, need_ctx, w_in, rpb, w_out):
    B, L, _ = h.shape
    Lc = hc.shape[1]
    rows = L // GRID_W
    kh = min(NA_KH, rows)
    nk = kh * GRID_W
    z = (h @ w_in).reshape(B, L, 4, NA_HEADS, NA_DH)
    q, k, v = z[:, :, 0], z[:, :, 1], z[:, :, 2]
    gate = z[:, :, 3].reshape(B, L, NA_WIDTH)
    zc = (hc @ w_in).reshape(B, Lc, 4, NA_HEADS, NA_DH)
    qc, kc, vc = zc[:, :, 0], zc[:, :, 1], zc[:, :, 2]
    gate_c = zc[:, :, 3].reshape(B, Lc, NA_WIDTH)

    qg = q.reshape(B, rows, GRID_W, NA_HEADS, NA_DH).transpose(1, 0, 2, 3, 4)
    kg = k.reshape(B, rows, GRID_W, NA_HEADS, NA_DH)
    vg = v.reshape(B, rows, GRID_W, NA_HEADS, NA_DH)
    col = jnp.arange(GRID_W, dtype=jnp.int32)
    cs = jnp.clip(col - NA_KW // 2, 0, GRID_W - NA_KW)
    col_mask = (col[None, :] >= cs[:, None]) & (col[None, :] < cs[:, None] + NA_KW)
    win_mask = jnp.tile(col_mask, (1, kh))
    dc_idx = jnp.clip(col[None, :] - col[:, None] + NA_KW - 1, 0, 2 * NA_KW - 2)

    def row_step(args):
        q_row, r = args
        rs = jnp.clip(r - kh // 2, 0, rows - kh)
        k_blk = lax.dynamic_slice_in_dim(kg, rs, kh, axis=1).reshape(B, nk, NA_HEADS, NA_DH)
        v_blk = lax.dynamic_slice_in_dim(vg, rs, kh, axis=1).reshape(B, nk, NA_HEADS, NA_DH)
        dr_idx = rs + jnp.arange(kh, dtype=jnp.int32) - r + NA_KH - 1
        bias = rpb[:, dr_idx][:, :, dc_idx]
        bias = bias.transpose(0, 2, 1, 3).reshape(NA_HEADS, GRID_W, nk)
        s_win = jnp.einsum('bqhd,bkhd->bhqk', q_row, k_blk) * NA_SCALE + bias
        s_win = jnp.where(win_mask, s_win.astype(jnp.float32), NEG_INF)
        s_ctx = (jnp.einsum('bqhd,bkhd->bhqk', q_row, kc) * NA_SCALE).astype(jnp.float32)
        p = softmax_f32(jnp.concatenate([s_win, s_ctx], axis=-1)).astype(v_blk.dtype)
        return (jnp.einsum('bhqk,bkhd->bqhd', p[..., :nk], v_blk)
                + jnp.einsum('bhqk,bkhd->bqhd', p[..., nk:], vc))

    o = lax.map(row_step, (qg, jnp.arange(rows, dtype=jnp.int32)))
    o = o.transpose(1, 0, 2, 3, 4).reshape(B, L, NA_WIDTH)
    out = (o * jax.nn.silu(gate)) @ w_out
    if not need_ctx:
        return out, None
    p_c = softmax_f32(jnp.einsum('bqhd,bkhd->bhqk', qc, kc) * NA_SCALE).astype(vc.dtype)
    o_c = jnp.einsum('bhqk,bkhd->bqhd', p_c, vc).reshape(B, Lc, NA_WIDTH)
    return out, (o_c * jax.nn.silu(gate_c)) @ w_out


def setup_inputs(seed: int = 0) -> dict:
    key = jax.random.key(seed)
    ks = jax.random.split(key, 32)
    f32 = jnp.float32

    def nrm(k, shape, s):
        return jax.random.normal(k, shape, f32) * s

    D = D_MODEL
    lam_im_base = jnp.pi * jnp.arange(S5_STATE, dtype=f32)
    return {
        "x": nrm(ks[0], (BATCH, SEQ, D), 1.0),
        "c": nrm(ks[1], (BATCH, D), 1.0),
        "ctx": nrm(ks[2], (BATCH, CTX_LEN, D), 1.0),
        "c_ctx": nrm(ks[3], (D,), 1.0),
        "ada_w": nrm(ks[4], (DEPTH, D, 3 * D), D ** -0.5),
        "ada_b": nrm(ks[5], (DEPTH, 3 * D), 0.02),
        "norm_g": 1.0 + nrm(ks[6], (DEPTH, D), 0.05),
        "final_g": 1.0 + nrm(ks[7], (D,), 0.05),
        "ev_w_in": nrm(ks[8], (N_EVEN, D, EVEN_IN), D ** -0.5),
        "ev_q_norm": 1.0 + nrm(ks[9], (N_EVEN, MLA_Q_RANK), 0.05),
        "ev_kv_norm": 1.0 + nrm(ks[10], (N_EVEN, MLA_KV_RANK), 0.05),
        "ev_w_uq": nrm(ks[11], (N_EVEN, MLA_Q_RANK, MLA_HEADS * MLA_QK), MLA_Q_RANK ** -0.5),
        "ev_w_ukv": nrm(ks[12], (N_EVEN, MLA_KV_RANK, MLA_HEADS * (MLA_NOPE + MLA_V)), MLA_KV_RANK ** -0.5),
        "s5_lam_re": -0.5 + nrm(ks[13], (N_EVEN, 2, S5_GROUPS, S5_STATE), 0.01),
        "s5_lam_im": lam_im_base + nrm(ks[14], (N_EVEN, 2, S5_GROUPS, S5_STATE), 0.01),
        "s5_log_dt": jax.random.uniform(ks[15], (N_EVEN, 2, S5_GROUPS), f32,
                                        minval=math.log(S5_DT_MIN), maxval=math.log(S5_DT_MAX)),
        "s5_b_re": nrm(ks[16], (N_EVEN, 2, S5_GROUPS, S5_STATE, S5_CH), (2 * S5_CH) ** -0.5),
        "s5_b_im": nrm(ks[17], (N_EVEN, 2, S5_GROUPS, S5_STATE, S5_CH), (2 * S5_CH) ** -0.5),
        "s5_c_re": nrm(ks[18], (N_EVEN, 2, S5_GROUPS, S5_CH, S5_STATE), 0.5),
        "s5_c_im": nrm(ks[19], (N_EVEN, 2, S5_GROUPS, S5_CH, S5_STATE), 0.5),
        "s5_d": nrm(ks[20], (N_EVEN, S5_WIDTH), 1.0),
        "s5_w_glu": nrm(ks[21], (N_EVEN, S5_WIDTH, 2 * S5_WIDTH), S5_WIDTH ** -0.5),
        "s5_b_glu": nrm(ks[22], (N_EVEN, 2 * S5_WIDTH), 0.02),
        "ev_w_out": nrm(ks[23], (N_EVEN, MLA_WIDTH + S5_WIDTH, D), (MLA_WIDTH + S5_WIDTH) ** -0.5),
        "na_w_in": nrm(ks[24], (N_ODD, D, ODD_IN), D ** -0.5),
        "na_rpb": nrm(ks[25], (N_ODD, NA_HEADS, 2 * NA_KH - 1, 2 * NA_KW - 1), 0.1),
        "na_w_out": nrm(ks[26], (N_ODD, NA_WIDTH, D), NA_WIDTH ** -0.5),
    }


def reference(x, c, ctx, c_ctx, ada_w, ada_b, norm_g, final_g,
              ev_w_in, ev_q_norm, ev_kv_norm, ev_w_uq, ev_w_ukv,
              s5_lam_re, s5_lam_im, s5_log_dt, s5_b_re, s5_b_im, s5_c_re, s5_c_im, s5_d,
              s5_w_glu, s5_b_glu, ev_w_out,
              na_w_in, na_rpb, na_w_out):
    n_tok = x.shape[1]
    cos, sin = axial_rope_tables(n_tok)
    sc = jax.nn.silu(c)
    scc = jax.nn.silu(c_ctx)
    for l in range(DEPTH):
        need_ctx = l < DEPTH - 1
        mod = sc @ ada_w[l] + ada_b[l]
        mod_c = scc @ ada_w[l] + ada_b[l]
        sh, scl, gt = jnp.split(mod, 3, axis=-1)
        sh_c, scl_c, gt_c = jnp.split(mod_c, 3, axis=-1)
        h = rmsnorm(x, norm_g[l]) * (1.0 + scl[:, None, :]) + sh[:, None, :]
        hc = rmsnorm(ctx, norm_g[l]) * (1.0 + scl_c) + sh_c
        i = l // 2
        if l % 2 == 0:
            out, out_c = even_mixer(h, hc, need_ctx, cos, sin, ev_w_in[i], ev_q_norm[i], ev_kv_norm[i],
                                    ev_w_uq[i], ev_w_ukv[i], s5_lam_re[i], s5_lam_im[i], s5_log_dt[i],
                                    s5_b_re[i], s5_b_im[i], s5_c_re[i], s5_c_im[i], s5_d[i],
                                    s5_w_glu[i], s5_b_glu[i], ev_w_out[i])
        else:
            out, out_c = odd_mixer(h, hc, need_ctx, na_w_in[i], na_rpb[i], na_w_out[i])
        x = x + gt[:, None, :] * out
        if need_ctx:
            ctx = ctx + gt_c * out_c
    return rmsnorm(x, final_g)
```

```cpp
#include <hip/hip_runtime.h>
#include <hip/hip_cooperative_groups.h>
#include <cstdio>
#include <cstdint>
#include <cmath>
namespace cg = cooperative_groups;

#define LAS __attribute__((address_space(3)))
#define GASP __attribute__((address_space(1)))
template <class T> __device__ __forceinline__ T* gptr(const void* p) { return (T*)(GASP T*)(T*)p; }
typedef unsigned short bf16_t;
typedef short bf16x8 __attribute__((ext_vector_type(8)));
typedef float f32x4 __attribute__((ext_vector_type(4)));
typedef float f32x2 __attribute__((ext_vector_type(2)));
typedef unsigned u32x4 __attribute__((ext_vector_type(4)));
typedef unsigned u32x2 __attribute__((ext_vector_type(2)));

constexpr int DM = 1024, NB = 8, SEQ = 4096, CTXL = 256;
constexpr int MLAT = NB * SEQ, MCTX = NB * CTXL, MROWS = MLAT + MCTX;
constexpr int EVEN_IN = 1952, EVEN_INP = 2048;
constexpr int EV_S1 = 256, EV_S2 = 384, EV_S3 = 416, EV_S4 = 928, EV_S5 = 1440;
constexpr int NCH = 136, NCHP = 1280, NCHR = NB * NCH;
constexpr float EPS = 1e-6f;

constexpr size_t MiB = 1u << 20;
constexpr size_t WS_CTL = 0, WS_MOD = 1 * MiB, WS_BB = 2 * MiB + 256 * 1024, WS_POW = 3 * MiB, WS_KT = 5 * MiB, WS_BTA = 8 * MiB, WS_BTC = 16 * MiB;
constexpr size_t WS_WEVIN = 40 * MiB, WS_WUQ = 44 * MiB, WS_WUKV = 44 * MiB + 512 * 1024, WS_WGLU = 45 * MiB, WS_WEVOUT = 46 * MiB, WS_WNAIN = 48 * MiB, WS_WNAOUT = 56 * MiB;
constexpr size_t WS_XCTX = 58 * MiB, WS_HB = 66 * MiB, WS_Z = 134 * MiB;
constexpr size_t WS_GATE = 134 * MiB;
constexpr size_t WS_CQ = 202 * MiB, WS_CKV = 219 * MiB, WS_SSQQ = 228 * MiB, WS_SSQKV = 229 * MiB, WS_KR = 230 * MiB, WS_S = 233 * MiB;
constexpr size_t WS_UX = 289 * MiB, WS_Q0 = 350 * MiB, WS_KV0 = 402 * MiB;
constexpr size_t WS_G2 = 254 * MiB;
constexpr size_t WS_VT = 406 * MiB;
constexpr size_t WS_SSQ = 498 * MiB;
constexpr size_t WS_SHW = 501 * MiB;
constexpr size_t WS_END = 502 * MiB;

struct Args { const float* in[27]; float* out; unsigned char* ws; };
typedef const __attribute__((address_space(4))) Args* KArgs;
__device__ __forceinline__ KArgs klaunder(KArgs a) { asm volatile("" : "+s"(a)); return a; }
__device__ __forceinline__ unsigned char* WSP(KArgs a) { return (unsigned char*)(GASP unsigned char*)a->ws; }
__device__ __forceinline__ const float* INP(KArgs a, int k) { return (const float*)(GASP const float*)a->in[k]; }
__device__ __forceinline__ float* OUTP(KArgs a) { return (float*)(GASP float*)a->out; }

__device__ __forceinline__ float bf2f(bf16_t v) { return __uint_as_float(((unsigned)v) << 16); }
__device__ __forceinline__ unsigned f2bf(float f) { unsigned u = __float_as_uint(f); return (u + 0x7fffu + ((u >> 16) & 1u)) >> 16; }
__device__ __forceinline__ unsigned pk2(float lo, float hi) { return f2bf(lo) | (f2bf(hi) << 16); }
__device__ __forceinline__ float lo16(unsigned w) { return __uint_as_float(w << 16); }
__device__ __forceinline__ float hi16(unsigned w) { return __uint_as_float(w & 0xffff0000u); }
__device__ __forceinline__ float wave_sum(float v) {
#pragma unroll
    for (int o = 1; o < 64; o <<= 1) v += __shfl_xor(v, o);
    return v;
}
__device__ __forceinline__ float silu_f(float v) { return v / (1.f + expf(-v)); }
__device__ __forceinline__ float gelu_tanh_f(float v) { const float u = 0.7978845608028654f * (v + 0.044715f * v * v * v); return v * (1.f - __builtin_amdgcn_rcpf(1.f + __expf(2.f * u))); }

namespace pg8 {
constexpr int BM = 256, BK = 64, HALF = 128, HTB = HALF * BK * 2, STAGE_BYTES = 8 * HTB, NXCD = 8, WGM = 8;
__host__ __device__ __forceinline__ int lds_byte(int r, int c) { const int st = (r >> 4) * 2 + (c >> 5), rr = r & 15, cc = c & 31, ob = rr * 64 + cc * 2; return st * 1024 + (ob ^ (((ob >> 9) & 1) << 5)); }
__host__ __device__ __forceinline__ void stage_rc(int b, int& R, int& C) { const int st = b / 1024, sb = b % 1024, swz = sb ^ (((sb >> 9) & 1) << 5); R = (st >> 1) * 16 + swz / 64; C = (st & 1) * 32 + (swz % 64) / 2; }
__host__ __device__ __forceinline__ int perm32(int rho) { const int n = rho >> 4, i = rho & 15; return 8 * (i >> 2) + 4 * n + (i & 3); }

struct Unit { int pm, pn; };
struct GD { const bf16_t* A; const bf16_t* Bt; bf16_t* O; int lda, K, ldc, nM, nN, mode, split_cols, vtb, ek; const void* p1; const void* p2; int ldb; const void* p3; const void* p4; const void* p5; int i1; };

struct Sched {
    int nM, nN, nwg, G, c, mode;
    __device__ __forceinline__ void init(const GD& g, int G_, int c_) { nM = g.nM; nN = g.nN; mode = g.mode; nwg = (mode == 0) ? nM * nN : (mode == 1 ? 160 : 320); G = G_; c = c_; }
    __device__ __forceinline__ bool next(int i, Unit& u) const {
        const long L = (long)i * G + c; if (L >= nwg) return false;
        int wgid = (int)L;
        if (mode == 1) { u.pm = wgid; u.pn = wgid / 5; return true; }
        if (mode == 2) { const int g = wgid / 10, rem = wgid % 10; u.pm = g * 5 + (rem >> 1); u.pn = 2 * g + (rem & 1); return true; }
        { const int q = nwg / NXCD, r = nwg % NXCD, xcd = wgid % NXCD, off = wgid / NXCD; wgid = (xcd < r ? xcd * (q + 1) : r * (q + 1) + (xcd - r) * q) + off; }
        const int nig = WGM * nN, gid = wgid / nig, fm = gid * WGM, gsz = (nM - fm) < WGM ? (nM - fm) : WGM;
        u.pm = fm + ((wgid % nig) % gsz); u.pn = (wgid % nig) / gsz; return true;
    }
};

__device__ __forceinline__ unsigned cvt_pk_bf16(float lo, float hi) { unsigned r; asm volatile("v_cvt_pk_bf16_f32 %0, %1, %2" : "=v"(r) : "v"(lo), "v"(hi)); return r; }

struct EpiBf16 {
    static constexpr bool PERM = true;
    bf16_t* O_; int ldc; int split_cols; int vtb; int ek; const void* p1; const void* p2; const void* p3; const void* p4; const void* p5; int i1; void* xl_; void* xc_;
    __device__ __forceinline__ void operator()(const f32x4 (&acc)[2][2][4][2], const Unit& u, int wr, int wc, int fr, int fq) const {
        bf16_t* const O = gptr<bf16_t>(this->O_);
        if (ek == 99) {
            f32x4 s = {0.f, 0.f, 0.f, 0.f};
#pragma unroll
            for (int ai = 0; ai < 2; ++ai)
#pragma unroll
                for (int bj = 0; bj < 2; ++bj)
#pragma unroll
                    for (int m = 0; m < 4; ++m) s += acc[ai][bj][m][0] + acc[ai][bj][m][1];
            if (s[0] + s[1] + s[2] + s[3] == 12345.678f) ((float*)p5)[0] = s[0];
            return; }
        const int row0 = u.pm * BM + wr * 64 + fr; int colt = u.pn * BM;
        if (ek == 6) {
            const int g = u.pn >> 1, cl0 = (u.pn & 1) * BM + wc * 32 + 8 * fq;
#pragma unroll
            for (int ai = 0; ai < 2; ++ai)
#pragma unroll
                for (int m = 0; m < 4; ++m) { const int R = row0 + ai * HALF + m * 16 - g * NCHP;
                    if (R < NCHR) { const int b = R / NCH, cc = R - b * NCH; const int tok0 = (cc < 8) ? MLAT + b * 256 + cc * 32 : b * 4096 + (cc - 8) * 32;
#pragma unroll
                        for (int bj = 0; bj < 2; ++bj) { const int cl = cl0 + bj * HALF, t = cl >> 4, h0 = cl & 15; const f32x4 v0 = acc[ai][bj][m][0], v1 = acc[ai][bj][m][1];
                            u32x4 w; w.x = cvt_pk_bf16(gelu_tanh_f(v0[0]), gelu_tanh_f(v0[1])); w.y = cvt_pk_bf16(gelu_tanh_f(v0[2]), gelu_tanh_f(v0[3]));
                            w.z = cvt_pk_bf16(gelu_tanh_f(v1[0]), gelu_tanh_f(v1[1])); w.w = cvt_pk_bf16(gelu_tanh_f(v1[2]), gelu_tanh_f(v1[3]));
                            *(u32x4*)(O + (size_t)(tok0 + t) * 512 + 16 * g + h0) = w; } } }
            return;
        }
        if (ek == 7) {
            const float* bias = gptr<const float>(p1); const bf16_t* zg = gptr<const bf16_t>(p2);
            const int ch0 = u.pn * HALF + wc * 32 + 8 * fq;
            const f32x4 ba0 = *(const f32x4*)(bias + ch0), ba1 = *(const f32x4*)(bias + ch0 + 4), bg0 = *(const f32x4*)(bias + 512 + ch0), bg1 = *(const f32x4*)(bias + 512 + ch0 + 4);
            u32x4 wzv[2][4];
#pragma unroll
            for (int ai = 0; ai < 2; ++ai)
#pragma unroll
                for (int m = 0; m < 4; ++m) wzv[ai][m] = *(const u32x4*)(zg + (size_t)(row0 + ai * HALF + m * 16) * (size_t)i1 + ch0);
#pragma unroll
            for (int ai = 0; ai < 2; ++ai)
#pragma unroll
                for (int m = 0; m < 4; ++m) { const size_t row = (size_t)(row0 + ai * HALF + m * 16);
                    const u32x4 wz = wzv[ai][m];
                    const f32x4 a0 = acc[ai][0][m][0] + ba0, a1 = acc[ai][0][m][1] + ba1, g0 = acc[ai][1][m][0] + bg0, g1 = acc[ai][1][m][1] + bg1;
#define GLX(av, gv, zv) ((av) * __builtin_amdgcn_rcpf(1.f + __expf(-(gv))) * silu_f(zv))
                    u32x4 w; w.x = cvt_pk_bf16(GLX(a0[0], g0[0], lo16(wz.x)), GLX(a0[1], g0[1], hi16(wz.x))); w.y = cvt_pk_bf16(GLX(a0[2], g0[2], lo16(wz.y)), GLX(a0[3], g0[3], hi16(wz.y)));
                    w.z = cvt_pk_bf16(GLX(a1[0], g1[0], lo16(wz.z)), GLX(a1[1], g1[1], hi16(wz.z))); w.w = cvt_pk_bf16(GLX(a1[2], g1[2], lo16(wz.w)), GLX(a1[3], g1[3], hi16(wz.w)));
#undef GLX
                    *(u32x4*)(O + row * ldc + ch0) = w; }
            return;
        }
        if (ek == 1) {
            unsigned char* wsb = gptr<unsigned char>(p3);
            bf16_t* CQ = (bf16_t*)(wsb + WS_CQ); bf16_t* CKV = (bf16_t*)(wsb + WS_CKV); bf16_t* KRo = (bf16_t*)(wsb + WS_KR); bf16_t* GATE = (bf16_t*)(wsb + WS_GATE); bf16_t* UXo = (bf16_t*)(wsb + WS_UX);
            float* SSQQ = (float*)(wsb + WS_SSQQ); float* SSQKV = (float*)(wsb + WS_SSQKV);
            const int bi = (u.pm < 128) ? (u.pm >> 4) : 8;
            const float* ssq = gptr<const float>(p1);
            f32x4 sw[2][2];
#pragma unroll
            for (int bj = 0; bj < 2; ++bj) { const float* shw = gptr<const float>(p2) + (size_t)bi * 4096 + colt + bj * HALF + wc * 32 + 8 * fq; sw[bj][0] = *(const f32x4*)shw; sw[bj][1] = *(const f32x4*)(shw + 4); }
#pragma unroll
            for (int ai = 0; ai < 2; ++ai) {
                float rsv[4];
#pragma unroll
                for (int m = 0; m < 4; ++m) { const f32x4 s0 = *((const f32x4*)(ssq + (size_t)(row0 + ai * HALF + m * 16) * 16) + fq);
                    float tot = (s0[0] + s0[1]) + (s0[2] + s0[3]); tot += __shfl_xor(tot, 16); tot += __shfl_xor(tot, 32);
                    rsv[m] = 1.0f / sqrtf(tot * (1.f / 1024.f) + EPS); }
#pragma unroll
                for (int m = 0; m < 4; ++m) { const int row = row0 + ai * HALF + m * 16;
                    const float rs = rsv[m];
                    float ss = 0.f;
#pragma unroll
                    for (int bj = 0; bj < 2; ++bj) { const int cw = colt + bj * HALF + wc * 32, c0 = cw + 8 * fq;
                        const f32x4 v0 = acc[ai][bj][m][0] * rs + sw[bj][0], v1 = acc[ai][bj][m][1] * rs + sw[bj][1];
                        u32x4 w; w.x = cvt_pk_bf16(v0[0], v0[1]); w.y = cvt_pk_bf16(v0[2], v0[3]); w.z = cvt_pk_bf16(v1[0], v1[1]); w.w = cvt_pk_bf16(v1[2], v1[3]);
                        if (cw < EV_S1) { *(u32x4*)(CQ + (size_t)row * 256 + c0) = w; ss += (v0[0] * v0[0] + v0[1] * v0[1]) + (v0[2] * v0[2] + v0[3] * v0[3]) + (v1[0] * v1[0] + v1[1] * v1[1]) + (v1[2] * v1[2] + v1[3] * v1[3]); }
                        else if (cw < EV_S2) { *(u32x4*)(CKV + (size_t)row * 128 + (c0 - EV_S1)) = w; ss += (v0[0] * v0[0] + v0[1] * v0[1]) + (v0[2] * v0[2] + v0[3] * v0[3]) + (v1[0] * v1[0] + v1[1] * v1[1]) + (v1[2] * v1[2] + v1[3] * v1[3]); }
                        else if (cw < EV_S3) *(u32x4*)(KRo + (size_t)row * 32 + (c0 - EV_S2)) = w;
                        else if (cw < EV_S4) *(u32x4*)(GATE + (size_t)row * 1024 + (c0 - EV_S3)) = w;
                        else if (cw < EV_S5) { const int ch = c0 - EV_S4; int R, s;
                            if (row < MLAT) { const int b = row >> 12, t = row & 4095; R = b * NCH + 8 + (t >> 5); s = t & 31; } else { const int r = row - MLAT, b = r >> 8, t = r & 255; R = b * NCH + (t >> 5); s = t & 31; }
                            *(u32x4*)(UXo + ((size_t)((ch >> 4) * NCHP + R)) * 768 + s * 16 + (ch & 15)) = w; }
                        else if (cw < EVEN_IN) *(u32x4*)(GATE + (size_t)row * 1024 + 512 + (c0 - EV_S5)) = w;
                    }
                    if (u.pn <= 1) { ss += __shfl_xor(ss, 16); ss += __shfl_xor(ss, 32);
                        if (fq == 0) { if (u.pn == 0) SSQQ[(size_t)row * 4 + wc] = ss; else SSQKV[(size_t)row * 4 + wc] = ss; } }
                    asm volatile("" ::: "memory");
                }
            }
            return;
        }
        if (ek == 3 || ek == 4) {
            const float* ssp = gptr<const float>(p1); const float invw = 1.0f / (float)i1;
            const int c00 = colt + wc * 32 + 8 * fq;
            float rstdv[2][4];
#pragma unroll
            for (int ai = 0; ai < 2; ++ai)
#pragma unroll
                for (int m = 0; m < 4; ++m) { const f32x4 s4 = *(const f32x4*)(ssp + (size_t)(row0 + ai * HALF + m * 16) * 4);
                    rstdv[ai][m] = ((ek == 3) ? 0.14724444f : 1.0f) / sqrtf(((s4[0] + s4[1]) + (s4[2] + s4[3])) * invw + EPS); }
#pragma unroll
            for (int ai = 0; ai < 2; ++ai)
#pragma unroll
                for (int m = 0; m < 4; ++m) { const int row = row0 + ai * HALF + m * 16;
                    const float rstd = rstdv[ai][m];
                    const bool lat = row < MLAT; const int t = row & 4095;
#pragma unroll
                    for (int bj = 0; bj < 2; ++bj) { const int c0 = c00 + bj * HALF; f32x4 v0 = acc[ai][bj][m][0] * rstd, v1 = acc[ai][bj][m][1] * rstd;
                        if (ek == 3) { const int d0 = c0 % 96; const bool rope = lat && (d0 >= 64); const int r0 = d0 - 64;
                            float vv[8] = {v0[0], v0[1], v0[2], v0[3], v1[0], v1[1], v1[2], v1[3]}, pv[8];
#pragma unroll
                            for (int e = 0; e < 8; ++e) pv[e] = __shfl_xor(vv[e], 16);
                            if (rope) { const float pos = (float)((r0 >> 4) ? (t & 63) : (t >> 6)); const bool hf = (r0 >> 3) & 1;
#pragma unroll
                                for (int e = 0; e < 8; ++e) { const float ang = pos * exp2f(-(float)e * (13.287712379549449f / 8.f)); const float sn = __sinf(ang), cs = __cosf(ang);
                                    vv[e] = hf ? (vv[e] * cs + pv[e] * sn) : (vv[e] * cs - pv[e] * sn); }
                                v0 = (f32x4){vv[0], vv[1], vv[2], vv[3]}; v1 = (f32x4){vv[4], vv[5], vv[6], vv[7]}; } }
                        u32x4 w; w.x = cvt_pk_bf16(v0[0], v0[1]); w.y = cvt_pk_bf16(v0[2], v0[3]); w.z = cvt_pk_bf16(v1[0], v1[1]); w.w = cvt_pk_bf16(v1[2], v1[3]);
                        *(u32x4*)(O + (size_t)row * ldc + c0) = w; } }
            return;
        }
        if (ek == 8) {
            const int l = i1 & 7; float* Xl = gptr<float>(xl_); float* Xc = gptr<float>(xc_); const float* xol_ = gptr<const float>(p1); const float* xoc_ = gptr<const float>(p2);
            const int bi = (u.pm < 128) ? (u.pm >> 4) : 8;
            const float* modl = gptr<const float>(p3) + (size_t)(l * 9 + bi) * 3072; const float* modn = gptr<const float>(p3) + (size_t)((l + 1) * 9 + bi) * 3072;
            const float* gam = p4 ? gptr<const float>(p4) : nullptr; float* ssq = gptr<float>(p5);
            const int c0 = u.pn * BM + wc * 32 + 8 * fq;
            f32x4 gt[2][2], gm[2][2];
#pragma unroll
            for (int bj = 0; bj < 2; ++bj)
#pragma unroll
                for (int n = 0; n < 2; ++n) { const int c = c0 + bj * HALF + 4 * n; gt[bj][n] = *(const f32x4*)(modl + 2048 + c);
                    if (gam) { const f32x4 g4 = *(const f32x4*)(gam + c), s4 = *(const f32x4*)(modn + 1024 + c); gm[bj][n] = g4 * (s4 + 1.0f); } else gm[bj][n] = (f32x4){0.f, 0.f, 0.f, 0.f}; }
#pragma unroll
            for (int ai = 0; ai < 2; ++ai)
#pragma unroll
              for (int mh = 0; mh < 2; ++mh) {
                f32x4 xpre[2][2][2];
#pragma unroll
                for (int mm = 0; mm < 2; ++mm) { const int row = row0 + ai * HALF + (2 * mh + mm) * 16; const bool lat = row < MLAT;
                    const float* xo = (lat ? xol_ : xoc_) + (lat ? (size_t)row * 1024 : (size_t)(row - MLAT) * 1024);
#pragma unroll
                    for (int bj = 0; bj < 2; ++bj)
#pragma unroll
                        for (int n = 0; n < 2; ++n) xpre[mm][bj][n] = *(const f32x4*)(xo + c0 + bj * HALF + 4 * n); }
#pragma unroll
                for (int mm = 0; mm < 2; ++mm) { const int m = 2 * mh + mm; const int row = row0 + ai * HALF + m * 16; const bool lat = row < MLAT;
                    const size_t ro = lat ? (size_t)row * 1024 : (size_t)(row - MLAT) * 1024;
                    float* xw = (lat ? Xl : Xc) + ro;
                    float ss = 0.f;
#pragma unroll
                    for (int bj = 0; bj < 2; ++bj) { f32x4 xn[2];
#pragma unroll
                        for (int n = 0; n < 2; ++n) { const int c = c0 + bj * HALF + 4 * n; const f32x4 xv = xpre[mm][bj][n]; xn[n] = xv + gt[bj][n] * acc[ai][bj][m][n];
                            *(f32x4*)(xw + c) = xn[n]; ss += (xn[n][0] * xn[n][0] + xn[n][1] * xn[n][1]) + (xn[n][2] * xn[n][2] + xn[n][3] * xn[n][3]); }
                        if (gam) { const f32x4 a0 = xn[0] * gm[bj][0], a1 = xn[1] * gm[bj][1];
                            u32x4 w; w.x = cvt_pk_bf16(a0[0], a0[1]); w.y = cvt_pk_bf16(a0[2], a0[3]); w.z = cvt_pk_bf16(a1[0], a1[1]); w.w = cvt_pk_bf16(a1[2], a1[3]);
                            *(u32x4*)(O + (size_t)row * ldc + c0 + bj * HALF) = w; } }
                    ss += __shfl_xor(ss, 16); ss += __shfl_xor(ss, 32);
                    if (fq == 0) ssq[(size_t)row * 16 + u.pn * 4 + wc] = ss; }
            }
            return;
        }
        if (split_cols) { const int t = colt / split_cols; colt -= t * split_cols; }
        const int col0 = colt + wc * 32 + 8 * fq;
        if (ek == 9) {
            const int bi = (u.pm < 128) ? (u.pm >> 4) : 8;
            const float* shw = (const float*)p2 + (size_t)bi * 4096 + col0; const float* ssq = gptr<const float>(p1);
            f32x4 sw[2][2];
#pragma unroll
            for (int bj = 0; bj < 2; ++bj) { sw[bj][0] = *(const f32x4*)(shw + bj * HALF); sw[bj][1] = *(const f32x4*)(shw + bj * HALF + 4); }
            float rsv[2][4];
#pragma unroll
            for (int ai = 0; ai < 2; ++ai)
#pragma unroll
                for (int m = 0; m < 4; ++m) { const f32x4 s0 = *((const f32x4*)(ssq + (size_t)(row0 + ai * HALF + m * 16) * 16) + fq);
                    float tot = (s0[0] + s0[1]) + (s0[2] + s0[3]); tot += __shfl_xor(tot, 16); tot += __shfl_xor(tot, 32);
                    rsv[ai][m] = 1.0f / sqrtf(tot * (1.f / 1024.f) + EPS); }
#pragma unroll
            for (int ai = 0; ai < 2; ++ai)
#pragma unroll
                for (int m = 0; m < 4; ++m) { const int row = row0 + ai * HALF + m * 16;
                    const float rs = rsv[ai][m];
                    bf16_t* rowp = O + (size_t)row * ldc + col0;
#pragma unroll
                    for (int bj = 0; bj < 2; ++bj) { f32x4 v0 = acc[ai][bj][m][0] * rs + sw[bj][0], v1 = acc[ai][bj][m][1] * rs + sw[bj][1];
                        if (colt < i1) { v0 *= 0.18033688f; v1 *= 0.18033688f; }
                        u32x4 w; w.x = cvt_pk_bf16(v0[0], v0[1]); w.y = cvt_pk_bf16(v0[2], v0[3]); w.z = cvt_pk_bf16(v1[0], v1[1]); w.w = cvt_pk_bf16(v1[2], v1[3]);
                        *(u32x4*)(rowp + bj * HALF) = w; } }
            return;
        }
        if (ek == 10) {
            const int bi = (u.pn < 128) ? (u.pn >> 4) : 8;
            const float* shw = (const float*)p2 + (size_t)bi * 4096; const float* ssq = gptr<const float>(p1);
            f32x4 rs4[2][2];
#pragma unroll
            for (int bj = 0; bj < 2; ++bj)
#pragma unroll
                for (int n = 0; n < 2; ++n)
#pragma unroll
                    for (int j = 0; j < 4; ++j) { const f32x4* sp = (const f32x4*)(ssq + (size_t)(col0 + bj * HALF + 4 * n + j) * 16); const f32x4 s0 = sp[0], s1 = sp[1], s2 = sp[2], s3 = sp[3];
                        const float tot = ((s0[0] + s0[1]) + (s0[2] + s0[3])) + ((s1[0] + s1[1]) + (s1[2] + s1[3])) + ((s2[0] + s2[1]) + (s2[2] + s2[3])) + ((s3[0] + s3[1]) + (s3[2] + s3[3]));
                        rs4[bj][n][j] = 1.0f / sqrtf(tot * (1.f / 1024.f) + EPS); }
            float shv[2][4];
#pragma unroll
            for (int ai = 0; ai < 2; ++ai)
#pragma unroll
                for (int m = 0; m < 4; ++m) shv[ai][m] = shw[row0 + ai * HALF + m * 16];
#pragma unroll
            for (int ai = 0; ai < 2; ++ai)
#pragma unroll
                for (int m = 0; m < 4; ++m) { const int row = row0 + ai * HALF + m * 16; const float sh = shv[ai][m];
#pragma unroll
                    for (int bj = 0; bj < 2; ++bj) { const f32x4 v0 = acc[ai][bj][m][0] * rs4[bj][0] + sh, v1 = acc[ai][bj][m][1] * rs4[bj][1] + sh;
                        u32x4 w; w.x = cvt_pk_bf16(v0[0], v0[1]); w.y = cvt_pk_bf16(v0[2], v0[3]); w.z = cvt_pk_bf16(v1[0], v1[1]); w.w = cvt_pk_bf16(v1[2], v1[3]);
                        *(u32x4*)(O + ((size_t)((col0 + bj * HALF) >> 3) * ldc + row) * 8) = w; } }
            return;
        }
#pragma unroll
        for (int ai = 0; ai < 2; ++ai)
#pragma unroll
            for (int m = 0; m < 4; ++m) { bf16_t* rowp = O + (size_t)(row0 + ai * HALF + m * 16) * ldc + col0;
#pragma unroll
                for (int bj = 0; bj < 2; ++bj) { const f32x4 v0 = acc[ai][bj][m][0], v1 = acc[ai][bj][m][1];
                    u32x4 w; w.x = cvt_pk_bf16(v0[0], v0[1]); w.y = cvt_pk_bf16(v0[2], v0[3]); w.z = cvt_pk_bf16(v1[0], v1[1]); w.w = cvt_pk_bf16(v1[2], v1[3]);
                    if (vtb) *(u32x4*)(O + ((size_t)((col0 + bj * HALF) >> 3) * ldc + (row0 + ai * HALF + m * 16)) * 8) = w;
                    else *(u32x4*)(rowp + bj * HALF) = w; } }
    }
};

template <class Epi>
__device__ __forceinline__ void gemm_phase(LAS unsigned char* lds, const GD g, const Sched& S, const Epi& E) {
    int tid_ = threadIdx.x; asm volatile("" : "+v"(tid_));
    const int tid = tid_, wid = __builtin_amdgcn_readfirstlane(tid >> 6), lane = tid & 63, wr = wid >> 2, wc = wid & 3, fr = lane & 15, fq = lane >> 4;
    const int K = g.K, nt = K / BK, lda = g.lda, ldb = g.ldb ? g.ldb : g.K;
    unsigned voffA[2], voffB[2];
#pragma unroll
    for (int i = 0; i < 2; ++i) { int R, C; stage_rc(tid * 16 + i * 8192, R, C); const int Rb = Epi::PERM ? ((R & ~31) + perm32(R & 31)) : R;
        voffA[i] = (unsigned)(R * lda + C) * 2u; voffB[i] = (unsigned)(Rb * ldb + C) * 2u; }
    const size_t kstep = (size_t)(BK * 2);
    const size_t hstepA = (size_t)HALF * lda * 2, hstepB = (size_t)HALF * ldb * 2;
    const size_t tstepA = 2 * hstepA, tstepB = 2 * hstepB;
    const unsigned ldsw = (unsigned)wid * 1024u;
    const int aoff = lds_byte(wr * 64 + fr, fq * 8), boff = lds_byte(wc * 32 + fr, fq * 8);
#define PG8_SA(b, h) (((b) * 2 + (h)) * HTB)
#define PG8_SB(b, h) ((4 + (b) * 2 + (h)) * HTB)
#define PG8_STAGE(bufoff, gbase, voff) do { _Pragma("unroll") for (int _i = 0; _i < 2; ++_i) \
        __builtin_amdgcn_global_load_lds((const unsigned*)((const char*)(gbase) + (voff)[_i]), (LAS unsigned*)(lds + (bufoff) + ldsw + _i * 8192), 16, 0, 0); } while (0)
#define PG8_LDA(dst, b, h) do { _Pragma("unroll") for (int m = 0; m < 4; ++m) _Pragma("unroll") for (int k = 0; k < 2; ++k) dst[m][k] = *(const LAS bf16x8*)(lds + PG8_SA(b, h) + aoff + m * 2048 + k * 1024); } while (0)
#define PG8_LDB(dst, b, h) do { _Pragma("unroll") for (int n = 0; n < 2; ++n) _Pragma("unroll") for (int k = 0; k < 2; ++k) dst[n][k] = *(const LAS bf16x8*)(lds + PG8_SB(b, h) + boff + n * 2048 + k * 1024); } while (0)
#define PG8_MMA(ai, bj, At, Bt) do { __builtin_amdgcn_s_setprio(1); _Pragma("unroll") for (int m = 0; m < 4; ++m) _Pragma("unroll") for (int n = 0; n < 2; ++n) _Pragma("unroll") for (int k = 0; k < 2; ++k) \
        acc[ai][bj][m][n] = __builtin_amdgcn_mfma_f32_16x16x32_bf16(Bt[n][k], At[m][k], acc[ai][bj][m][n], 0, 0, 0); __builtin_amdgcn_s_setprio(0); } while (0)
#define PG8_WAIT_V(n) asm volatile("s_waitcnt vmcnt(" #n ")" ::: "memory")
#define PG8_WAIT_L(n) asm volatile("s_waitcnt lgkmcnt(" #n ")" ::: "memory")
#define PG8_BAR __builtin_amdgcn_s_barrier()
#define PG8_SCHED __builtin_amdgcn_sched_barrier(0)
    Unit cur, nxt; int ui = 0;
    if (!S.next(0, cur)) return;
    f32x4 acc[2][2][4][2];
#pragma unroll
    for (int a = 0; a < 2; ++a)
#pragma unroll
        for (int b = 0; b < 2; ++b)
#pragma unroll
            for (int m = 0; m < 4; ++m)
#pragma unroll
                for (int n = 0; n < 2; ++n) acc[a][b][m][n] = (f32x4){0.f, 0.f, 0.f, 0.f};
    bf16x8 At[4][2], B0[2][2], B1[2][2];
    const char* cA = (const char*)g.A + (size_t)cur.pm * tstepA; const char* cB = (const char*)g.Bt + (size_t)cur.pn * tstepB;
    PG8_STAGE(PG8_SB(0, 0), cB, voffB); PG8_STAGE(PG8_SB(0, 1), cB + hstepB, voffB); PG8_STAGE(PG8_SA(0, 0), cA, voffA); PG8_STAGE(PG8_SA(0, 1), cA + hstepA, voffA);
    if (wr == 1) PG8_BAR;
    PG8_WAIT_V(2); PG8_BAR;
    PG8_STAGE(PG8_SB(1, 0), cB + kstep, voffB); PG8_STAGE(PG8_SA(1, 0), cA + kstep, voffA); PG8_STAGE(PG8_SB(1, 1), cB + hstepB + kstep, voffB);
    PG8_WAIT_V(6); PG8_BAR;
    for (;;) {
        const bool has_next = S.next(ui + 1, nxt);
        const char* nA = has_next ? (const char*)g.A + (size_t)nxt.pm * tstepA : cA; const char* nB = has_next ? (const char*)g.Bt + (size_t)nxt.pn * tstepB : cB;
        for (int t = 0; t < nt; t += 2) {
            const bool last = (t == nt - 2);
            const char* a1 = cA + (size_t)(t + 1) * kstep;
            const char* a2 = last ? nA : cA + (size_t)(t + 2) * kstep; const char* b2 = last ? nB : cB + (size_t)(t + 2) * kstep;
            const char* a3 = a2 + kstep; const char* b3 = b2 + kstep;
            PG8_LDB(B0, 0, 0); PG8_LDB(B1, 0, 1); PG8_SCHED; PG8_LDA(At, 0, 0); PG8_STAGE(PG8_SA(1, 1), a1 + hstepA, voffA);
            PG8_WAIT_V(8); PG8_WAIT_L(0); PG8_BAR; PG8_MMA(0, 0, At, B0); PG8_MMA(0, 1, At, B1); PG8_BAR; PG8_SCHED;
            PG8_LDA(At, 0, 1); PG8_STAGE(PG8_SB(0, 0), b2, voffB); PG8_STAGE(PG8_SB(0, 1), b2 + hstepB, voffB); PG8_STAGE(PG8_SA(0, 0), a2, voffA);
            PG8_WAIT_V(8); PG8_WAIT_L(0); PG8_BAR; PG8_MMA(1, 0, At, B0); PG8_MMA(1, 1, At, B1); PG8_BAR; PG8_SCHED;
            PG8_LDB(B0, 1, 0); PG8_LDB(B1, 1, 1); PG8_SCHED; PG8_LDA(At, 1, 0); PG8_STAGE(PG8_SA(0, 1), a2 + hstepA, voffA);
            PG8_WAIT_V(8); PG8_WAIT_L(0); PG8_BAR; PG8_MMA(0, 0, At, B0); PG8_MMA(0, 1, At, B1); PG8_BAR; PG8_SCHED;
            PG8_LDA(At, 1, 1); PG8_STAGE(PG8_SB(1, 0), b3, voffB); PG8_STAGE(PG8_SB(1, 1), b3 + hstepB, voffB); PG8_STAGE(PG8_SA(1, 0), a3, voffA);
            PG8_WAIT_V(8); PG8_WAIT_L(0); PG8_BAR; PG8_MMA(1, 0, At, B0); PG8_MMA(1, 1, At, B1); PG8_BAR; PG8_SCHED;
        }
        if (wr == 0) PG8_BAR;
        E(acc, cur, wr, wc, fr, fq);
        if (!has_next) break;
#pragma unroll
        for (int a = 0; a < 2; ++a)
#pragma unroll
            for (int b = 0; b < 2; ++b)
#pragma unroll
                for (int m = 0; m < 4; ++m)
#pragma unroll
                    for (int n = 0; n < 2; ++n) acc[a][b][m][n] = (f32x4){0.f, 0.f, 0.f, 0.f};
        cur = nxt; cA = nA; cB = nB; ++ui;
        if (wr == 1) PG8_BAR;
    }
    PG8_WAIT_V(0);
    PG8_BAR;
#undef PG8_SA
#undef PG8_SB
#undef PG8_STAGE
#undef PG8_LDA
#undef PG8_LDB
#undef PG8_MMA
#undef PG8_WAIT_V
#undef PG8_WAIT_L
#undef PG8_BAR
#undef PG8_SCHED
}
}

#define XB_TMO      128
#define XB_XCNT(j)  (256  + 64 * (j))
#define XB_XSUB(j)  (1280 + 64 * (j))
#define XB_XGEN(j)  (2304 + 64 * (j))
#define XB_TOP      3328
#define XB_TOPGEN   3392
#define XCD_BAR_WORDS 3456
#define XB_SPIN_CAP (1u << 22)
__device__ __forceinline__ unsigned xb_ld(unsigned* p)              { return __hip_atomic_load(p, __ATOMIC_RELAXED, __HIP_MEMORY_SCOPE_AGENT); }
__device__ __forceinline__ unsigned xb_add(unsigned* p, unsigned v) { return __hip_atomic_fetch_add(p, v, __ATOMIC_RELAXED, __HIP_MEMORY_SCOPE_AGENT); }
__device__ __forceinline__ unsigned xb_xcc_id() { return (unsigned)__builtin_amdgcn_s_getreg((3 << 11) | 20) & 0xFu; }
#define XB_SPIN(cond, bar) do { unsigned _sp = 0; while (cond) { __builtin_amdgcn_s_sleep(1); \
    if ((++_sp & 255u) == 0u) { if (xb_ld(&(bar)[XB_TMO])) break; if (_sp > XB_SPIN_CAP) { atomicAdd(&(bar)[XB_TMO], 1u); break; } } } } while (0)
struct XcdBarrier { unsigned* bar; unsigned x; volatile LAS unsigned* st; };
__device__ __forceinline__ XcdBarrier xcd_barrier_post(unsigned* bar, volatile LAS unsigned* st) {
    XcdBarrier b; b.bar = bar; b.x = xb_xcc_id(); b.st = st;
    if (threadIdx.x == 0) (void)xb_add(&bar[XB_XCNT(b.x)], 1u);
    return b;
}
__device__ __forceinline__ void xcd_barrier_complete(unsigned* bar, unsigned x, unsigned& nloc, unsigned& nx) {
    const unsigned G = gridDim.x * gridDim.y * gridDim.z;
    unsigned sum, cnt, mine, sp = 0u;
    for (;;) {
        sum = 0u; cnt = 0u; mine = 0u;
#pragma unroll
        for (unsigned j = 0; j < 16; ++j) { const unsigned c = xb_ld(&bar[XB_XCNT(j)]); sum += c; cnt += (c > 0u) ? 1u : 0u; mine = (j == x) ? c : mine; }
        if (sum == G) break;
        __builtin_amdgcn_s_sleep(1);
        if ((++sp & 255u) == 0u) { if (xb_ld(&bar[XB_TMO])) break; if (sp > XB_SPIN_CAP) { atomicAdd(&bar[XB_TMO], 1u); break; } }
    }
    nloc = mine > 0u ? mine : 1u; nx = cnt > 0u ? cnt : 1u;
}
__device__ __forceinline__ void xcd_barrier(const XcdBarrier& b) {
    asm volatile("s_waitcnt vmcnt(0)" ::: "memory");
    __syncthreads();
    if (threadIdx.x == 0) {
        unsigned* bar = b.bar;
        __builtin_amdgcn_s_waitcnt(0);
        unsigned nloc = b.st[0], nx = b.st[1];
        if (nloc == 0u) { xcd_barrier_complete(bar, b.x, nloc, nx); b.st[0] = nloc; b.st[1] = nx; }
        const unsigned old = xb_add(&bar[XB_XSUB(b.x)], 1u);
        const unsigned gen = old / nloc;
        if (old + 1u == (gen + 1u) * nloc) {
            __builtin_amdgcn_fence(__ATOMIC_RELEASE, "agent");
            asm volatile("s_waitcnt vmcnt(0)" ::: "memory");
            const unsigned og = xb_add(&bar[XB_TOP], 1u);
            const unsigned tg = og / nx;
            if (og + 1u == (tg + 1u) * nx) xb_add(&bar[XB_TOPGEN], 1u);
            else XB_SPIN(xb_ld(&bar[XB_TOPGEN]) == tg, bar);
            __builtin_amdgcn_fence(__ATOMIC_ACQUIRE, "agent");
            xb_add(&bar[XB_XGEN(b.x)], 1u);
            asm volatile("s_waitcnt vmcnt(0)" ::: "memory");
        } else {
            XB_SPIN(xb_ld(&bar[XB_XGEN(b.x)]) == gen, bar);
            __builtin_amdgcn_fence(__ATOMIC_ACQUIRE, "agent");
            asm volatile("s_waitcnt vmcnt(0)" ::: "memory");
        }
    }
    __syncthreads();
}

#ifndef PROBE_NOEPI
#define PROBE_NOEPI 0
#endif
#ifndef PROBE_SITES
#define PROBE_SITES 0
#endif
#ifndef PROBE_PRO
#define PROBE_PRO 1
#endif
#ifndef PROBE_WGT
#define PROBE_WGT 1
#endif
#ifndef PROBE_NAFAKE
#define PROBE_NAFAKE 0
#endif
#ifndef PROBE_MLAFAKE
#define PROBE_MLAFAKE 0
#endif
#ifndef PROBE_MLA
#define PROBE_MLA 1
#endif
#ifndef PROBE_NA
#define PROBE_NA 1
#endif
#ifndef PROBE_EW
#define PROBE_EW 1
#endif
#ifndef PROBE_S5
#define PROBE_S5 1
#endif
#ifndef PROBE_CARRY
#define PROBE_CARRY 1
#endif
constexpr int NWAVES = 8, NTHR = 512;
constexpr int LDS_BYTES = 147456;
struct Fr {
    LAS unsigned char* lds; int tid, lane, wave, gw, NGW, gt, NGT;
};
__device__ __forceinline__ Fr launder(Fr F) { asm volatile("" : "+v"(F.tid), "+v"(F.lane), "+v"(F.gt)); asm volatile("" : "+s"(F.wave), "+s"(F.gw)); return F; }

__device__ __forceinline__ void transpose_item(const float* W, int K, int N, bf16_t* WT, LAS float* scr, int item, int lane, int perm = 0, const float* kscale = nullptr) {
    const int nblk = N / 32, kb = item / nblk, nb = item % nblk, k0 = 64 * kb, n0 = 32 * nb;
#pragma unroll 8
    for (int i = 0; i < 32; ++i) { const int kk = 2 * i + (lane >> 5); float wv = W[(size_t)(k0 + kk) * N + n0 + (lane & 31)]; if (kscale) wv *= kscale[k0 + kk]; scr[kk * 33 + (lane & 31)] = wv; }
    asm volatile("s_waitcnt lgkmcnt(0)" ::: "memory");
    const int c = lane & 7;
#pragma unroll
    for (int j = 0; j < 4; ++j) { const int n = (lane >> 3) + 8 * j; const LAS float* s = scr + (8 * c) * 33 + n;
        u32x4 o; o.x = pk2(s[0 * 33], s[1 * 33]); o.y = pk2(s[2 * 33], s[3 * 33]); o.z = pk2(s[4 * 33], s[5 * 33]); o.w = pk2(s[6 * 33], s[7 * 33]);
        int nr = n0 + n; if (perm == 1) { const int cp = nr & 511; nr = 256 * (cp >> 7) + ((nr >> 9) << 7) + (cp & 127); }
        *(u32x4*)(WT + (size_t)nr * K + k0 + 8 * c) = o; }
    asm volatile("s_waitcnt lgkmcnt(0)" ::: "memory");
}

__device__ __forceinline__ void phase_mod(KArgs a0, const Fr& F0) {
    const Fr F = launder(F0); const KArgs a = klaunder(a0);
    LAS float* sc = (LAS float*)F.lds;
    LAS float* red = sc + 9 * 1024;
    float* MOD = (float*)(WSP(a) + WS_MOD);
    const float* c = INP(a, 1); const float* cc = INP(a, 3); const float* ada_w = INP(a, 4); const float* ada_b = INP(a, 5);
    if ((int)blockIdx.x < 192) {
        for (int i = F.tid; i < 9 * 1024; i += NTHR) { const int r = i >> 10, k = i & 1023; const float v = (r < 8) ? c[r * 1024 + k] : cc[k]; sc[i] = silu_f(v); }
    }
    __syncthreads();
    for (int item = blockIdx.x; item < 192; item += gridDim.x) {
        const int l = item / 48, cch = item % 48, col = cch * 64 + F.lane;
        const float* W = ada_w + (size_t)l * 1024 * 3072 + col;
        float acc[9];
#pragma unroll
        for (int r = 0; r < 9; ++r) acc[r] = 0.f;
        const int k0 = F.wave * 128;
#pragma unroll 16
        for (int k = k0; k < k0 + 128; ++k) { const float w = W[(size_t)k * 3072];
#pragma unroll
            for (int r = 0; r < 9; ++r) acc[r] += sc[r * 1024 + k] * w; }
#pragma unroll
        for (int r = 0; r < 9; ++r) red[(F.wave * 9 + r) * 64 + F.lane] = acc[r];
        __syncthreads();
        for (int i = F.tid; i < 576; i += NTHR) { const int r = i >> 6, ln = i & 63; float s = 0.f;
#pragma unroll
            for (int w = 0; w < 8; ++w) s += red[(w * 9 + r) * 64 + ln];
            MOD[(size_t)(l * 9 + r) * 3072 + cch * 64 + ln] = s + ada_b[l * 3072 + cch * 64 + ln]; }
        __syncthreads();
    }
}

__device__ __forceinline__ void phase_weights(KArgs a0, const Fr& F0, int l) {
    const Fr F = launder(F0); const KArgs a = klaunder(a0);
    LAS float* scr = (LAS float*)(F.lds + F.wave * 16384);
    const int i = l >> 1;
    if ((l & 1) == 0) {
        const float* w_in = INP(a, 8) + (size_t)i * 1024 * EVEN_IN; const float* w_uq = INP(a, 11) + (size_t)i * 256 * 768; const float* w_ukv = INP(a, 12) + (size_t)i * 128 * 1024;
        const float* w_glu = INP(a, 21) + (size_t)i * 512 * 1024; const float* w_out = INP(a, 23) + (size_t)i * 1024 * 1024;
        constexpr int I0 = 16 * 61, I1 = 4 * 24, I2 = 2 * 32, I3 = 8 * 32, I4 = 16 * 32, NI = I0 + I1 + I2 + I3 + I4;
        for (int it = F.gw; it < NI; it += F.NGW) {
            int r = it;
            if (r < I0) { transpose_item(w_in, 1024, EVEN_IN, (bf16_t*)(WSP(a) + WS_WEVIN), scr, r, F.lane); continue; } r -= I0;
            if (r < I1) { transpose_item(w_uq, 256, 768, (bf16_t*)(WSP(a) + WS_WUQ), scr, r, F.lane, 0, INP(a, 9) + i * 256); continue; } r -= I1;
            if (r < I2) { transpose_item(w_ukv, 128, 1024, (bf16_t*)(WSP(a) + WS_WUKV), scr, r, F.lane, 0, INP(a, 10) + i * 128); continue; } r -= I2;
            if (r < I3) { transpose_item(w_glu, 512, 1024, (bf16_t*)(WSP(a) + WS_WGLU), scr, r, F.lane, 1); continue; } r -= I3;
            transpose_item(w_out, 1024, 1024, (bf16_t*)(WSP(a) + WS_WEVOUT), scr, r, F.lane);
        }
        u32x4* pad = (u32x4*)((bf16_t*)(WSP(a) + WS_WEVIN) + (size_t)EVEN_IN * 1024);
        for (int t = F.gt; t < (EVEN_INP - EVEN_IN) * 1024 / 8; t += F.NGT) pad[t] = (u32x4){0u, 0u, 0u, 0u};
    } else {
        const float* w_in = INP(a, 24) + (size_t)i * 1024 * 4096; const float* w_out = INP(a, 26) + (size_t)i * 1024 * 1024;
        constexpr int I0 = 16 * 128, I1 = 16 * 32, NI = I0 + I1;
        for (int it = F.gw; it < NI; it += F.NGW) {
            int r = it;
            if (r < I0) { transpose_item(w_in, 1024, 4096, (bf16_t*)(WSP(a) + WS_WNAIN), scr, r, F.lane); continue; } r -= I0;
            transpose_item(w_out, 1024, 1024, (bf16_t*)(WSP(a) + WS_WNAOUT), scr, r, F.lane);
        }
    }
}

__device__ __forceinline__ void phase_s5_setup(KArgs a0, const Fr& F0, int i) {
    const Fr F = launder(F0); const KArgs a = klaunder(a0);
    f32x2* BB = (f32x2*)(WSP(a) + WS_BB); f32x2* POW = (f32x2*)(WSP(a) + WS_POW);
    const float* lam_re = INP(a, 13) + (size_t)i * 4096; const float* lam_im = INP(a, 14) + (size_t)i * 4096; const float* log_dt = INP(a, 15) + i * 64;
    const float* b_re = INP(a, 16) + (size_t)i * 65536; const float* b_im = INP(a, 17) + (size_t)i * 65536;
    for (int t = F.gt; t < 4096; t += F.NGT) {
        const int dg = t >> 6;
        const float dt = expf(log_dt[dg]);
        const float lr = fminf(lam_re[t], -1e-4f), li = lam_im[t];
        const float aa = lr * dt, th = li * dt;
        float sn, cs; sincosf(th, &sn, &cs);
        const float mag = expf(aa);
        const float lbr = mag * cs, lbi = mag * sn;
        const float sh = sinf(0.5f * th);
        const float nr = expm1f(aa) * cs - 2.f * sh * sh;
        const float den = lr * lr + li * li;
        const float kre = (nr * lr + lbi * li) / den, kim = (lbi * lr - nr * li) / den;
#pragma unroll
        for (int h = 0; h < 16; ++h) { const float br = b_re[(size_t)t * 16 + h], bi = b_im[(size_t)t * 16 + h];
            BB[(size_t)t * 16 + h] = (f32x2){kre * br - kim * bi, kre * bi + kim * br}; }
        const int p = t & 63;
        for (int tau = 0; tau <= 32; ++tau) { float s2, c2; sincosf(th * (float)tau, &s2, &c2); const float m2 = expf(aa * (float)tau);
            POW[((size_t)dg * 33 + tau) * 64 + p] = (f32x2){m2 * c2, m2 * s2}; }
    }
}
__device__ __forceinline__ void phase_s5_kt(KArgs a0, const Fr& F0, int i) {
    const Fr F = launder(F0); const KArgs a = klaunder(a0);
    const f32x2* BB = (const f32x2*)(WSP(a) + WS_BB); const f32x2* POW = (const f32x2*)(WSP(a) + WS_POW); float* KT = (float*)(WSP(a) + WS_KT);
    const float* c_re = INP(a, 18) + (size_t)i * 65536; const float* c_im = INP(a, 19) + (size_t)i * 65536;
    for (int t = F.gt; t < 32 * 2 * 32 * 256; t += F.NGT) {
        const int hp = t & 15, h = (t >> 4) & 15, tau = (t >> 8) & 31, di = (t >> 13) & 1, g = t >> 14;
        const int dg = di * 32 + g;
        const float* cr = c_re + ((size_t)dg * 16 + h) * 64; const float* ci = c_im + ((size_t)dg * 16 + h) * 64;
        const f32x2* pw = POW + ((size_t)dg * 33 + tau) * 64; const f32x2* bb = BB + (size_t)dg * 64 * 16 + hp;
        float s = 0.f;
#pragma unroll 16
        for (int p = 0; p < 64; ++p) { const f32x2 w = pw[p], b = bb[p * 16]; const float gr = cr[p] * w.x - ci[p] * w.y, gi = cr[p] * w.y + ci[p] * w.x; s += gr * b.x - gi * b.y; }
        KT[t] = s;
    }
}
__device__ __forceinline__ void phase_s5_tables(KArgs a0, const Fr& F0, int i) {
    const Fr F = launder(F0); const KArgs a = klaunder(a0);
    const f32x2* BB = (const f32x2*)(WSP(a) + WS_BB); const f32x2* POW = (const f32x2*)(WSP(a) + WS_POW); const float* KT = (const float*)(WSP(a) + WS_KT);
    const float* c_re = INP(a, 18) + (size_t)i * 65536; const float* c_im = INP(a, 19) + (size_t)i * 65536; const float* dsk = INP(a, 20) + i * 512;
    bf16_t* BTA = (bf16_t*)(WSP(a) + WS_BTA); bf16_t* BTC = (bf16_t*)(WSP(a) + WS_BTC);
    for (int t = F.gt; t < 32 * 256 * 64; t += F.NGT) {
        const int c8 = t & 63, row = (t >> 6) & 255, g = t >> 14;
        const int di = row >> 7, ri = (row >> 6) & 1, p = row & 63, s = c8 >> 1, h0 = (c8 & 1) * 8;
        const int dg = di * 32 + g, tau = di ? s : 31 - s;
        const f32x2 w = POW[((size_t)dg * 33 + tau) * 64 + p]; const f32x2* bb = BB + ((size_t)dg * 64 + p) * 16 + h0;
        float v[8];
#pragma unroll
        for (int j = 0; j < 8; ++j) { const f32x2 b = bb[j]; v[j] = ri ? (w.x * b.y + w.y * b.x) : (w.x * b.x - w.y * b.y); }
        *(u32x4*)(BTA + ((size_t)(g * 256 + row)) * 512 + c8 * 8) = (u32x4){pk2(v[0], v[1]), pk2(v[2], v[3]), pk2(v[4], v[5]), pk2(v[6], v[7])};
    }
    for (int t = F.gt; t < 32 * 512 * 96; t += F.NGT) {
        const int c8 = t % 96, row = (t / 96) & 511, g = t / (96 * 512);
        const int tt = row >> 4, h = row & 15;
        float v[8];
        if (c8 < 64) {
            const int s = c8 >> 1, h0 = (c8 & 1) * 8;
#pragma unroll
            for (int j = 0; j < 8; ++j) { const int hp = h0 + j; float x;
                if (tt > s) x = KT[(((size_t)(g * 2 + 0) * 32 + (tt - s)) * 16 + h) * 16 + hp];
                else if (tt < s) x = KT[(((size_t)(g * 2 + 1) * 32 + (s - tt)) * 16 + h) * 16 + hp];
                else { x = KT[(((size_t)(g * 2 + 0) * 32) * 16 + h) * 16 + hp] + KT[(((size_t)(g * 2 + 1) * 32) * 16 + h) * 16 + hp]; if (hp == h) x += dsk[g * 16 + h]; }
                v[j] = x; }
        } else {
            const int cc = (c8 - 64) * 8, di = cc >> 7, ri = (cc >> 6) & 1, p0 = cc & 63;
            const int dg = di * 32 + g, tau = di ? 32 - tt : tt + 1;
#pragma unroll
            for (int j = 0; j < 8; ++j) { const int p = p0 + j; const f32x2 w = POW[((size_t)dg * 33 + tau) * 64 + p];
                const float cr = c_re[((size_t)dg * 16 + h) * 64 + p], ci = c_im[((size_t)dg * 16 + h) * 64 + p];
                v[j] = ri ? -(cr * w.y + ci * w.x) : (cr * w.x - ci * w.y); }
        }
        *(u32x4*)(BTC + ((size_t)(g * 512 + row)) * 768 + c8 * 8) = (u32x4){pk2(v[0], v[1]), pk2(v[2], v[3]), pk2(v[4], v[5]), pk2(v[6], v[7])};
    }
}

__device__ __forceinline__ void phase_rn0(KArgs a0, const Fr& F0) {
    const Fr F = launder(F0); const KArgs a = klaunder(a0);
    const float* MOD = (const float*)(WSP(a) + WS_MOD); bf16_t* H = (bf16_t*)(WSP(a) + WS_HB); float* SSQ = (float*)(WSP(a) + WS_SSQ);
    const float* gam = INP(a, 6);
    for (int row = F.gw; row < MROWS; row += F.NGW) {
        const bool lat = row < MLAT; const int bi = lat ? (row >> 12) : 8;
        const float* xo = lat ? INP(a, 0) + (size_t)row * 1024 : INP(a, 2) + (size_t)(row - MLAT) * 1024;
        const float* md = MOD + (size_t)bi * 3072;
        f32x4 v[4]; float ss = 0.f;
#pragma unroll
        for (int j = 0; j < 4; ++j) { v[j] = ((const f32x4*)xo)[F.lane + 64 * j]; ss += (v[j].x * v[j].x + v[j].y * v[j].y) + (v[j].z * v[j].z + v[j].w * v[j].w); }
        ss = wave_sum(ss);
        u32x2* hrow = (u32x2*)(H + (size_t)row * 1024);
#pragma unroll
        for (int j = 0; j < 4; ++j) { const f32x4 g4 = ((const f32x4*)gam)[F.lane + 64 * j], s4 = ((const f32x4*)(md + 1024))[F.lane + 64 * j];
            hrow[F.lane + 64 * j] = (u32x2){pk2(v[j].x * g4.x * (1.f + s4.x), v[j].y * g4.y * (1.f + s4.y)), pk2(v[j].z * g4.z * (1.f + s4.z), v[j].w * g4.w * (1.f + s4.w))}; }
        if (F.lane < 16) SSQ[(size_t)row * 16 + F.lane] = (F.lane == 0) ? ss : 0.f;
    }
}
__device__ __forceinline__ void phase_shw(KArgs a0, const Fr& F0) {
    const Fr F = launder(F0); const KArgs a = klaunder(a0);
    LAS float* sc = (LAS float*)F.lds; LAS float* red = sc + 9 * 1024;
    const float* MOD = (const float*)(WSP(a) + WS_MOD); float* SHW = (float*)(WSP(a) + WS_SHW);
    for (int item = blockIdx.x; item < 190; item += gridDim.x) {
        int l, cch; if (item < 31) { l = 0; cch = item; } else if (item < 95) { l = 1; cch = item - 31; } else if (item < 126) { l = 2; cch = item - 95; } else { l = 3; cch = item - 126; }
        const int N = (l & 1) ? 4096 : EVEN_IN; const float* W = (l & 1) ? INP(a, 24) + (size_t)(l >> 1) * 1024 * 4096 : INP(a, 8) + (size_t)(l >> 1) * 1024 * EVEN_IN;
        __syncthreads();
        for (int t = F.tid; t < 9 * 1024; t += NTHR) sc[t] = MOD[(size_t)(l * 9 + (t >> 10)) * 3072 + (t & 1023)];
        __syncthreads();
        const int col = cch * 64 + F.lane; const bool ok = col < N; const float* Wc = W + (ok ? col : 0);
        float acc[9];
#pragma unroll
        for (int r = 0; r < 9; ++r) acc[r] = 0.f;
        const int k0 = F.wave * 128;
#pragma unroll 16
        for (int k = k0; k < k0 + 128; ++k) { const float w = Wc[(size_t)k * N];
#pragma unroll
            for (int r = 0; r < 9; ++r) acc[r] += sc[r * 1024 + k] * w; }
#pragma unroll
        for (int r = 0; r < 9; ++r) red[(F.wave * 9 + r) * 64 + F.lane] = acc[r];
        __syncthreads();
        for (int t = F.tid; t < 576; t += NTHR) { const int r = t >> 6, ln = t & 63; float s = 0.f;
#pragma unroll
            for (int w = 0; w < 8; ++w) s += red[(w * 9 + r) * 64 + ln];
            if (cch * 64 + ln < N) SHW[(size_t)(l * 9 + r) * 4096 + cch * 64 + ln] = s; }
    }
    __syncthreads();
}
__device__ __forceinline__ void phase_final(KArgs a0, const Fr& F0) {
    const Fr F = launder(F0); const KArgs a = klaunder(a0);
    const float* gam = INP(a, 7);
    for (int rp = F.gw; rp < MLAT / 2; rp += F.NGW) {
        float* xr0 = OUTP(a) + (size_t)(2 * rp) * 1024; float* xr1 = xr0 + 1024;
        f32x4 v[4], w[4]; float s0 = 0.f, s1 = 0.f;
#pragma unroll
        for (int j = 0; j < 4; ++j) { v[j] = ((const f32x4*)xr0)[F.lane + 64 * j]; w[j] = ((const f32x4*)xr1)[F.lane + 64 * j]; }
#pragma unroll
        for (int j = 0; j < 4; ++j) { s0 += (v[j].x * v[j].x + v[j].y * v[j].y) + (v[j].z * v[j].z + v[j].w * v[j].w); s1 += (w[j].x * w[j].x + w[j].y * w[j].y) + (w[j].z * w[j].z + w[j].w * w[j].w); }
        const float r0 = 1.0f / sqrtf(wave_sum(s0) * (1.f / 1024.f) + EPS), r1 = 1.0f / sqrtf(wave_sum(s1) * (1.f / 1024.f) + EPS);
#pragma unroll
        for (int j = 0; j < 4; ++j) { const f32x4 g4 = ((const f32x4*)gam)[F.lane + 64 * j];
            ((f32x4*)xr0)[F.lane + 64 * j] = (f32x4){v[j].x * r0 * g4.x, v[j].y * r0 * g4.y, v[j].z * r0 * g4.z, v[j].w * r0 * g4.w};
            ((f32x4*)xr1)[F.lane + 64 * j] = (f32x4){w[j].x * r1 * g4.x, w[j].y * r1 * g4.y, w[j].z * r1 * g4.z, w[j].w * r1 * g4.w}; }
    }
}

__device__ __forceinline__ void chunk_of_row(int row, int& R, int& s) {
    if (row < MLAT) { const int b = row >> 12, t = row & 4095; R = b * NCH + 8 + (t >> 5); s = t & 31; }
    else { const int r = row - MLAT, b = r >> 8, t = r & 255; R = b * NCH + (t >> 5); s = t & 31; }
}

__device__ __forceinline__ void phase_e2b(KArgs a0, const Fr& F0) {
    const Fr F = launder(F0); const KArgs a = klaunder(a0);
    const bf16_t* S = (const bf16_t*)(WSP(a) + WS_S); bf16_t* UX = (bf16_t*)(WSP(a) + WS_UX); const f32x2* POW = (const f32x2*)(WSP(a) + WS_POW);
    LAS bf16_t* T = (LAS bf16_t*)F.lds;
    for (int rep = 0; rep < PROBE_CARRY; ++rep)
    for (int it = blockIdx.x; it < NB * 32; it += gridDim.x) {
        const int b = it >> 5, g = it & 31;
        const size_t row0 = (size_t)g * NCHP + b * NCH;
        __syncthreads();
        { const u32x4* src4 = (const u32x4*)(S + row0 * 256); LAS u32x4* t4 = (LAS u32x4*)T;
          for (int t = F.tid; t < NCH * 32; t += NTHR) t4[t] = src4[t]; }
        __syncthreads();
        if (F.tid < 128) {
            const int di = F.tid >> 6, p = F.tid & 63;
            const f32x2 lt = POW[((size_t)(di * 32 + g) * 33 + 32) * 64 + p];
            float xr = 0.f, xi = 0.f;
#pragma unroll 8
            for (int k = 0; k < NCH; ++k) { const int cc = (di == 0) ? k : ((k < 8) ? 7 - k : 143 - k);
                LAS bf16_t* e = T + cc * 256 + di * 128 + p;
                const float sr = bf2f(e[0]), si = bf2f(e[64]);
                e[0] = (bf16_t)f2bf(xr); e[64] = (bf16_t)f2bf(xi);
                const float nr = lt.x * xr - lt.y * xi + sr, ni = lt.x * xi + lt.y * xr + si; xr = nr; xi = ni; }
        }
        __syncthreads();
        { const LAS u32x4* t4 = (const LAS u32x4*)T;
          for (int t = F.tid; t < NCH * 32; t += NTHR) { const int cc = t >> 5, c16 = t & 31; *(u32x4*)(UX + (row0 + cc) * 768 + 512 + c16 * 8) = t4[t]; } }
    }
    __syncthreads();
}

__device__ __forceinline__ void phase_krope(KArgs a0, const Fr& F0) {
    const Fr F = launder(F0); const KArgs a = klaunder(a0);
    bf16_t* KR = (bf16_t*)(WSP(a) + WS_KR);
    for (int t = F.gt; t < MLAT * 16; t += F.NGT) {
        const int row = t >> 4, axis = (t >> 3) & 1, ii = t & 7; const int tk = row & 4095;
        bf16_t* p0 = KR + (size_t)row * 32 + axis * 16 + ii;
        const float x0 = bf2f(p0[0]), x1 = bf2f(p0[8]);
        const float pos = (float)(axis ? (tk & 63) : (tk >> 6)); const float ang = pos * exp2f(-(float)ii * (13.287712379549449f / 8.f));
        float sn, cs; sincosf(ang, &sn, &cs);
        p0[0] = (bf16_t)f2bf(x0 * cs - x1 * sn); p0[8] = (bf16_t)f2bf(x1 * cs + x0 * sn);
    }
}

namespace mla {
using s16x4 = __attribute__((ext_vector_type(4))) short;
using f32x16 = __attribute__((ext_vector_type(16))) float;
constexpr int QBLK = 32, KVBLK = 64;
constexpr float SCALE = 0.10206207261596577f, THR = 8.f;
constexpr int SHM_V = 16384, SHM_K = 16384;
#define KSWZ(row, colB) ((row) * 256 + ((colB) ^ (((row) & 15) << 4)))
#define SBAR() __builtin_amdgcn_sched_barrier(0)
__device__ __forceinline__ int crow(int r, int hi) { return (r & 3) + 8 * (r >> 2) + 4 * hi; }
__device__ __forceinline__ unsigned cvtpk(float lo, float hi) { unsigned r; asm volatile("v_cvt_pk_bf16_f32 %0, %1, %2" : "=v"(r) : "v"(lo), "v"(hi)); return r; }
template <bool FIRST> __device__ __forceinline__ void partialSM(f32x16& p0, f32x16& p1, float& m_reg, float& alpha) {
  constexpr float THR2 = THR * 1.4426950408889634f;
  float pmax = p0[0];
#pragma unroll
  for (int r = 1; r < 16; ++r) pmax = fmaxf(pmax, p0[r]);
#pragma unroll
  for (int r = 0; r < 16; ++r) pmax = fmaxf(pmax, p1[r]);
  { auto rr = __builtin_amdgcn_permlane32_swap(__float_as_uint(pmax), __float_as_uint(pmax), false, false);
    pmax = fmaxf(__uint_as_float(rr[0]), __uint_as_float(rr[1])); }
  alpha = 1.f;
  if (FIRST || !__builtin_expect(__all(pmax <= THR2), 1)) {
    const float dl = FIRST ? pmax : fmaxf(pmax, 0.f);
    if (!FIRST) alpha = __builtin_amdgcn_exp2f(-dl);
    m_reg += dl;
#pragma unroll
    for (int r = 0; r < 16; ++r) { p0[r] -= dl; p1[r] -= dl; }
  }
#pragma unroll
  for (int r = 0; r < 16; ++r) p0[r] = __builtin_amdgcn_exp2f(p0[r]);
}
__device__ __forceinline__ void finishSM(f32x16& p0, f32x16& p1, float alpha, float& l_reg, bf16x8& pa0, bf16x8& pa1, bf16x8& pa2, bf16x8& pa3) {
#pragma unroll
  for (int r = 0; r < 16; ++r) p1[r] = __builtin_amdgcn_exp2f(p1[r]);
  float ps = 0;
#pragma unroll
  for (int r = 0; r < 16; ++r) ps += p0[r];
#pragma unroll
  for (int r = 0; r < 16; ++r) ps += p1[r];
  { auto rr = __builtin_amdgcn_permlane32_swap(__float_as_uint(ps), __float_as_uint(ps), false, false);
    ps = __uint_as_float(rr[0]) + __uint_as_float(rr[1]); }
  l_reg = l_reg * alpha + ps;
#define PK4(P, BASE, OUT) do { unsigned a0 = cvtpk(P[BASE + 0], P[BASE + 1]), a1 = cvtpk(P[BASE + 2], P[BASE + 3]);   \
    unsigned b0 = cvtpk(P[BASE + 4], P[BASE + 5]), b1 = cvtpk(P[BASE + 6], P[BASE + 7]);                              \
    auto r0 = __builtin_amdgcn_permlane32_swap(a0, b0, false, false); auto r1 = __builtin_amdgcn_permlane32_swap(a1, b1, false, false); \
    u32x4 w = {r0[0], r1[0], r0[1], r1[1]}; OUT = *reinterpret_cast<bf16x8*>(&w); } while (0)
  PK4(p0, 0, pa0); PK4(p0, 8, pa1); PK4(p1, 0, pa2); PK4(p1, 8, pa3);
#undef PK4
}
__device__ __forceinline__ void qkt(f32x16& p0, f32x16& p1, const char* Ks, const bf16x8* qr, int r32, int hi, float m_ref) {
#pragma unroll
  for (int r = 0; r < 16; ++r) { p0[r] = -m_ref; p1[r] = -m_ref; }
#pragma unroll
  for (int d0 = 0; d0 < 6; ++d0) { const int cb = (d0 * 16 + hi * 8) * 2;
    const bf16x8 b0 = *reinterpret_cast<const bf16x8*>(Ks + KSWZ(r32, cb));
    const bf16x8 b1 = *reinterpret_cast<const bf16x8*>(Ks + KSWZ(32 + r32, cb));
    p0 = __builtin_amdgcn_mfma_f32_32x32x16_bf16(b0, qr[d0], p0, 0, 0, 0);
    p1 = __builtin_amdgcn_mfma_f32_32x32x16_bf16(b1, qr[d0], p1, 0, 0, 0); }
}
__device__ __forceinline__ int v_st(int k, int c) { const int kk = (k & ~0xC) | ((k & 4) << 1) | ((k & 8) >> 1); return ((kk >> 3) * 4 + (c >> 5)) * 512 + ((kk & 7) * 32 + (c & 31)) * 2; }
__device__ __forceinline__ int v_rd_base(int lane) { return ((lane & 3) << 3) | (((lane >> 2) & 3) << 6) | (((lane >> 4) & 1) << 5) | (((lane >> 5) & 1) << 8); }
constexpr int v_rd_off(int d0, int ks, int half) { return d0 * 512 + ks * 4096 + half * 2048; }
template <int OFF> __device__ __forceinline__ s16x4 tr_read(int vb) { s16x4 r; asm volatile("ds_read_b64_tr_b16 %0, %1 offset:%2" : "=&v"(r) : "v"(vb), "i"(OFF) : "memory"); return r; }
template <int D0> __device__ __forceinline__ void pv_one(f32x16& od, int vb, bf16x8 pa0, bf16x8 pa1, bf16x8 pa2, bf16x8 pa3) {
  const s16x4 l0 = tr_read<v_rd_off(D0, 0, 0)>(vb), h0 = tr_read<v_rd_off(D0, 0, 1)>(vb), l1 = tr_read<v_rd_off(D0, 1, 0)>(vb), h1 = tr_read<v_rd_off(D0, 1, 1)>(vb);
  const s16x4 l2 = tr_read<v_rd_off(D0, 2, 0)>(vb), h2 = tr_read<v_rd_off(D0, 2, 1)>(vb), l3 = tr_read<v_rd_off(D0, 3, 0)>(vb), h3 = tr_read<v_rd_off(D0, 3, 1)>(vb);
  asm volatile("s_waitcnt lgkmcnt(0)" ::: "memory"); SBAR();
#define PK(L, H) (bf16x8){L[0], L[1], L[2], L[3], H[0], H[1], H[2], H[3]}
  od = __builtin_amdgcn_mfma_f32_32x32x16_bf16(pa0, PK(l0, h0), od, 0, 0, 0);
  od = __builtin_amdgcn_mfma_f32_32x32x16_bf16(pa1, PK(l1, h1), od, 0, 0, 0);
  od = __builtin_amdgcn_mfma_f32_32x32x16_bf16(pa2, PK(l2, h2), od, 0, 0, 0);
  od = __builtin_amdgcn_mfma_f32_32x32x16_bf16(pa3, PK(l3, h3), od, 0, 0, 0);
#undef PK
}
__device__ __forceinline__ void pv_d0(f32x16* o, int vb, bf16x8 pa0, bf16x8 pa1, bf16x8 pa2, bf16x8 pa3) { pv_one<0>(o[0], vb, pa0, pa1, pa2, pa3); pv_one<1>(o[1], vb, pa0, pa1, pa2, pa3); }

template <int FAKE> __device__ __forceinline__ void unit(const bf16_t* __restrict__ Q0, const bf16_t* __restrict__ KV0, const bf16_t* __restrict__ KR, const bf16_t* __restrict__ Z, bf16_t* __restrict__ BR,
                                     int qrow0, int b, int h, int nkeys, char* lds) {
  int tid_ = threadIdx.x; asm volatile("" : "+v"(tid_));
  const int tid = tid_, wid = tid >> 6, lane = tid & 63, r32 = lane & 31, hi = lane >> 5;
  char* V_lds = lds; char* K_lds = lds + 3 * SHM_V;
  float* ws = (float*)(lds + 3 * SHM_V + 3 * SHM_K) + wid * 64; float* li_l = ws; float* al_l = ws + 32;
  float m_reg = 0.f, l_reg = 0; f32x16 o[2] = {}; bf16x8 qr[6];
  const bf16_t* Qw = Q0 + (size_t)(qrow0 + wid * QBLK + r32) * 768 + h * 96 + hi * 8;
#pragma unroll
  for (int d0 = 0; d0 < 6; ++d0) qr[d0] = *reinterpret_cast<const bf16x8*>(Qw + d0 * 16);
  const int vrow = tid >> 3, vc = (tid & 7) * 8, vst = v_st(vrow, vc);
  const int kr0 = tid / 12, kc0 = tid % 12, kr1 = (512 + (tid & 255)) / 12, kc1 = (512 + (tid & 255)) % 12;
  const bf16_t* vsrc = KV0 + (size_t)vrow * 1024 + h * 128 + 64 + vc;
  const bf16_t* ksrc0 = (kc0 < 8) ? KV0 + (size_t)kr0 * 1024 + h * 128 + 8 * kc0 : KR + (size_t)kr0 * 32 + 8 * (kc0 - 8);
  const bf16_t* ksrc1 = (kc1 < 8) ? KV0 + (size_t)kr1 * 1024 + h * 128 + 8 * kc1 : KR + (size_t)kr1 * 32 + 8 * (kc1 - 8);
  const int kstr0 = (kc0 < 8) ? 1024 : 32, kstr1 = (kc1 < 8) ? 1024 : 32;
  const int kst0 = KSWZ(kr0, kc0 * 16), kst1 = KSWZ(kr1, kc1 * 16);
  const int vb0 = (int)(uintptr_t)V_lds + v_rd_base(lane);
  struct { bf16x8 vs, ks0, ks1; } sr_[2];
#define ROWB(k0) (((k0) < 256) ? (MLAT + b * 256 + (k0)) : (b * 4096 + (k0) - 256))
#define SLOAD(i, k0) do { if (FAKE == 1) break; const size_t rb_ = (size_t)ROWB(k0); sr_[i].vs = *reinterpret_cast<const bf16x8*>(vsrc + rb_ * 1024); \
    sr_[i].ks0 = *reinterpret_cast<const bf16x8*>(ksrc0 + rb_ * kstr0); sr_[i].ks1 = *reinterpret_cast<const bf16x8*>(ksrc1 + rb_ * kstr1); } while (0)
#define SWRITE(bf, i) do { *(bf16x8*)(V_lds + (bf) * SHM_V + vst) = sr_[i].vs; *(bf16x8*)(K_lds + (bf) * SHM_K + kst0) = sr_[i].ks0; \
    *(bf16x8*)(K_lds + (bf) * SHM_K + kst1) = sr_[i].ks1; } while (0)
#define RESC(a) do { if (__any((a) < 1.f)) { if (hi == 0) al_l[r32] = (a); asm volatile("s_waitcnt lgkmcnt(0)" ::: "memory"); \
    _Pragma("unroll") for (int d = 0; d < 2; ++d) _Pragma("unroll") for (int r = 0; r < 16; ++r) o[d][r] *= al_l[crow(r, hi)]; } } while (0)
#define BARX() do { if (FAKE != 3) __syncthreads(); } while (0)
#define QKT(P0, P1, KS) do { if (FAKE == 5) { P0 = f32x16{}; P1 = f32x16{}; } else qkt(P0, P1, KS, qr, r32, hi, m_reg); } while (0)
#define PSM(P0, P1, MN, AL) do { if (FAKE == 2) { AL = 1.f; } else partialSM<false>(P0, P1, m_reg, AL); } while (0)
#define PSM0(P0, P1, AL) do { if (FAKE == 2) { AL = 1.f; } else partialSM<true>(P0, P1, m_reg, AL); } while (0)
#define FSM(P0, P1, AL) do { if (FAKE == 2) { u32x4 w_ = {__float_as_uint(P0[0]), __float_as_uint(P0[1]), __float_as_uint(P1[0]), __float_as_uint(P1[1])}; pa0 = pa1 = pa2 = pa3 = *reinterpret_cast<bf16x8*>(&w_); } else finishSM(P0, P1, AL, l_reg, pa0, pa1, pa2, pa3); } while (0)
#define PVD(VB) do { if (FAKE != 4) pv_d0(o, VB, pa0, pa1, pa2, pa3); } while (0)
  f32x16 pA0, pA1, pB0, pB1; float mnA, mnB, alA, alB; bf16x8 pa0, pa1, pa2, pa3; const int NT = nkeys / KVBLK;
  int bo_prev = 0, bo_cur = 0, bo_next = SHM_V;
#define ROT3() do { bo_prev = bo_cur; bo_cur = bo_next; bo_next = (bo_next == 2 * SHM_V) ? 0 : bo_next + SHM_V; } while (0)
#define SWRITE3(off, i) do { if (FAKE == 1) break; *(bf16x8*)(V_lds + (off) + vst) = sr_[i].vs; *(bf16x8*)(K_lds + (off) + kst0) = sr_[i].ks0; *(bf16x8*)(K_lds + (off) + kst1) = sr_[i].ks1; } while (0)
  SLOAD(0, 0); SLOAD(1, KVBLK); SWRITE3(0, 0); SLOAD(0, 2 * KVBLK);
  BARX();
  SWRITE3(bo_next, 1); SLOAD(1, 3 * KVBLK);
  QKT(pA0, pA1, K_lds + bo_cur); PSM0(pA0, pA1, alA); RESC(alA);
  ROT3();
  for (int j = 1; j + 1 < NT; j += 2) {
    BARX();
    SWRITE3(bo_next, 0); { const int tn = (j + 3 < NT) ? j + 3 : NT - 1; SLOAD(0, tn * KVBLK); }
    QKT(pB0, pB1, K_lds + bo_cur);
    FSM(pA0, pA1, alA);
    PVD(vb0 + bo_prev); PSM(pB0, pB1, mnB, alB); RESC(alB);
    ROT3();
    BARX();
    SWRITE3(bo_next, 1); { const int tn = (j + 4 < NT) ? j + 4 : NT - 1; SLOAD(1, tn * KVBLK); }
    QKT(pA0, pA1, K_lds + bo_cur);
    FSM(pB0, pB1, alB);
    PVD(vb0 + bo_prev); PSM(pA0, pA1, mnA, alA); RESC(alA);
    ROT3();
  }
  BARX();
  QKT(pB0, pB1, K_lds + bo_cur);
  FSM(pA0, pA1, alA);
  PVD(vb0 + bo_prev); PSM(pB0, pB1, mnB, alB); RESC(alB);
  FSM(pB0, pB1, alB);
  PVD(vb0 + bo_cur);
#undef ROT3
#undef BARX
#undef QKT
#undef PSM
#undef PSM0
#undef FSM
#undef PVD
#undef SWRITE3
  if (hi == 0) li_l[r32] = l_reg; asm volatile("s_waitcnt lgkmcnt(0)" ::: "memory");
  float rli[16];
#pragma unroll
  for (int r = 0; r < 16; ++r) rli[r] = __builtin_amdgcn_rcpf(li_l[crow(r, hi)]);
  { LAS float* stg = (LAS float*)(unsigned)(uintptr_t)(lds + 3 * SHM_V + 3 * SHM_K + 2048) + wid * (32 * 36);
#pragma unroll
    for (int d0 = 0; d0 < 2; ++d0) {
      u32x4 gw[2];
#pragma unroll
      for (int i2 = 0; i2 < 2; ++i2) { const size_t qrow = (size_t)(qrow0 + wid * QBLK + 16 * i2 + (lane >> 2)); gw[i2] = *(const u32x4*)(Z + qrow * 1024 + h * 64 + d0 * 32 + 8 * (lane & 3)); }
#pragma unroll
      for (int r = 0; r < 16; ++r) stg[crow(r, hi) * 36 + r32] = o[d0][r] * rli[r];
      asm volatile("s_waitcnt lgkmcnt(0)" ::: "memory");
#pragma unroll
      for (int i2 = 0; i2 < 2; ++i2) { const size_t qrow = (size_t)(qrow0 + wid * QBLK + 16 * i2 + (lane >> 2));
        const LAS f32x4* sp = (const LAS f32x4*)(stg + (16 * i2 + (lane >> 2)) * 36 + 8 * (lane & 3)); const f32x4 a0 = sp[0], a1 = sp[1]; const u32x4 g = gw[i2];
        u32x4 w; w.x = pk2(a0[0] * silu_f(lo16(g.x)), a0[1] * silu_f(hi16(g.x))); w.y = pk2(a0[2] * silu_f(lo16(g.y)), a0[3] * silu_f(hi16(g.y)));
        w.z = pk2(a1[0] * silu_f(lo16(g.z)), a1[1] * silu_f(hi16(g.z))); w.w = pk2(a1[2] * silu_f(lo16(g.w)), a1[3] * silu_f(hi16(g.w)));
        *(u32x4*)(BR + qrow * 1024 + h * 64 + d0 * 32 + 8 * (lane & 3)) = w; }
      asm volatile("s_waitcnt lgkmcnt(0)" ::: "memory");
    } }
#undef ROWB
#undef SLOAD
#undef SWRITE
#undef RESC
}
#undef KSWZ
#undef SBAR
}

template <int FAKE> __device__ __forceinline__ void phase_mla(KArgs a0, const Fr& F0) {
    const Fr F = launder(F0); const KArgs a = klaunder(a0);
    const bf16_t* Q0 = (const bf16_t*)(WSP(a) + WS_Q0); const bf16_t* KV0 = (const bf16_t*)(WSP(a) + WS_KV0); const bf16_t* KR = (const bf16_t*)(WSP(a) + WS_KR);
    const bf16_t* Z = (const bf16_t*)(WSP(a) + WS_GATE); bf16_t* BR = (bf16_t*)(WSP(a) + WS_HB);
    const int vcu = (gridDim.x % 8 == 0) ? ((int)blockIdx.x % 8) * ((int)gridDim.x / 8) + (int)blockIdx.x / 8 : (int)blockIdx.x;
    for (int u = vcu; u < 1024 + 64; u += gridDim.x) {
        __syncthreads();
        if (u < 1024) { const int bh = u >> 4, qb = u & 15, b = bh >> 3, h = bh & 7; mla::unit<FAKE>(Q0, KV0, KR, Z, BR, b * 4096 + qb * 256, b, h, 4352, (char*)F.lds); }
        else { const int bh = u - 1024, b = bh >> 3, h = bh & 7; mla::unit<FAKE>(Q0, KV0, KR, Z, BR, MLAT + b * 256, b, h, 256, (char*)F.lds); }
    }
    __syncthreads();
}

namespace na {
using f32x16 = __attribute__((ext_vector_type(16))) float;
constexpr float C1 = 0.125f * 1.4426950408889634f, L2E = 1.4426950408889634f, THR2 = 11.5f;
__device__ __forceinline__ int crow(int r, int hi) { return (r & 3) + 8 * (r >> 2) + 4 * hi; }
__device__ __forceinline__ unsigned cvtpk(float lo, float hi) { unsigned r; asm volatile("v_cvt_pk_bf16_f32 %0, %1, %2" : "=v"(r) : "v"(lo), "v"(hi)); return r; }
constexpr int RING_OFF = 0, SLOT = 16384, NSLOT = 4, TAB_OFF = 69632, WSF_OFF = 73728, STG_OFF = 81920;
template <int FAKE> __device__ __forceinline__ void item(bf16_t* __restrict__ Z, const bf16_t* __restrict__ VT, LAS unsigned char* lds, int b, int h, bool lat, int q4) {
  int tid_ = threadIdx.x; asm volatile("" : "+v"(tid_));
  const int tid = tid_, lane = tid & 63, r32 = lane & 31, hi = lane >> 5, wid = __builtin_amdgcn_readfirstlane(tid >> 6);
  const LAS float* tab = (const LAS float*)(lds + TAB_OFF); LAS float* wsf = (LAS float*)(lds + WSF_OFF) + wid * 64;
  const int rp = 2 * q4 + (wid >> 2), ct = wid & 3;
  int rq = 0, cq = 0, qtok;
  if (lat) { rq = 2 * rp + (r32 >> 4); cq = 16 * ct + (r32 & 15); qtok = b * 4096 + rq * 64 + cq; } else qtok = MLAT + b * 256 + 32 * wid + r32;
  int rs0 = 2 * rp - 4; rs0 = rs0 < 0 ? 0 : (rs0 > 56 ? 56 : rs0);
  int rs1 = 2 * rp - 3; rs1 = rs1 < 0 ? 0 : (rs1 > 56 ? 56 : rs1);
  int u0 = 16 * ct - 8; u0 = u0 < 0 ? 0 : (u0 > 32 ? 32 : u0);
  int rsq = rq - 4; rsq = rsq < 0 ? 0 : (rsq > 56 ? 56 : rsq);
  int csq = cq - 8; csq = csq < 0 ? 0 : (csq > 48 ? 48 : csq);
  int rsA = 4 * q4 - 4; rsA = rsA < 0 ? 0 : (rsA > 56 ? 56 : rsA);
  int rsB = 4 * q4 - 1; rsB = rsB < 0 ? 0 : (rsB > 56 ? 56 : rsB);
  const int nst = lat ? 4 + (rsB - rsA + 8) : 4;
  bf16x8 qr[4];
  { const bf16_t* qp = Z + (size_t)qtok * 4096 + h * 64 + hi * 8;
#pragma unroll
    for (int d0 = 0; d0 < 4; ++d0) qr[d0] = *reinterpret_cast<const bf16x8*>(qp + d0 * 16); }
  const int srow = 8 * wid + (lane >> 3), sch = (lane & 7) ^ ((srow >> 1) & 7);
  const bf16_t* ksrc = Z + (size_t)srow * 4096 + 1024 + h * 64 + 8 * sch;
  const bf16_t* vsrc = VT + ((size_t)sch * 1024 + h * 64 + srow) * 8;
#define TOKB(s) (((s) < 4) ? (MLAT + b * 256 + 64 * (s)) : (b * 4096 + (rsA + (s) - 4) * 64))
  const unsigned ldsb = (unsigned)(uintptr_t)(lds + RING_OFF) + (unsigned)wid * 1024u;
#define GLDS16(gsrc, dst) do { unsigned keep_; asm volatile("s_mov_b32 %0, m0\n\ts_mov_b32 m0, %2\n\ts_nop 0\n\tglobal_load_lds_dwordx4 %1, off\n\ts_mov_b32 m0, %0" : "=&s"(keep_) : "v"(gsrc), "s"(dst) : "memory"); } while (0)
#define ISSUE(s) do { if (FAKE == 1) break; const int tb_ = TOKB(s); const unsigned sl_ = (unsigned)__builtin_amdgcn_readfirstlane(ldsb + (unsigned)(((s) & 3) * SLOT)); \
    GLDS16(ksrc + (size_t)tb_ * 4096, sl_); GLDS16(vsrc + (size_t)(tb_ >> 3) * 8192, sl_ + 8192u); } while (0)
  const int swz = (r32 >> 1) & 7;
  f32x16 o[2] = {}; float m_reg = 0.f, l_reg = 0.f;
#define PK4(P, BASE, OUT) do { unsigned a0 = cvtpk(P[BASE + 0], P[BASE + 1]), a1 = cvtpk(P[BASE + 2], P[BASE + 3]);   \
    unsigned b0 = cvtpk(P[BASE + 4], P[BASE + 5]), b1 = cvtpk(P[BASE + 6], P[BASE + 7]);                              \
    auto r0 = __builtin_amdgcn_permlane32_swap(a0, b0, false, false); auto r1 = __builtin_amdgcn_permlane32_swap(a1, b1, false, false); \
    u32x4 w = {r0[0], r1[0], r0[1], r1[1]}; OUT = *reinterpret_cast<bf16x8*>(&w); } while (0)
#define BLOCK(SL, krow0, kswz, vch0, WIN, kr, FIRSTB) do { \
    bf16x8 kf[4], vf[2][2]; \
    { const LAS unsigned char* kp_ = (SL) + ((krow0) + r32) * 128; \
      _Pragma("unroll") for (int d0 = 0; d0 < 4; ++d0) kf[d0] = *(const LAS bf16x8*)(kp_ + (((2 * d0 + hi) ^ (kswz)) << 4)); \
      _Pragma("unroll") for (int d0 = 0; d0 < 2; ++d0) _Pragma("unroll") for (int ks = 0; ks < 2; ++ks) \
        vf[d0][ks] = *(const LAS bf16x8*)((SL) + 8192 + (32 * d0 + r32) * 128 + ((((vch0) + 2 * ks + hi) ^ swz) << 4)); } \
    f32x16 p; \
    _Pragma("unroll") for (int r = 0; r < 16; ++r) p[r] = -m_reg;                   \
    if (FAKE != 5) { _Pragma("unroll") for (int d0 = 0; d0 < 4; ++d0) p = __builtin_amdgcn_mfma_f32_32x32x16_bf16(kf[d0], qr[d0], p, 0, 0, 0); } \
    if (FAKE != 2) { \
    if (WIN) { \
      const bool rowok = (unsigned)((kr) - rsq) < 8u; \
      const LAS float* tp = tab + ((kr) - rq + 7) * 31 + (u0 - cq + 15) + 4 * hi; \
      const int kc0 = u0 + 4 * hi - csq; \
      _Pragma("unroll") for (int r = 0; r < 16; ++r) { const int off = (r & 3) + 8 * (r >> 2); const bool ok = rowok && ((unsigned)(kc0 + off) < 16u); \
        const float bv = tp[off]; p[r] = ok ? (p[r] + bv) : -1e30f; } \
    } \
    float bmax = p[0]; \
    _Pragma("unroll") for (int r = 1; r < 16; ++r) bmax = fmaxf(bmax, p[r]); \
    { auto rr = __builtin_amdgcn_permlane32_swap(__float_as_uint(bmax), __float_as_uint(bmax), false, false); bmax = fmaxf(__uint_as_float(rr[0]), __uint_as_float(rr[1])); } \
    if ((FIRSTB) || !__all(bmax <= THR2)) { \
      const float dl = (FIRSTB) ? bmax : fmaxf(bmax, 0.f); m_reg += dl; \
      _Pragma("unroll") for (int r = 0; r < 16; ++r) p[r] -= dl; \
      if (!(FIRSTB)) { const float alpha = __builtin_amdgcn_exp2f(-dl); l_reg *= alpha; \
        if (hi == 0) wsf[r32] = alpha; asm volatile("s_waitcnt lgkmcnt(0)" ::: "memory"); \
        _Pragma("unroll") for (int d = 0; d < 2; ++d) _Pragma("unroll") for (int r = 0; r < 16; ++r) o[d][r] *= wsf[crow(r, hi)]; } \
    } \
    float ps = 0.f; \
    _Pragma("unroll") for (int r = 0; r < 16; ++r) { p[r] = __builtin_amdgcn_exp2f(p[r]); ps += p[r]; } \
    l_reg += ps; \
    } \
    bf16x8 pa0, pa1; PK4(p, 0, pa0); PK4(p, 8, pa1); \
    if (FAKE != 4) { _Pragma("unroll") for (int d0 = 0; d0 < 2; ++d0) { o[d0] = __builtin_amdgcn_mfma_f32_32x32x16_bf16(pa0, vf[d0][0], o[d0], 0, 0, 0); o[d0] = __builtin_amdgcn_mfma_f32_32x32x16_bf16(pa1, vf[d0][1], o[d0], 0, 0, 0); } } \
  } while (0)
  const int kswzw = ((u0 + r32) >> 1) & 7;
  ISSUE(0); ISSUE(1);
  for (int s = 0; s < nst; ++s) {
    if (s + 1 < nst) asm volatile("s_waitcnt vmcnt(2)" ::: "memory"); else asm volatile("s_waitcnt vmcnt(0)" ::: "memory");
    asm volatile("s_waitcnt lgkmcnt(0)" ::: "memory");
    if (FAKE != 3) __builtin_amdgcn_s_barrier();
    if (s + 2 < nst) ISSUE(s + 2);
    const LAS unsigned char* sl = lds + RING_OFF + (s & 3) * SLOT;
    if (s == 0) { BLOCK(sl, 0, swz, 0, false, 0, true); BLOCK(sl, 32, swz, 4, false, 0, false); }
    else if (s < 4) { BLOCK(sl, 0, swz, 0, false, 0, false); BLOCK(sl, 32, swz, 4, false, 0, false); }
    else { const int kr = rsA + s - 4; if (kr >= rs0 && kr <= rs1 + 7) BLOCK(sl, u0, kswzw, (u0 >> 3), true, kr, false); }
  }
#undef BLOCK
#undef PK4
#undef ISSUE
#undef GLDS16
#undef TOKB
  { auto rr = __builtin_amdgcn_permlane32_swap(__float_as_uint(l_reg), __float_as_uint(l_reg), false, false); l_reg = __uint_as_float(rr[0]) + __uint_as_float(rr[1]); }
  if (hi == 0) wsf[32 + r32] = l_reg; asm volatile("s_waitcnt lgkmcnt(0)" ::: "memory");
  if (FAKE == 6) return;
  { LAS float* stg = (LAS float*)(lds + STG_OFF) + wid * (32 * 36);
    float rli[16];
#pragma unroll
    for (int r = 0; r < 16; ++r) rli[r] = __builtin_amdgcn_rcpf(wsf[32 + crow(r, hi)]);
#pragma unroll
    for (int d0 = 0; d0 < 2; ++d0) {
      u32x4 gw[2]; size_t toks[2];
#pragma unroll
      for (int i2 = 0; i2 < 2; ++i2) { const int qi = 16 * i2 + (lane >> 2);
        toks[i2] = lat ? (size_t)(b * 4096 + (2 * rp + (qi >> 4)) * 64 + 16 * ct + (qi & 15)) : (size_t)(MLAT + b * 256 + 32 * wid + qi);
        gw[i2] = *(const u32x4*)(Z + toks[i2] * 4096 + 3072 + h * 64 + d0 * 32 + 8 * (lane & 3)); }
#pragma unroll
      for (int r = 0; r < 16; ++r) stg[crow(r, hi) * 36 + r32] = o[d0][r] * rli[r];
      asm volatile("s_waitcnt lgkmcnt(0)" ::: "memory");
#pragma unroll
      for (int i2 = 0; i2 < 2; ++i2) { const LAS f32x4* sp = (const LAS f32x4*)(stg + (16 * i2 + (lane >> 2)) * 36 + 8 * (lane & 3)); const f32x4 a0 = sp[0], a1 = sp[1]; const u32x4 g = gw[i2];
        u32x4 w; w.x = pk2(a0[0] * silu_f(lo16(g.x)), a0[1] * silu_f(hi16(g.x))); w.y = pk2(a0[2] * silu_f(lo16(g.y)), a0[3] * silu_f(hi16(g.y)));
        w.z = pk2(a1[0] * silu_f(lo16(g.z)), a1[1] * silu_f(hi16(g.z))); w.w = pk2(a1[2] * silu_f(lo16(g.w)), a1[3] * silu_f(hi16(g.w)));
        *(u32x4*)(Z + toks[i2] * 4096 + 2048 + h * 64 + d0 * 32 + 8 * (lane & 3)) = w; }
      asm volatile("s_waitcnt lgkmcnt(0)" ::: "memory");
    } }
}
}

template <int FAKE> __device__ __forceinline__ void phase_na(KArgs a0, const Fr& F0, int i, bool need_ctx) {
    const Fr F = launder(F0); const KArgs a = klaunder(a0);
    bf16_t* Z = (bf16_t*)(WSP(a) + WS_Z); const bf16_t* VT = (const bf16_t*)(WSP(a) + WS_VT);
    const float* rpb = INP(a, 25) + (size_t)i * 16 * 465;
    LAS float* tab = (LAS float*)(F.lds + na::TAB_OFF);
    const int vcu = (gridDim.x % 8 == 0) ? ((int)blockIdx.x % 8) * ((int)gridDim.x / 8) + (int)blockIdx.x / 8 : (int)blockIdx.x;
    const int nitems = 8 * 16 * 16 + (need_ctx ? 8 * 16 : 0);
    for (int it = vcu; it < nitems; it += gridDim.x) {
        const bool lat = it < 2048;
        int b, h, q4 = 0;
        if (lat) { q4 = it & 15; h = (it >> 4) & 15; b = it >> 8; } else { const int j = it - 2048; h = j & 15; b = j >> 4; }
        __syncthreads();
        for (int t = F.tid; t < 465; t += NTHR) tab[t] = rpb[h * 465 + t] * na::L2E;
        __syncthreads();
        na::item<FAKE>(Z, VT, F.lds, b, h, lat, q4);
    }
    __syncthreads();
}

__device__ __forceinline__ void run_gemm(const Fr& F, const pg8::GD& g, void* xl = nullptr, void* xc = nullptr, int site = 31, int rot = 0) {
    pg8::Sched S; S.init(g, (int)gridDim.x, (int)((blockIdx.x + rot) % gridDim.x));
    pg8::EpiBf16 E{g.O, g.ldc, g.split_cols, g.vtb, g.ek, g.p1, g.p2, g.p3, g.p4, g.p5, g.i1, xl, xc};
    if ((PROBE_NOEPI >> site) & 1) { pg8::EpiBf16 E0 = E; E0.ek = 99; pg8::gemm_phase<pg8::EpiBf16>(F.lds, g, S, E0); }
    for (int rep = 0; rep < (((PROBE_SITES >> site) & 1) ? 2 : 1); ++rep) pg8::gemm_phase<pg8::EpiBf16>(F.lds, g, S, E);
}

__global__ void __launch_bounds__(NTHR, 2) mega_fwd(Args a_unused) {
    const KArgs a_k = (KArgs)__builtin_amdgcn_kernarg_segment_ptr(); const KArgs a = a_k;
    extern __shared__ __attribute__((aligned(16))) unsigned char lds_raw[];
    cg::grid_group grid = cg::this_grid();
    Fr F; F.lds = (LAS unsigned char*)lds_raw; F.tid = threadIdx.x; F.lane = F.tid & 63; F.wave = __builtin_amdgcn_readfirstlane(F.tid >> 6);
    F.gw = blockIdx.x * NWAVES + F.wave; F.NGW = gridDim.x * NWAVES; F.gt = blockIdx.x * NTHR + F.tid; F.NGT = gridDim.x * NTHR;
    unsigned char* ws = WSP(klaunder(a));
    volatile LAS unsigned* bst = (volatile LAS unsigned*)(F.lds + LDS_BYTES - 64);
    if (F.tid < 16) bst[F.tid] = 0u;
    __syncthreads();
    const unsigned xcc_x = xcd_barrier_post((unsigned*)(ws + WS_CTL) + 4096, bst).x;
#define GSYNC() do { XcdBarrier xb_; xb_.bar = (unsigned*)(WSP(klaunder(a_k)) + WS_CTL) + 4096; { unsigned x_ = xcc_x; asm volatile("" : "+s"(x_)); xb_.x = x_; } xb_.st = (volatile LAS unsigned*)(F.lds + LDS_BYTES - 64); xcd_barrier(xb_); } while (0)
    for (int rep = 0; rep < PROBE_PRO; ++rep) { phase_mod(a, F); phase_s5_setup(a, F, 0); }
    { u32x4* ux = (u32x4*)(ws + WS_UX);
      for (int t = F.gt; t < 32 * (NCHP - NCHR) * 96; t += F.NGT) { const int g = t / ((NCHP - NCHR) * 96), rem = t % ((NCHP - NCHR) * 96); ux[((size_t)(g * NCHP + NCHR)) * 96 + rem] = (u32x4){0u, 0u, 0u, 0u}; } }
    grid.sync();
    for (int rep = 0; rep < PROBE_PRO; ++rep) { phase_weights(a, F, 0); __syncthreads();
    for (int rep2 = 0; rep2 < PROBE_S5; ++rep2) phase_s5_kt(a, F, 0);
    phase_shw(a, F);
    phase_rn0(a, F); }
    GSYNC();
    for (int l = 0; l < 4; ++l) {
        const int i = l >> 1;
        const KArgs a = klaunder(a_k); unsigned char* ws = WSP(a);
        float* Xctx = (float*)(ws + WS_XCTX);
        const float* MODp = (const float*)(ws + WS_MOD); const float* SSQp = (const float*)(ws + WS_SSQ);
        const float* SHWl = (const float*)(ws + WS_SHW) + (size_t)l * 9 * 4096;
        const float* xol = (l == 0) ? INP(a, 0) : (const float*)OUTP(a); const float* xoc = (l == 0) ? INP(a, 2) : (const float*)Xctx;
        const float* gnext = (l < 3) ? INP(a, 6) + (l + 1) * 1024 : nullptr;
        if (l < 3) for (int rep = 0; rep < PROBE_WGT; ++rep) { phase_weights(a, F, l + 1); if (((l + 1) & 1) == 0) phase_s5_setup(a, F, (l + 1) >> 1); __syncthreads(); }
        if ((l & 1) == 0) {
            if (l == 0) for (int rep = 0; rep < PROBE_S5; ++rep) phase_s5_tables(a, F, i);
            { pg8::GD g{(const bf16_t*)(ws + WS_HB), (const bf16_t*)(ws + WS_WEVIN), nullptr, 1024, 1024, EVEN_INP, MROWS / 256, EVEN_INP / 256, 0, 0, 0, 1, SSQp, SHWl, 0, (const void*)ws}; run_gemm(F, g, nullptr, nullptr, 0); }
            GSYNC();
            phase_krope(a, F);
            for (int j = 0; j < 3; ++j) {
                pg8::GD g;
                if (j == 0) g = pg8::GD{(const bf16_t*)(ws + WS_CQ), (const bf16_t*)(ws + WS_WUQ), (bf16_t*)(ws + WS_Q0), 256, 256, 768, MROWS / 256, 3, 0, 0, 0, 3, (const void*)(ws + WS_SSQQ), (const void*)ws, 0, (const void*)ws, (const void*)ws, (const void*)ws, 256};
                else if (j == 1) g = pg8::GD{(const bf16_t*)(ws + WS_CKV), (const bf16_t*)(ws + WS_WUKV), (bf16_t*)(ws + WS_KV0), 128, 128, 1024, MROWS / 256, 4, 0, 0, 0, 4, (const void*)(ws + WS_SSQKV), (const void*)ws, 0, (const void*)ws, (const void*)ws, (const void*)ws, 128};
                else g = pg8::GD{(const bf16_t*)(ws + WS_UX), (const bf16_t*)(ws + WS_BTA), (bf16_t*)(ws + WS_S), 768, 512, 256, 160, 1, 1, 256, 0, 0, (const void*)ws, (const void*)ws, 0, (const void*)ws, (const void*)ws, (const void*)ws, 0};
                run_gemm(F, g, nullptr, nullptr, 1 + j, (j == 0) ? 0 : (j == 1 ? 152 : 96));
            }
            GSYNC();
            phase_e2b(a, F);
            GSYNC();
            { pg8::GD g{(const bf16_t*)(ws + WS_UX), (const bf16_t*)(ws + WS_BTC), (bf16_t*)(ws + WS_G2), 768, 768, 512, 160, 2, 2, 512, 0, 6, nullptr, nullptr}; run_gemm(F, g, nullptr, nullptr, 4); }
#if PROBE_MLAFAKE
            phase_mla<PROBE_MLAFAKE>(a, F);
#endif
            for (int rep = 0; rep < PROBE_MLA; ++rep) phase_mla<0>(a, F);
            GSYNC();
            { pg8::GD g{(const bf16_t*)(ws + WS_G2), (const bf16_t*)(ws + WS_WGLU), (bf16_t*)(ws + WS_HB) + 512, 512, 512, 1024, MROWS / 256, 4, 0, 0, 0, 7, (const void*)(INP(a, 22) + i * 1024), (const void*)((const bf16_t*)(ws + WS_GATE) + 512), 0, nullptr, nullptr, nullptr, 1024}; run_gemm(F, g, nullptr, nullptr, 5); }
            GSYNC();
            { pg8::GD g{(const bf16_t*)(ws + WS_HB), (const bf16_t*)(ws + WS_WEVOUT), (bf16_t*)(ws + WS_Z) + 2048, 1024, 1024, 4096, MROWS / 256, 4, 0, 0, 0, 8, xol, xoc, 0, MODp, gnext, (void*)(ws + WS_SSQ), l}; run_gemm(F, g, OUTP(a), Xctx); }
            GSYNC();
        } else {
            for (int j = 0; j < 3; ++j) {
                pg8::GD g;
                if (j == 0) g = pg8::GD{(const bf16_t*)(ws + WS_Z) + 2048, (const bf16_t*)(ws + WS_WNAIN), (bf16_t*)(ws + WS_Z), 4096, 1024, 4096, MROWS / 256, 8, 0, 0, 0, 9, SSQp, SHWl, 0, (const void*)ws, (const void*)ws, (const void*)ws, 1024};
                else if (j == 1) g = pg8::GD{(const bf16_t*)(ws + WS_Z) + 2048, (const bf16_t*)(ws + WS_WNAIN) + (size_t)3072 * 1024, (bf16_t*)(ws + WS_Z) + 3072, 4096, 1024, 4096, MROWS / 256, 4, 0, 0, 0, 9, SSQp, SHWl + 3072, 0, (const void*)ws, (const void*)ws, (const void*)ws, 0};
                else g = pg8::GD{(const bf16_t*)(ws + WS_WNAIN) + (size_t)2048 * 1024, (const bf16_t*)(ws + WS_Z) + 2048, (bf16_t*)(ws + WS_VT), 1024, 1024, 1024, 4, MROWS / 256, 0, 0, 1, 10, SSQp, SHWl + 2048, 4096, (const void*)ws, (const void*)ws, (const void*)ws, 0};
                run_gemm(F, g, nullptr, nullptr, 7 + j, (j == 0) ? 0 : (j == 1 ? 64 : 96));
            }
            GSYNC();
            if (l == 1) for (int rep = 0; rep < PROBE_S5; ++rep) phase_s5_kt(a, F, 1);
#if PROBE_NAFAKE
            phase_na<PROBE_NAFAKE>(a, F, i, l < 3);
#endif
            for (int rep = 0; rep < PROBE_NA; ++rep) phase_na<0>(a, F, i, l < 3);
            GSYNC();
            if (l == 1) for (int rep = 0; rep < PROBE_S5; ++rep) phase_s5_tables(a, F, 1);
            { pg8::GD g{(const bf16_t*)(ws + WS_Z) + 2048, (const bf16_t*)(ws + WS_WNAOUT), (bf16_t*)(ws + WS_HB), 4096, 1024, 1024, (l < 3) ? MROWS / 256 : MLAT / 256, 4, 0, 0, 0, 8, xol, xoc, 0, MODp, gnext, (void*)(ws + WS_SSQ), l}; run_gemm(F, g, OUTP(a), Xctx); }
            GSYNC();
        }
    }
    phase_final(a, F);
}

extern "C" void kernel_launch(void* const* d_in, const int* in_sizes, int n_in, void* d_out, int out_size, void* d_ws, size_t ws_size, hipStream_t stream) {
    static int grid = 0;
    if (grid == 0) {
        if (n_in != 27 || ws_size < WS_END) { fprintf(stderr, "kernel_launch: unexpected n_in %d / ws_size %zu\n", n_in, ws_size); grid = -1; return; }
        int dev = 0, cus = 0, per_cu = 0;
        hipGetDevice(&dev);
        hipDeviceGetAttribute(&cus, hipDeviceAttributeMultiprocessorCount, dev);
        hipFuncSetAttribute((const void*)mega_fwd, hipFuncAttributeMaxDynamicSharedMemorySize, LDS_BYTES);
        hipOccupancyMaxActiveBlocksPerMultiprocessor(&per_cu, (const void*)mega_fwd, NTHR, LDS_BYTES);
        if (per_cu < 1) { fprintf(stderr, "kernel_launch: occupancy query says %d blocks per CU\n", per_cu); per_cu = 1; }
        grid = cus * 1;
        (void)hipGetLastError();
    }
    if (grid < 0) return;
    (void)hipMemsetAsync((char*)d_ws + WS_CTL, 0, 64 * 1024, stream);
    Args a{};
    for (int i = 0; i < 27; ++i) a.in[i] = (const float*)d_in[i];
    a.out = (float*)d_out; a.ws = (unsigned char*)d_ws;
    void* params[] = {&a};
    hipError_t e = hipLaunchCooperativeKernel((const void*)mega_fwd, dim3(grid), dim3(NTHR), params, LDS_BYTES, stream);
    if (e != hipSuccess) fprintf(stderr, "cooperative launch failed: %s (grid %d)\n", hipGetErrorString(e), grid);
}
```

```cpp
#include <hip/hip_runtime.h>
#include <hip/hip_cooperative_groups.h>
#include <cstdio>
#include <cstdint>
#include <cmath>
namespace cg = cooperative_groups;

#define LAS __attribute__((address_space(3)))
#define GASP __attribute__((address_space(1)))
template <class T> __device__ __forceinline__ T* gptr(const void* p) { return (T*)(GASP T*)(T*)p; }
typedef unsigned short bf16_t;
typedef short bf16x8 __attribute__((ext_vector_type(8)));
typedef float f32x4 __attribute__((ext_vector_type(4)));
typedef float f32x2 __attribute__((ext_vector_type(2)));
typedef unsigned u32x4 __attribute__((ext_vector_type(4)));
typedef unsigned u32x2 __attribute__((ext_vector_type(2)));

constexpr int DM = 1024, NB = 8, SEQ = 4096, CTXL = 256;
constexpr int MLAT = NB * SEQ, MCTX = NB * CTXL, MROWS = MLAT + MCTX;
constexpr int EVEN_IN = 1952, EVEN_INP = 2048;
constexpr int EV_S1 = 256, EV_S2 = 384, EV_S3 = 416, EV_S4 = 928, EV_S5 = 1440;
constexpr int NCH = 136, NCHP = 1280, NCHR = NB * NCH;
constexpr float EPS = 1e-6f;

constexpr size_t MiB = 1u << 20;
constexpr size_t WS_CTL = 0, WS_MOD = 1 * MiB, WS_BB = 2 * MiB + 256 * 1024, WS_POW = 3 * MiB, WS_KT = 5 * MiB, WS_BTA = 8 * MiB, WS_BTC = 16 * MiB;
constexpr size_t WS_WEVIN = 40 * MiB, WS_WUQ = 44 * MiB, WS_WUKV = 44 * MiB + 512 * 1024, WS_WGLU = 45 * MiB, WS_WEVOUT = 46 * MiB, WS_WNAIN = 48 * MiB, WS_WNAOUT = 56 * MiB;
constexpr size_t WS_XCTX = 58 * MiB, WS_HB = 66 * MiB, WS_Z = 134 * MiB;
constexpr size_t WS_GATE = 134 * MiB;
constexpr size_t WS_CQ = 202 * MiB, WS_CKV = 219 * MiB, WS_SSQQ = 228 * MiB, WS_SSQKV = 229 * MiB, WS_KR = 230 * MiB, WS_S = 233 * MiB;
constexpr size_t WS_UX = 289 * MiB, WS_Q0 = 350 * MiB, WS_KV0 = 402 * MiB;
constexpr size_t WS_G2 = 254 * MiB;
constexpr size_t WS_VT = 406 * MiB;
constexpr size_t WS_SSQ = 498 * MiB;
constexpr size_t WS_SHW = 501 * MiB;
constexpr size_t WS_END = 502 * MiB;

struct Args { const float* in[27]; float* out; unsigned char* ws; };
typedef const __attribute__((address_space(4))) Args* KArgs;
__device__ __forceinline__ KArgs klaunder(KArgs a) { asm volatile("" : "+s"(a)); return a; }
__device__ __forceinline__ unsigned char* WSP(KArgs a) { return (unsigned char*)(GASP unsigned char*)a->ws; }
__device__ __forceinline__ const float* INP(KArgs a, int k) { return (const float*)(GASP const float*)a->in[k]; }
__device__ __forceinline__ float* OUTP(KArgs a) { return (float*)(GASP float*)a->out; }

__device__ __forceinline__ float bf2f(bf16_t v) { return __uint_as_float(((unsigned)v) << 16); }
__device__ __forceinline__ unsigned f2bf(float f) { unsigned u = __float_as_uint(f); return (u + 0x7fffu + ((u >> 16) & 1u)) >> 16; }
__device__ __forceinline__ unsigned pk2(float lo, float hi) { return f2bf(lo) | (f2bf(hi) << 16); }
__device__ __forceinline__ float lo16(unsigned w) { return __uint_as_float(w << 16); }
__device__ __forceinline__ float hi16(unsigned w) { return __uint_as_float(w & 0xffff0000u); }
__device__ __forceinline__ float wave_sum(float v) {
#pragma unroll
    for (int o = 1; o < 64; o <<= 1) v += __shfl_xor(v, o);
    return v;
}
__device__ __forceinline__ float silu_f(float v) { return v / (1.f + expf(-v)); }
__device__ __forceinline__ float gelu_tanh_f(float v) { const float u = 0.7978845608028654f * (v + 0.044715f * v * v * v); return v * (1.f - __builtin_amdgcn_rcpf(1.f + __expf(2.f * u))); }

namespace pg8 {
constexpr int BM = 256, BK = 64, HALF = 128, HTB = HALF * BK * 2, STAGE_BYTES = 8 * HTB, NXCD = 8, WGM = 8;
__host__ __device__ __forceinline__ int lds_byte(int r, int c) { const int st = (r >> 4) * 2 + (c >> 5), rr = r & 15, cc = c & 31, ob = rr * 64 + cc * 2; return st * 1024 + (ob ^ (((ob >> 9) & 1) << 5)); }
__host__ __device__ __forceinline__ void stage_rc(int b, int& R, int& C) { const int st = b / 1024, sb = b % 1024, swz = sb ^ (((sb >> 9) & 1) << 5); R = (st >> 1) * 16 + swz / 64; C = (st & 1) * 32 + (swz % 64) / 2; }
__host__ __device__ __forceinline__ int perm32(int rho) { const int n = rho >> 4, i = rho & 15; return 8 * (i >> 2) + 4 * n + (i & 3); }

struct Unit { int pm, pn; };
struct GD { const bf16_t* A; const bf16_t* Bt; bf16_t* O; int lda, K, ldc, nM, nN, mode, split_cols, vtb, ek; const void* p1; const void* p2; int ldb; const void* p3; const void* p4; const void* p5; int i1; };

struct Sched {
    int nM, nN, nwg, G, c, mode;
    __device__ __forceinline__ void init(const GD& g, int G_, int c_) { nM = g.nM; nN = g.nN; mode = g.mode; nwg = (mode == 0) ? nM * nN : (mode == 1 ? 160 : 320); G = G_; c = c_; }
    __device__ __forceinline__ bool next(int i, Unit& u) const {
        const long L = (long)i * G + c; if (L >= nwg) return false;
        int wgid = (int)L;
        if (mode == 1) { u.pm = wgid; u.pn = wgid / 5; return true; }
        if (mode == 2) { const int g = wgid / 10, rem = wgid % 10; u.pm = g * 5 + (rem >> 1); u.pn = 2 * g + (rem & 1); return true; }
        { const int q = nwg / NXCD, r = nwg % NXCD, xcd = wgid % NXCD, off = wgid / NXCD; wgid = (xcd < r ? xcd * (q + 1) : r * (q + 1) + (xcd - r) * q) + off; }
        const int nig = WGM * nN, gid = wgid / nig, fm = gid * WGM, gsz = (nM - fm) < WGM ? (nM - fm) : WGM;
        u.pm = fm + ((wgid % nig) % gsz); u.pn = (wgid % nig) / gsz; return true;
    }
};

__device__ __forceinline__ unsigned cvt_pk_bf16(float lo, float hi) { unsigned r; asm volatile("v_cvt_pk_bf16_f32 %0, %1, %2" : "=v"(r) : "v"(lo), "v"(hi)); return r; }

struct EpiBf16 {
    static constexpr bool PERM = true;
    bf16_t* O_; int ldc; int split_cols; int vtb; int ek; const void* p1; const void* p2; const void* p3; const void* p4; const void* p5; int i1; void* xl_; void* xc_;
    __device__ __forceinline__ void operator()(const f32x4 (&acc)[2][2][4][2], const Unit& u, int wr, int wc, int fr, int fq) const {
        bf16_t* const O = gptr<bf16_t>(this->O_);
        if (ek == 99) {
            f32x4 s = {0.f, 0.f, 0.f, 0.f};
#pragma unroll
            for (int ai = 0; ai < 2; ++ai)
#pragma unroll
                for (int bj = 0; bj < 2; ++bj)
#pragma unroll
                    for (int m = 0; m < 4; ++m) s += acc[ai][bj][m][0] + acc[ai][bj][m][1];
            if (s[0] + s[1] + s[2] + s[3] == 12345.678f) ((float*)p5)[0] = s[0];
            return; }
        const int row0 = u.pm * BM + wr * 64 + fr; int colt = u.pn * BM;
        if (ek == 6) {
            const int g = u.pn >> 1, cl0 = (u.pn & 1) * BM + wc * 32 + 8 * fq;
#pragma unroll
            for (int ai = 0; ai < 2; ++ai)
#pragma unroll
                for (int m = 0; m < 4; ++m) { const int R = row0 + ai * HALF + m * 16 - g * NCHP;
                    if (R < NCHR) { const int b = R / NCH, cc = R - b * NCH; const int tok0 = (cc < 8) ? MLAT + b * 256 + cc * 32 : b * 4096 + (cc - 8) * 32;
#pragma unroll
                        for (int bj = 0; bj < 2; ++bj) { const int cl = cl0 + bj * HALF, t = cl >> 4, h0 = cl & 15; const f32x4 v0 = acc[ai][bj][m][0], v1 = acc[ai][bj][m][1];
                            u32x4 w; w.x = cvt_pk_bf16(gelu_tanh_f(v0[0]), gelu_tanh_f(v0[1])); w.y = cvt_pk_bf16(gelu_tanh_f(v0[2]), gelu_tanh_f(v0[3]));
                            w.z = cvt_pk_bf16(gelu_tanh_f(v1[0]), gelu_tanh_f(v1[1])); w.w = cvt_pk_bf16(gelu_tanh_f(v1[2]), gelu_tanh_f(v1[3]));
                            *(u32x4*)(O + (size_t)(tok0 + t) * 512 + 16 * g + h0) = w; } } }
            return;
        }
        if (ek == 7) {
            const float* bias = gptr<const float>(p1); const bf16_t* zg = gptr<const bf16_t>(p2);
            const int ch0 = u.pn * HALF + wc * 32 + 8 * fq;
            const f32x4 ba0 = *(const f32x4*)(bias + ch0), ba1 = *(const f32x4*)(bias + ch0 + 4), bg0 = *(const f32x4*)(bias + 512 + ch0), bg1 = *(const f32x4*)(bias + 512 + ch0 + 4);
            u32x4 wzv[2][4];
#pragma unroll
            for (int ai = 0; ai < 2; ++ai)
#pragma unroll
                for (int m = 0; m < 4; ++m) wzv[ai][m] = *(const u32x4*)(zg + (size_t)(row0 + ai * HALF + m * 16) * (size_t)i1 + ch0);
#pragma unroll
            for (int ai = 0; ai < 2; ++ai)
#pragma unroll
                for (int m = 0; m < 4; ++m) { const size_t row = (size_t)(row0 + ai * HALF + m * 16);
                    const u32x4 wz = wzv[ai][m];
                    const f32x4 a0 = acc[ai][0][m][0] + ba0, a1 = acc[ai][0][m][1] + ba1, g0 = acc[ai][1][m][0] + bg0, g1 = acc[ai][1][m][1] + bg1;
#define GLX(av, gv, zv) ((av) * __builtin_amdgcn_rcpf(1.f + __expf(-(gv))) * silu_f(zv))
                    u32x4 w; w.x = cvt_pk_bf16(GLX(a0[0], g0[0], lo16(wz.x)), GLX(a0[1], g0[1], hi16(wz.x))); w.y = cvt_pk_bf16(GLX(a0[2], g0[2], lo16(wz.y)), GLX(a0[3], g0[3], hi16(wz.y)));
                    w.z = cvt_pk_bf16(GLX(a1[0], g1[0], lo16(wz.z)), GLX(a1[1], g1[1], hi16(wz.z))); w.w = cvt_pk_bf16(GLX(a1[2], g1[2], lo16(wz.w)), GLX(a1[3], g1[3], hi16(wz.w)));
#undef GLX
                    *(u32x4*)(O + row * ldc + ch0) = w; }
            return;
        }
        if (ek == 1) {
            unsigned char* wsb = gptr<unsigned char>(p3);
            bf16_t* CQ = (bf16_t*)(wsb + WS_CQ); bf16_t* CKV = (bf16_t*)(wsb + WS_CKV); bf16_t* KRo = (bf16_t*)(wsb + WS_KR); bf16_t* GATE = (bf16_t*)(wsb + WS_GATE); bf16_t* UXo = (bf16_t*)(wsb + WS_UX);
            float* SSQQ = (float*)(wsb + WS_SSQQ); float* SSQKV = (float*)(wsb + WS_SSQKV);
            const int bi = (u.pm < 128) ? (u.pm >> 4) : 8;
            const float* ssq = gptr<const float>(p1);
            f32x4 sw[2][2];
#pragma unroll
            for (int bj = 0; bj < 2; ++bj) { const float* shw = gptr<const float>(p2) + (size_t)bi * 4096 + colt + bj * HALF + wc * 32 + 8 * fq; sw[bj][0] = *(const f32x4*)shw; sw[bj][1] = *(const f32x4*)(shw + 4); }
#pragma unroll
            for (int ai = 0; ai < 2; ++ai) {
                float rsv[4];
#pragma unroll
                for (int m = 0; m < 4; ++m) { const f32x4 s0 = *((const f32x4*)(ssq + (size_t)(row0 + ai * HALF + m * 16) * 16) + fq);
                    float tot = (s0[0] + s0[1]) + (s0[2] + s0[3]); tot += __shfl_xor(tot, 16); tot += __shfl_xor(tot, 32);
                    rsv[m] = 1.0f / sqrtf(tot * (1.f / 1024.f) + EPS); }
#pragma unroll
                for (int m = 0; m < 4; ++m) { const int row = row0 + ai * HALF + m * 16;
                    const float rs = rsv[m];
                    float ss = 0.f;
#pragma unroll
                    for (int bj = 0; bj < 2; ++bj) { const int cw = colt + bj * HALF + wc * 32, c0 = cw + 8 * fq;
                        const f32x4 v0 = acc[ai][bj][m][0] * rs + sw[bj][0], v1 = acc[ai][bj][m][1] * rs + sw[bj][1];
                        u32x4 w; w.x = cvt_pk_bf16(v0[0], v0[1]); w.y = cvt_pk_bf16(v0[2], v0[3]); w.z = cvt_pk_bf16(v1[0], v1[1]); w.w = cvt_pk_bf16(v1[2], v1[3]);
                        if (cw < EV_S1) { *(u32x4*)(CQ + (size_t)row * 256 + c0) = w; ss += (v0[0] * v0[0] + v0[1] * v0[1]) + (v0[2] * v0[2] + v0[3] * v0[3]) + (v1[0] * v1[0] + v1[1] * v1[1]) + (v1[2] * v1[2] + v1[3] * v1[3]); }
                        else if (cw < EV_S2) { *(u32x4*)(CKV + (size_t)row * 128 + (c0 - EV_S1)) = w; ss += (v0[0] * v0[0] + v0[1] * v0[1]) + (v0[2] * v0[2] + v0[3] * v0[3]) + (v1[0] * v1[0] + v1[1] * v1[1]) + (v1[2] * v1[2] + v1[3] * v1[3]); }
                        else if (cw < EV_S3) *(u32x4*)(KRo + (size_t)row * 32 + (c0 - EV_S2)) = w;
                        else if (cw < EV_S4) *(u32x4*)(GATE + (size_t)row * 1024 + (c0 - EV_S3)) = w;
                        else if (cw < EV_S5) { const int ch = c0 - EV_S4; int R, s;
                            if (row < MLAT) { const int b = row >> 12, t = row & 4095; R = b * NCH + 8 + (t >> 5); s = t & 31; } else { const int r = row - MLAT, b = r >> 8, t = r & 255; R = b * NCH + (t >> 5); s = t & 31; }
                            *(u32x4*)(UXo + ((size_t)((ch >> 4) * NCHP + R)) * 768 + s * 16 + (ch & 15)) = w; }
                        else if (cw < EVEN_IN) *(u32x4*)(GATE + (size_t)row * 1024 + 512 + (c0 - EV_S5)) = w;
                    }
                    if (u.pn <= 1) { ss += __shfl_xor(ss, 16); ss += __shfl_xor(ss, 32);
                        if (fq == 0) { if (u.pn == 0) SSQQ[(size_t)row * 4 + wc] = ss; else SSQKV[(size_t)row * 4 + wc] = ss; } }
                    asm volatile("" ::: "memory");
                }
            }
            return;
        }
        if (ek == 3 || ek == 4) {
            const float* ssp = gptr<const float>(p1); const float invw = 1.0f / (float)i1;
            const int c00 = colt + wc * 32 + 8 * fq;
            float rstdv[2][4];
#pragma unroll
            for (int ai = 0; ai < 2; ++ai)
#pragma unroll
                for (int m = 0; m < 4; ++m) { const f32x4 s4 = *(const f32x4*)(ssp + (size_t)(row0 + ai * HALF + m * 16) * 4);
                    rstdv[ai][m] = ((ek == 3) ? 0.14724444f : 1.0f) / sqrtf(((s4[0] + s4[1]) + (s4[2] + s4[3])) * invw + EPS); }
#pragma unroll
            for (int ai = 0; ai < 2; ++ai)
#pragma unroll
                for (int m = 0; m < 4; ++m) { const int row = row0 + ai * HALF + m * 16;
                    const float rstd = rstdv[ai][m];
                    const bool lat = row < MLAT; const int t = row & 4095;
#pragma unroll
                    for (int bj = 0; bj < 2; ++bj) { const int c0 = c00 + bj * HALF; f32x4 v0 = acc[ai][bj][m][0] * rstd, v1 = acc[ai][bj][m][1] * rstd;
                        if (ek == 3) { const int d0 = c0 % 96; const bool rope = lat && (d0 >= 64); const int r0 = d0 - 64;
                            float vv[8] = {v0[0], v0[1], v0[2], v0[3], v1[0], v1[1], v1[2], v1[3]}, pv[8];
#pragma unroll
                            for (int e = 0; e < 8; ++e) pv[e] = __shfl_xor(vv[e], 16);
                            if (rope) { const float pos = (float)((r0 >> 4) ? (t & 63) : (t >> 6)); const bool hf = (r0 >> 3) & 1;
#pragma unroll
                                for (int e = 0; e < 8; ++e) { const float ang = pos * exp2f(-(float)e * (13.287712379549449f / 8.f)); const float sn = __sinf(ang), cs = __cosf(ang);
                                    vv[e] = hf ? (vv[e] * cs + pv[e] * sn) : (vv[e] * cs - pv[e] * sn); }
                                v0 = (f32x4){vv[0], vv[1], vv[2], vv[3]}; v1 = (f32x4){vv[4], vv[5], vv[6], vv[7]}; } }
                        u32x4 w; w.x = cvt_pk_bf16(v0[0], v0[1]); w.y = cvt_pk_bf16(v0[2], v0[3]); w.z = cvt_pk_bf16(v1[0], v1[1]); w.w = cvt_pk_bf16(v1[2], v1[3]);
                        *(u32x4*)(O + (size_t)row * ldc + c0) = w; } }
            return;
        }
        if (ek == 8) {
            const int l = i1 & 7; float* Xl = gptr<float>(xl_); float* Xc = gptr<float>(xc_); const float* xol_ = gptr<const float>(p1); const float* xoc_ = gptr<const float>(p2);
            const int bi = (u.pm < 128) ? (u.pm >> 4) : 8;
            const float* modl = gptr<const float>(p3) + (size_t)(l * 9 + bi) * 3072; const float* modn = gptr<const float>(p3) + (size_t)((l + 1) * 9 + bi) * 3072;
            const float* gam = p4 ? gptr<const float>(p4) : nullptr; float* ssq = gptr<float>(p5);
            const int c0 = u.pn * BM + wc * 32 + 8 * fq;
            f32x4 gt[2][2], gm[2][2];
#pragma unroll
            for (int bj = 0; bj < 2; ++bj)
#pragma unroll
                for (int n = 0; n < 2; ++n) { const int c = c0 + bj * HALF + 4 * n; gt[bj][n] = *(const f32x4*)(modl + 2048 + c);
                    if (gam) { const f32x4 g4 = *(const f32x4*)(gam + c), s4 = *(const f32x4*)(modn + 1024 + c); gm[bj][n] = g4 * (s4 + 1.0f); } else gm[bj][n] = (f32x4){0.f, 0.f, 0.f, 0.f}; }
#pragma unroll
            for (int ai = 0; ai < 2; ++ai)
#pragma unroll
              for (int mh = 0; mh < 2; ++mh) {
                f32x4 xpre[2][2][2];
#pragma unroll
                for (int mm = 0; mm < 2; ++mm) { const int row = row0 + ai * HALF + (2 * mh + mm) * 16; const bool lat = row < MLAT;
                    const float* xo = (lat ? xol_ : xoc_) + (lat ? (size_t)row * 1024 : (size_t)(row - MLAT) * 1024);
#pragma unroll
                    for (int bj = 0; bj < 2; ++bj)
#pragma unroll
                        for (int n = 0; n < 2; ++n) xpre[mm][bj][n] = *(const f32x4*)(xo + c0 + bj * HALF + 4 * n); }
#pragma unroll
                for (int mm = 0; mm < 2; ++mm) { const int m = 2 * mh + mm; const int row = row0 + ai * HALF + m * 16; const bool lat = row < MLAT;
                    const size_t ro = lat ? (size_t)row * 1024 : (size_t)(row - MLAT) * 1024;
                    float* xw = (lat ? Xl : Xc) + ro;
                    float ss = 0.f;
#pragma unroll
                    for (int bj = 0; bj < 2; ++bj) { f32x4 xn[2];
#pragma unroll
                        for (int n = 0; n < 2; ++n) { const int c = c0 + bj * HALF + 4 * n; const f32x4 xv = xpre[mm][bj][n]; xn[n] = xv + gt[bj][n] * acc[ai][bj][m][n];
                            *(f32x4*)(xw + c) = xn[n]; ss += (xn[n][0] * xn[n][0] + xn[n][1] * xn[n][1]) + (xn[n][2] * xn[n][2] + xn[n][3] * xn[n][3]); }
                        if (gam) { const f32x4 a0 = xn[0] * gm[bj][0], a1 = xn[1] * gm[bj][1];
                            u32x4 w; w.x = cvt_pk_bf16(a0[0], a0[1]); w.y = cvt_pk_bf16(a0[2], a0[3]); w.z = cvt_pk_bf16(a1[0], a1[1]); w.w = cvt_pk_bf16(a1[2], a1[3]);
                            *(u32x4*)(O + (size_t)row * ldc + c0 + bj * HALF) = w; } }
                    ss += __shfl_xor(ss, 16); ss += __shfl_xor(ss, 32);
                    if (fq == 0) ssq[(size_t)row * 16 + u.pn * 4 + wc] = ss; }
            }
            return;
        }
        if (split_cols) { const int t = colt / split_cols; colt -= t * split_cols; }
        const int col0 = colt + wc * 32 + 8 * fq;
        if (ek == 9) {
            const int bi = (u.pm < 128) ? (u.pm >> 4) : 8;
            const float* shw = (const float*)p2 + (size_t)bi * 4096 + col0; const float* ssq = gptr<const float>(p1);
            f32x4 sw[2][2];
#pragma unroll
            for (int bj = 0; bj < 2; ++bj) { sw[bj][0] = *(const f32x4*)(shw + bj * HALF); sw[bj][1] = *(const f32x4*)(shw + bj * HALF + 4); }
            float rsv[2][4];
#pragma unroll
            for (int ai = 0; ai < 2; ++ai)
#pragma unroll
                for (int m = 0; m < 4; ++m) { const f32x4 s0 = *((const f32x4*)(ssq + (size_t)(row0 + ai * HALF + m * 16) * 16) + fq);
                    float tot = (s0[0] + s0[1]) + (s0[2] + s0[3]); tot += __shfl_xor(tot, 16); tot += __shfl_xor(tot, 32);
                    rsv[ai][m] = 1.0f / sqrtf(tot * (1.f / 1024.f) + EPS); }
#pragma unroll
            for (int ai = 0; ai < 2; ++ai)
#pragma unroll
                for (int m = 0; m < 4; ++m) { const int row = row0 + ai * HALF + m * 16;
                    const float rs = rsv[ai][m];
                    bf16_t* rowp = O + (size_t)row * ldc + col0;
#pragma unroll
                    for (int bj = 0; bj < 2; ++bj) { f32x4 v0 = acc[ai][bj][m][0] * rs + sw[bj][0], v1 = acc[ai][bj][m][1] * rs + sw[bj][1];
                        if (colt < i1) { v0 *= 0.18033688f; v1 *= 0.18033688f; }
                        u32x4 w; w.x = cvt_pk_bf16(v0[0], v0[1]); w.y = cvt_pk_bf16(v0[2], v0[3]); w.z = cvt_pk_bf16(v1[0], v1[1]); w.w = cvt_pk_bf16(v1[2], v1[3]);
                        *(u32x4*)(rowp + bj * HALF) = w; } }
            return;
        }
        if (ek == 10) {
            const int bi = (u.pn < 128) ? (u.pn >> 4) : 8;
            const float* shw = (const float*)p2 + (size_t)bi * 4096; const float* ssq = gptr<const float>(p1);
            f32x4 rs4[2][2];
#pragma unroll
            for (int bj = 0; bj < 2; ++bj)
#pragma unroll
                for (int n = 0; n < 2; ++n)
#pragma unroll
                    for (int j = 0; j < 4; ++j) { const f32x4* sp = (const f32x4*)(ssq + (size_t)(col0 + bj * HALF + 4 * n + j) * 16); const f32x4 s0 = sp[0], s1 = sp[1], s2 = sp[2], s3 = sp[3];
                        const float tot = ((s0[0] + s0[1]) + (s0[2] + s0[3])) + ((s1[0] + s1[1]) + (s1[2] + s1[3])) + ((s2[0] + s2[1]) + (s2[2] + s2[3])) + ((s3[0] + s3[1]) + (s3[2] + s3[3]));
                        rs4[bj][n][j] = 1.0f / sqrtf(tot * (1.f / 1024.f) + EPS); }
            float shv[2][4];
#pragma unroll
            for (int ai = 0; ai < 2; ++ai)
#pragma unroll
                for (int m = 0; m < 4; ++m) shv[ai][m] = shw[row0 + ai * HALF + m * 16];
#pragma unroll
            for (int ai = 0; ai < 2; ++ai)
#pragma unroll
                for (int m = 0; m < 4; ++m) { const int row = row0 + ai * HALF + m * 16; const float sh = shv[ai][m];
#pragma unroll
                    for (int bj = 0; bj < 2; ++bj) { const f32x4 v0 = acc[ai][bj][m][0] * rs4[bj][0] + sh, v1 = acc[ai][bj][m][1] * rs4[bj][1] + sh;
                        u32x4 w; w.x = cvt_pk_bf16(v0[0], v0[1]); w.y = cvt_pk_bf16(v0[2], v0[3]); w.z = cvt_pk_bf16(v1[0], v1[1]); w.w = cvt_pk_bf16(v1[2], v1[3]);
                        *(u32x4*)(O + ((size_t)((col0 + bj * HALF) >> 3) * ldc + row) * 8) = w; } }
            return;
        }
#pragma unroll
        for (int ai = 0; ai < 2; ++ai)
#pragma unroll
            for (int m = 0; m < 4; ++m) { bf16_t* rowp = O + (size_t)(row0 + ai * HALF + m * 16) * ldc + col0;
#pragma unroll
                for (int bj = 0; bj < 2; ++bj) { const f32x4 v0 = acc[ai][bj][m][0], v1 = acc[ai][bj][m][1];
                    u32x4 w; w.x = cvt_pk_bf16(v0[0], v0[1]); w.y = cvt_pk_bf16(v0[2], v0[3]); w.z = cvt_pk_bf16(v1[0], v1[1]); w.w = cvt_pk_bf16(v1[2], v1[3]);
                    if (vtb) *(u32x4*)(O + ((size_t)((col0 + bj * HALF) >> 3) * ldc + (row0 + ai * HALF + m * 16)) * 8) = w;
                    else *(u32x4*)(rowp + bj * HALF) = w; } }
    }
};

template <class Epi>
__device__ __forceinline__ void gemm_phase(LAS unsigned char* lds, const GD g, const Sched& S, const Epi& E) {
    int tid_ = threadIdx.x; asm volatile("" : "+v"(tid_));
    const int tid = tid_, wid = __builtin_amdgcn_readfirstlane(tid >> 6), lane = tid & 63, wr = wid >> 2, wc = wid & 3, fr = lane & 15, fq = lane >> 4;
    const int K = g.K, nt = K / BK, lda = g.lda, ldb = g.ldb ? g.ldb : g.K;
    unsigned voffA[2], voffB[2];
#pragma unroll
    for (int i = 0; i < 2; ++i) { int R, C; stage_rc(tid * 16 + i * 8192, R, C); const int Rb = Epi::PERM ? ((R & ~31) + perm32(R & 31)) : R;
        voffA[i] = (unsigned)(R * lda + C) * 2u; voffB[i] = (unsigned)(Rb * ldb + C) * 2u; }
    const size_t kstep = (size_t)(BK * 2);
    const size_t hstepA = (size_t)HALF * lda * 2, hstepB = (size_t)HALF * ldb * 2;
    const size_t tstepA = 2 * hstepA, tstepB = 2 * hstepB;
    const unsigned ldsw = (unsigned)wid * 1024u;
    const int aoff = lds_byte(wr * 64 + fr, fq * 8), boff = lds_byte(wc * 32 + fr, fq * 8);
#define PG8_SA(b, h) (((b) * 2 + (h)) * HTB)
#define PG8_SB(b, h) ((4 + (b) * 2 + (h)) * HTB)
#define PG8_STAGE(bufoff, gbase, voff) do { _Pragma("unroll") for (int _i = 0; _i < 2; ++_i) \
        __builtin_amdgcn_global_load_lds((const unsigned*)((const char*)(gbase) + (voff)[_i]), (LAS unsigned*)(lds + (bufoff) + ldsw + _i * 8192), 16, 0, 0); } while (0)
#define PG8_LDA(dst, b, h) do { _Pragma("unroll") for (int m = 0; m < 4; ++m) _Pragma("unroll") for (int k = 0; k < 2; ++k) dst[m][k] = *(const LAS bf16x8*)(lds + PG8_SA(b, h) + aoff + m * 2048 + k * 1024); } while (0)
#define PG8_LDB(dst, b, h) do { _Pragma("unroll") for (int n = 0; n < 2; ++n) _Pragma("unroll") for (int k = 0; k < 2; ++k) dst[n][k] = *(const LAS bf16x8*)(lds + PG8_SB(b, h) + boff + n * 2048 + k * 1024); } while (0)
#define PG8_MMA(ai, bj, At, Bt) do { __builtin_amdgcn_s_setprio(1); _Pragma("unroll") for (int m = 0; m < 4; ++m) _Pragma("unroll") for (int n = 0; n < 2; ++n) _Pragma("unroll") for (int k = 0; k < 2; ++k) \
        acc[ai][bj][m][n] = __builtin_amdgcn_mfma_f32_16x16x32_bf16(Bt[n][k], At[m][k], acc[ai][bj][m][n], 0, 0, 0); __builtin_amdgcn_s_setprio(0); } while (0)
#define PG8_WAIT_V(n) asm volatile("s_waitcnt vmcnt(" #n ")" ::: "memory")
#define PG8_WAIT_L(n) asm volatile("s_waitcnt lgkmcnt(" #n ")" ::: "memory")
#define PG8_BAR __builtin_amdgcn_s_barrier()
#define PG8_SCHED __builtin_amdgcn_sched_barrier(0)
    Unit cur, nxt; int ui = 0;
    if (!S.next(0, cur)) return;
    f32x4 acc[2][2][4][2];
#pragma unroll
    for (int a = 0; a < 2; ++a)
#pragma unroll
        for (int b = 0; b < 2; ++b)
#pragma unroll
            for (int m = 0; m < 4; ++m)
#pragma unroll
                for (int n = 0; n < 2; ++n) acc[a][b][m][n] = (f32x4){0.f, 0.f, 0.f, 0.f};
    bf16x8 At[4][2], B0[2][2], B1[2][2];
    const char* cA = (const char*)g.A + (size_t)cur.pm * tstepA; const char* cB = (const char*)g.Bt + (size_t)cur.pn * tstepB;
    PG8_STAGE(PG8_SB(0, 0), cB, voffB); PG8_STAGE(PG8_SB(0, 1), cB + hstepB, voffB); PG8_STAGE(PG8_SA(0, 0), cA, voffA); PG8_STAGE(PG8_SA(0, 1), cA + hstepA, voffA);
    if (wr == 1) PG8_BAR;
    PG8_WAIT_V(2); PG8_BAR;
    PG8_STAGE(PG8_SB(1, 0), cB + kstep, voffB); PG8_STAGE(PG8_SA(1, 0), cA + kstep, voffA); PG8_STAGE(PG8_SB(1, 1), cB + hstepB + kstep, voffB);
    PG8_WAIT_V(6); PG8_BAR;
    for (;;) {
        const bool has_next = S.next(ui + 1, nxt);
        const char* nA = has_next ? (const char*)g.A + (size_t)nxt.pm * tstepA : cA; const char* nB = has_next ? (const char*)g.Bt + (size_t)nxt.pn * tstepB : cB;
        for (int t = 0; t < nt; t += 2) {
            const bool last = (t == nt - 2);
            const char* a1 = cA + (size_t)(t + 1) * kstep;
            const char* a2 = last ? nA : cA + (size_t)(t + 2) * kstep; const char* b2 = last ? nB : cB + (size_t)(t + 2) * kstep;
            const char* a3 = a2 + kstep; const char* b3 = b2 + kstep;
            PG8_LDB(B0, 0, 0); PG8_LDB(B1, 0, 1); PG8_SCHED; PG8_LDA(At, 0, 0); PG8_STAGE(PG8_SA(1, 1), a1 + hstepA, voffA);
            PG8_WAIT_V(8); PG8_WAIT_L(0); PG8_BAR; PG8_MMA(0, 0, At, B0); PG8_MMA(0, 1, At, B1); PG8_BAR; PG8_SCHED;
            PG8_LDA(At, 0, 1); PG8_STAGE(PG8_SB(0, 0), b2, voffB); PG8_STAGE(PG8_SB(0, 1), b2 + hstepB, voffB); PG8_STAGE(PG8_SA(0, 0), a2, voffA);
            PG8_WAIT_V(8); PG8_WAIT_L(0); PG8_BAR; PG8_MMA(1, 0, At, B0); PG8_MMA(1, 1, At, B1); PG8_BAR; PG8_SCHED;
            PG8_LDB(B0, 1, 0); PG8_LDB(B1, 1, 1); PG8_SCHED; PG8_LDA(At, 1, 0); PG8_STAGE(PG8_SA(0, 1), a2 + hstepA, voffA);
            PG8_WAIT_V(8); PG8_WAIT_L(0); PG8_BAR; PG8_MMA(0, 0, At, B0); PG8_MMA(0, 1, At, B1); PG8_BAR; PG8_SCHED;
            PG8_LDA(At, 1, 1); PG8_STAGE(PG8_SB(1, 0), b3, voffB); PG8_STAGE(PG8_SB(1, 1), b3 + hstepB, voffB); PG8_STAGE(PG8_SA(1, 0), a3, voffA);
            PG8_WAIT_V(8); PG8_WAIT_L(0); PG8_BAR; PG8_MMA(1, 0, At, B0); PG8_MMA(1, 1, At, B1); PG8_BAR; PG8_SCHED;
        }
        if (wr == 0) PG8_BAR;
        E(acc, cur, wr, wc, fr, fq);
        if (!has_next) break;
#pragma unroll
        for (int a = 0; a < 2; ++a)
#pragma unroll
            for (int b = 0; b < 2; ++b)
#pragma unroll
                for (int m = 0; m < 4; ++m)
#pragma unroll
                    for (int n = 0; n < 2; ++n) acc[a][b][m][n] = (f32x4){0.f, 0.f, 0.f, 0.f};
        cur = nxt; cA = nA; cB = nB; ++ui;
        if (wr == 1) PG8_BAR;
    }
    PG8_WAIT_V(0);
    PG8_BAR;
#undef PG8_SA
#undef PG8_SB
#undef PG8_STAGE
#undef PG8_LDA
#undef PG8_LDB
#undef PG8_MMA
#undef PG8_WAIT_V
#undef PG8_WAIT_L
#undef PG8_BAR
#undef PG8_SCHED
}
}

#define XB_TMO      128
#define XB_XCNT(j)  (256  + 64 * (j))
#define XB_XSUB(j)  (1280 + 64 * (j))
#define XB_XGEN(j)  (2304 + 64 * (j))
#define XB_TOP      3328
#define XB_TOPGEN   3392
#define XCD_BAR_WORDS 3456
#define XB_SPIN_CAP (1u << 22)
__device__ __forceinline__ unsigned xb_ld(unsigned* p)              { return __hip_atomic_load(p, __ATOMIC_RELAXED, __HIP_MEMORY_SCOPE_AGENT); }
__device__ __forceinline__ unsigned xb_add(unsigned* p, unsigned v) { return __hip_atomic_fetch_add(p, v, __ATOMIC_RELAXED, __HIP_MEMORY_SCOPE_AGENT); }
__device__ __forceinline__ unsigned xb_xcc_id() { return (unsigned)__builtin_amdgcn_s_getreg((3 << 11) | 20) & 0xFu; }
#define XB_SPIN(cond, bar) do { unsigned _sp = 0; while (cond) { __builtin_amdgcn_s_sleep(1); \
    if ((++_sp & 255u) == 0u) { if (xb_ld(&(bar)[XB_TMO])) break; if (_sp > XB_SPIN_CAP) { atomicAdd(&(bar)[XB_TMO], 1u); break; } } } } while (0)
struct XcdBarrier { unsigned* bar; unsigned x; volatile LAS unsigned* st; };
__device__ __forceinline__ XcdBarrier xcd_barrier_post(unsigned* bar, volatile LAS unsigned* st) {
    XcdBarrier b; b.bar = bar; b.x = xb_xcc_id(); b.st = st;
    if (threadIdx.x == 0) (void)xb_add(&bar[XB_XCNT(b.x)], 1u);
    return b;
}
__device__ __forceinline__ void xcd_barrier_complete(unsigned* bar, unsigned x, unsigned& nloc, unsigned& nx) {
    const unsigned G = gridDim.x * gridDim.y * gridDim.z;
    unsigned sum, cnt, mine, sp = 0u;
    for (;;) {
        sum = 0u; cnt = 0u; mine = 0u;
#pragma unroll
        for (unsigned j = 0; j < 16; ++j) { const unsigned c = xb_ld(&bar[XB_XCNT(j)]); sum += c; cnt += (c > 0u) ? 1u : 0u; mine = (j == x) ? c : mine; }
        if (sum == G) break;
        __builtin_amdgcn_s_sleep(1);
        if ((++sp & 255u) == 0u) { if (xb_ld(&bar[XB_TMO])) break; if (sp > XB_SPIN_CAP) { atomicAdd(&bar[XB_TMO], 1u); break; } }
    }
    nloc = mine > 0u ? mine : 1u; nx = cnt > 0u ? cnt : 1u;
}
__device__ __forceinline__ void xcd_barrier(const XcdBarrier& b) {
    asm volatile("s_waitcnt vmcnt(0)" ::: "memory");
    __syncthreads();
    if (threadIdx.x == 0) {
        unsigned* bar = b.bar;
        __builtin_amdgcn_s_waitcnt(0);
        unsigned nloc = b.st[0], nx = b.st[1];
        if (nloc == 0u) { xcd_barrier_complete(bar, b.x, nloc, nx); b.st[0] = nloc; b.st[1] = nx; }
        const unsigned old = xb_add(&bar[XB_XSUB(b.x)], 1u);
        const unsigned gen = old / nloc;
        if (old + 1u == (gen + 1u) * nloc) {
            __builtin_amdgcn_fence(__ATOMIC_RELEASE, "agent");
            asm volatile("s_waitcnt vmcnt(0)" ::: "memory");
            const unsigned og = xb_add(&bar[XB_TOP], 1u);
            const unsigned tg = og / nx;
            if (og + 1u == (tg + 1u) * nx) xb_add(&bar[XB_TOPGEN], 1u);
            else XB_SPIN(xb_ld(&bar[XB_TOPGEN]) == tg, bar);
            __builtin_amdgcn_fence(__ATOMIC_ACQUIRE, "agent");
            xb_add(&bar[XB_XGEN(b.x)], 1u);
            asm volatile("s_waitcnt vmcnt(0)" ::: "memory");
        } else {
            XB_SPIN(xb_ld(&bar[XB_XGEN(b.x)]) == gen, bar);
            __builtin_amdgcn_fence(__ATOMIC_ACQUIRE, "agent");
            asm volatile("s_waitcnt vmcnt(0)" ::: "memory");
        }
    }
    __syncthreads();
}

#ifndef PROBE_NOEPI
#define PROBE_NOEPI 0
#endif
#ifndef PROBE_SITES
#define PROBE_SITES 0
#endif
#ifndef PROBE_PRO
#define PROBE_PRO 1
#endif
#ifndef PROBE_WGT
#define PROBE_WGT 1
#endif
#ifndef PROBE_NAFAKE
#define PROBE_NAFAKE 0
#endif
#ifndef MLA_V2
#define MLA_V2 1
#endif
#ifndef PROBE_MLAFAKE
#define PROBE_MLAFAKE 0
#endif
#ifndef PROBE_MLA
#define PROBE_MLA 1
#endif
#ifndef PROBE_NA
#define PROBE_NA 1
#endif
#ifndef PROBE_EW
#define PROBE_EW 1
#endif
#ifndef PROBE_S5
#define PROBE_S5 1
#endif
#ifndef PROBE_CARRY
#define PROBE_CARRY 1
#endif
constexpr int NWAVES = 8, NTHR = 512;
constexpr int LDS_BYTES = 147456;
struct Fr {
    LAS unsigned char* lds; int tid, lane, wave, gw, NGW, gt, NGT;
};
__device__ __forceinline__ Fr launder(Fr F) { asm volatile("" : "+v"(F.tid), "+v"(F.lane), "+v"(F.gt)); asm volatile("" : "+s"(F.wave), "+s"(F.gw)); return F; }

__device__ __forceinline__ void transpose_item(const float* W, int K, int N, bf16_t* WT, LAS float* scr, int item, int lane, int perm = 0, const float* kscale = nullptr) {
    const int nblk = N / 32, kb = item / nblk, nb = item % nblk, k0 = 64 * kb, n0 = 32 * nb;
#pragma unroll 8
    for (int i = 0; i < 32; ++i) { const int kk = 2 * i + (lane >> 5); float wv = W[(size_t)(k0 + kk) * N + n0 + (lane & 31)]; if (kscale) wv *= kscale[k0 + kk]; scr[kk * 33 + (lane & 31)] = wv; }
    asm volatile("s_waitcnt lgkmcnt(0)" ::: "memory");
    const int c = lane & 7;
#pragma unroll
    for (int j = 0; j < 4; ++j) { const int n = (lane >> 3) + 8 * j; const LAS float* s = scr + (8 * c) * 33 + n;
        u32x4 o; o.x = pk2(s[0 * 33], s[1 * 33]); o.y = pk2(s[2 * 33], s[3 * 33]); o.z = pk2(s[4 * 33], s[5 * 33]); o.w = pk2(s[6 * 33], s[7 * 33]);
        int nr = n0 + n; if (perm == 1) { const int cp = nr & 511; nr = 256 * (cp >> 7) + ((nr >> 9) << 7) + (cp & 127); }
        *(u32x4*)(WT + (size_t)nr * K + k0 + 8 * c) = o; }
    asm volatile("s_waitcnt lgkmcnt(0)" ::: "memory");
}

__device__ __forceinline__ void phase_mod(KArgs a0, const Fr& F0) {
    const Fr F = launder(F0); const KArgs a = klaunder(a0);
    LAS float* sc = (LAS float*)F.lds;
    LAS float* red = sc + 9 * 1024;
    float* MOD = (float*)(WSP(a) + WS_MOD);
    const float* c = INP(a, 1); const float* cc = INP(a, 3); const float* ada_w = INP(a, 4); const float* ada_b = INP(a, 5);
    if ((int)blockIdx.x < 192) {
        for (int i = F.tid; i < 9 * 1024; i += NTHR) { const int r = i >> 10, k = i & 1023; const float v = (r < 8) ? c[r * 1024 + k] : cc[k]; sc[i] = silu_f(v); }
    }
    __syncthreads();
    for (int item = blockIdx.x; item < 192; item += gridDim.x) {
        const int l = item / 48, cch = item % 48, col = cch * 64 + F.lane;
        const float* W = ada_w + (size_t)l * 1024 * 3072 + col;
        float acc[9];
#pragma unroll
        for (int r = 0; r < 9; ++r) acc[r] = 0.f;
        const int k0 = F.wave * 128;
#pragma unroll 16
        for (int k = k0; k < k0 + 128; ++k) { const float w = W[(size_t)k * 3072];
#pragma unroll
            for (int r = 0; r < 9; ++r) acc[r] += sc[r * 1024 + k] * w; }
#pragma unroll
        for (int r = 0; r < 9; ++r) red[(F.wave * 9 + r) * 64 + F.lane] = acc[r];
        __syncthreads();
        for (int i = F.tid; i < 576; i += NTHR) { const int r = i >> 6, ln = i & 63; float s = 0.f;
#pragma unroll
            for (int w = 0; w < 8; ++w) s += red[(w * 9 + r) * 64 + ln];
            MOD[(size_t)(l * 9 + r) * 3072 + cch * 64 + ln] = s + ada_b[l * 3072 + cch * 64 + ln]; }
        __syncthreads();
    }
}

__device__ __forceinline__ void phase_weights(KArgs a0, const Fr& F0, int l) {
    const Fr F = launder(F0); const KArgs a = klaunder(a0);
    LAS float* scr = (LAS float*)(F.lds + F.wave * 16384);
    const int i = l >> 1;
    if ((l & 1) == 0) {
        const float* w_in = INP(a, 8) + (size_t)i * 1024 * EVEN_IN; const float* w_uq = INP(a, 11) + (size_t)i * 256 * 768; const float* w_ukv = INP(a, 12) + (size_t)i * 128 * 1024;
        const float* w_glu = INP(a, 21) + (size_t)i * 512 * 1024; const float* w_out = INP(a, 23) + (size_t)i * 1024 * 1024;
        constexpr int I0 = 16 * 61, I1 = 4 * 24, I2 = 2 * 32, I3 = 8 * 32, I4 = 16 * 32, NI = I0 + I1 + I2 + I3 + I4;
        for (int it = F.gw; it < NI; it += F.NGW) {
            int r = it;
            if (r < I0) { transpose_item(w_in, 1024, EVEN_IN, (bf16_t*)(WSP(a) + WS_WEVIN), scr, r, F.lane); continue; } r -= I0;
            if (r < I1) { transpose_item(w_uq, 256, 768, (bf16_t*)(WSP(a) + WS_WUQ), scr, r, F.lane, 0, INP(a, 9) + i * 256); continue; } r -= I1;
            if (r < I2) { transpose_item(w_ukv, 128, 1024, (bf16_t*)(WSP(a) + WS_WUKV), scr, r, F.lane, 0, INP(a, 10) + i * 128); continue; } r -= I2;
            if (r < I3) { transpose_item(w_glu, 512, 1024, (bf16_t*)(WSP(a) + WS_WGLU), scr, r, F.lane, 1); continue; } r -= I3;
            transpose_item(w_out, 1024, 1024, (bf16_t*)(WSP(a) + WS_WEVOUT), scr, r, F.lane);
        }
        u32x4* pad = (u32x4*)((bf16_t*)(WSP(a) + WS_WEVIN) + (size_t)EVEN_IN * 1024);
        for (int t = F.gt; t < (EVEN_INP - EVEN_IN) * 1024 / 8; t += F.NGT) pad[t] = (u32x4){0u, 0u, 0u, 0u};
    } else {
        const float* w_in = INP(a, 24) + (size_t)i * 1024 * 4096; const float* w_out = INP(a, 26) + (size_t)i * 1024 * 1024;
        constexpr int I0 = 16 * 128, I1 = 16 * 32, NI = I0 + I1;
        for (int it = F.gw; it < NI; it += F.NGW) {
            int r = it;
            if (r < I0) { transpose_item(w_in, 1024, 4096, (bf16_t*)(WSP(a) + WS_WNAIN), scr, r, F.lane); continue; } r -= I0;
            transpose_item(w_out, 1024, 1024, (bf16_t*)(WSP(a) + WS_WNAOUT), scr, r, F.lane);
        }
    }
}

__device__ __forceinline__ void phase_s5_setup(KArgs a0, const Fr& F0, int i) {
    const Fr F = launder(F0); const KArgs a = klaunder(a0);
    f32x2* BB = (f32x2*)(WSP(a) + WS_BB); f32x2* POW = (f32x2*)(WSP(a) + WS_POW);
    const float* lam_re = INP(a, 13) + (size_t)i * 4096; const float* lam_im = INP(a, 14) + (size_t)i * 4096; const float* log_dt = INP(a, 15) + i * 64;
    const float* b_re = INP(a, 16) + (size_t)i * 65536; const float* b_im = INP(a, 17) + (size_t)i * 65536;
    for (int t = F.gt; t < 4096; t += F.NGT) {
        const int dg = t >> 6;
        const float dt = expf(log_dt[dg]);
        const float lr = fminf(lam_re[t], -1e-4f), li = lam_im[t];
        const float aa = lr * dt, th = li * dt;
        float sn, cs; sincosf(th, &sn, &cs);
        const float mag = expf(aa);
        const float lbr = mag * cs, lbi = mag * sn;
        const float sh = sinf(0.5f * th);
        const float nr = expm1f(aa) * cs - 2.f * sh * sh;
        const float den = lr * lr + li * li;
        const float kre = (nr * lr + lbi * li) / den, kim = (lbi * lr - nr * li) / den;
#pragma unroll
        for (int h = 0; h < 16; ++h) { const float br = b_re[(size_t)t * 16 + h], bi = b_im[(size_t)t * 16 + h];
            BB[(size_t)t * 16 + h] = (f32x2){kre * br - kim * bi, kre * bi + kim * br}; }
        const int p = t & 63;
        for (int tau = 0; tau <= 32; ++tau) { float s2, c2; sincosf(th * (float)tau, &s2, &c2); const float m2 = expf(aa * (float)tau);
            POW[((size_t)dg * 33 + tau) * 64 + p] = (f32x2){m2 * c2, m2 * s2}; }
    }
}
__device__ __forceinline__ void phase_s5_kt(KArgs a0, const Fr& F0, int i) {
    const Fr F = launder(F0); const KArgs a = klaunder(a0);
    const f32x2* BB = (const f32x2*)(WSP(a) + WS_BB); const f32x2* POW = (const f32x2*)(WSP(a) + WS_POW); float* KT = (float*)(WSP(a) + WS_KT);
    const float* c_re = INP(a, 18) + (size_t)i * 65536; const float* c_im = INP(a, 19) + (size_t)i * 65536;
    for (int t = F.gt; t < 32 * 2 * 32 * 256; t += F.NGT) {
        const int hp = t & 15, h = (t >> 4) & 15, tau = (t >> 8) & 31, di = (t >> 13) & 1, g = t >> 14;
        const int dg = di * 32 + g;
        const float* cr = c_re + ((size_t)dg * 16 + h) * 64; const float* ci = c_im + ((size_t)dg * 16 + h) * 64;
        const f32x2* pw = POW + ((size_t)dg * 33 + tau) * 64; const f32x2* bb = BB + (size_t)dg * 64 * 16 + hp;
        float s = 0.f;
#pragma unroll 16
        for (int p = 0; p < 64; ++p) { const f32x2 w = pw[p], b = bb[p * 16]; const float gr = cr[p] * w.x - ci[p] * w.y, gi = cr[p] * w.y + ci[p] * w.x; s += gr * b.x - gi * b.y; }
        KT[t] = s;
    }
}
__device__ __forceinline__ void phase_s5_tables(KArgs a0, const Fr& F0, int i) {
    const Fr F = launder(F0); const KArgs a = klaunder(a0);
    const f32x2* BB = (const f32x2*)(WSP(a) + WS_BB); const f32x2* POW = (const f32x2*)(WSP(a) + WS_POW); const float* KT = (const float*)(WSP(a) + WS_KT);
    const float* c_re = INP(a, 18) + (size_t)i * 65536; const float* c_im = INP(a, 19) + (size_t)i * 65536; const float* dsk = INP(a, 20) + i * 512;
    bf16_t* BTA = (bf16_t*)(WSP(a) + WS_BTA); bf16_t* BTC = (bf16_t*)(WSP(a) + WS_BTC);
    for (int t = F.gt; t < 32 * 256 * 64; t += F.NGT) {
        const int c8 = t & 63, row = (t >> 6) & 255, g = t >> 14;
        const int di = row >> 7, ri = (row >> 6) & 1, p = row & 63, s = c8 >> 1, h0 = (c8 & 1) * 8;
        const int dg = di * 32 + g, tau = di ? s : 31 - s;
        const f32x2 w = POW[((size_t)dg * 33 + tau) * 64 + p]; const f32x2* bb = BB + ((size_t)dg * 64 + p) * 16 + h0;
        float v[8];
#pragma unroll
        for (int j = 0; j < 8; ++j) { const f32x2 b = bb[j]; v[j] = ri ? (w.x * b.y + w.y * b.x) : (w.x * b.x - w.y * b.y); }
        *(u32x4*)(BTA + ((size_t)(g * 256 + row)) * 512 + c8 * 8) = (u32x4){pk2(v[0], v[1]), pk2(v[2], v[3]), pk2(v[4], v[5]), pk2(v[6], v[7])};
    }
    for (int t = F.gt; t < 32 * 512 * 96; t += F.NGT) {
        const int c8 = t % 96, row = (t / 96) & 511, g = t / (96 * 512);
        const int tt = row >> 4, h = row & 15;
        float v[8];
        if (c8 < 64) {
            const int s = c8 >> 1, h0 = (c8 & 1) * 8;
#pragma unroll
            for (int j = 0; j < 8; ++j) { const int hp = h0 + j; float x;
                if (tt > s) x = KT[(((size_t)(g * 2 + 0) * 32 + (tt - s)) * 16 + h) * 16 + hp];
                else if (tt < s) x = KT[(((size_t)(g * 2 + 1) * 32 + (s - tt)) * 16 + h) * 16 + hp];
                else { x = KT[(((size_t)(g * 2 + 0) * 32) * 16 + h) * 16 + hp] + KT[(((size_t)(g * 2 + 1) * 32) * 16 + h) * 16 + hp]; if (hp == h) x += dsk[g * 16 + h]; }
                v[j] = x; }
        } else {
            const int cc = (c8 - 64) * 8, di = cc >> 7, ri = (cc >> 6) & 1, p0 = cc & 63;
            const int dg = di * 32 + g, tau = di ? 32 - tt : tt + 1;
#pragma unroll
            for (int j = 0; j < 8; ++j) { const int p = p0 + j; const f32x2 w = POW[((size_t)dg * 33 + tau) * 64 + p];
                const float cr = c_re[((size_t)dg * 16 + h) * 64 + p], ci = c_im[((size_t)dg * 16 + h) * 64 + p];
                v[j] = ri ? -(cr * w.y + ci * w.x) : (cr * w.x - ci * w.y); }
        }
        *(u32x4*)(BTC + ((size_t)(g * 512 + row)) * 768 + c8 * 8) = (u32x4){pk2(v[0], v[1]), pk2(v[2], v[3]), pk2(v[4], v[5]), pk2(v[6], v[7])};
    }
}

__device__ __forceinline__ void phase_rn0(KArgs a0, const Fr& F0) {
    const Fr F = launder(F0); const KArgs a = klaunder(a0);
    const float* MOD = (const float*)(WSP(a) + WS_MOD); bf16_t* H = (bf16_t*)(WSP(a) + WS_HB); float* SSQ = (float*)(WSP(a) + WS_SSQ);
    const float* gam = INP(a, 6);
    for (int row = F.gw; row < MROWS; row += F.NGW) {
        const bool lat = row < MLAT; const int bi = lat ? (row >> 12) : 8;
        const float* xo = lat ? INP(a, 0) + (size_t)row * 1024 : INP(a, 2) + (size_t)(row - MLAT) * 1024;
        const float* md = MOD + (size_t)bi * 3072;
        f32x4 v[4]; float ss = 0.f;
#pragma unroll
        for (int j = 0; j < 4; ++j) { v[j] = ((const f32x4*)xo)[F.lane + 64 * j]; ss += (v[j].x * v[j].x + v[j].y * v[j].y) + (v[j].z * v[j].z + v[j].w * v[j].w); }
        ss = wave_sum(ss);
        u32x2* hrow = (u32x2*)(H + (size_t)row * 1024);
#pragma unroll
        for (int j = 0; j < 4; ++j) { const f32x4 g4 = ((const f32x4*)gam)[F.lane + 64 * j], s4 = ((const f32x4*)(md + 1024))[F.lane + 64 * j];
            hrow[F.lane + 64 * j] = (u32x2){pk2(v[j].x * g4.x * (1.f + s4.x), v[j].y * g4.y * (1.f + s4.y)), pk2(v[j].z * g4.z * (1.f + s4.z), v[j].w * g4.w * (1.f + s4.w))}; }
        if (F.lane < 16) SSQ[(size_t)row * 16 + F.lane] = (F.lane == 0) ? ss : 0.f;
    }
}
__device__ __forceinline__ void phase_shw(KArgs a0, const Fr& F0) {
    const Fr F = launder(F0); const KArgs a = klaunder(a0);
    LAS float* sc = (LAS float*)F.lds; LAS float* red = sc + 9 * 1024;
    const float* MOD = (const float*)(WSP(a) + WS_MOD); float* SHW = (float*)(WSP(a) + WS_SHW);
    for (int item = blockIdx.x; item < 190; item += gridDim.x) {
        int l, cch; if (item < 31) { l = 0; cch = item; } else if (item < 95) { l = 1; cch = item - 31; } else if (item < 126) { l = 2; cch = item - 95; } else { l = 3; cch = item - 126; }
        const int N = (l & 1) ? 4096 : EVEN_IN; const float* W = (l & 1) ? INP(a, 24) + (size_t)(l >> 1) * 1024 * 4096 : INP(a, 8) + (size_t)(l >> 1) * 1024 * EVEN_IN;
        __syncthreads();
        for (int t = F.tid; t < 9 * 1024; t += NTHR) sc[t] = MOD[(size_t)(l * 9 + (t >> 10)) * 3072 + (t & 1023)];
        __syncthreads();
        const int col = cch * 64 + F.lane; const bool ok = col < N; const float* Wc = W + (ok ? col : 0);
        float acc[9];
#pragma unroll
        for (int r = 0; r < 9; ++r) acc[r] = 0.f;
        const int k0 = F.wave * 128;
#pragma unroll 16
        for (int k = k0; k < k0 + 128; ++k) { const float w = Wc[(size_t)k * N];
#pragma unroll
            for (int r = 0; r < 9; ++r) acc[r] += sc[r * 1024 + k] * w; }
#pragma unroll
        for (int r = 0; r < 9; ++r) red[(F.wave * 9 + r) * 64 + F.lane] = acc[r];
        __syncthreads();
        for (int t = F.tid; t < 576; t += NTHR) { const int r = t >> 6, ln = t & 63; float s = 0.f;
#pragma unroll
            for (int w = 0; w < 8; ++w) s += red[(w * 9 + r) * 64 + ln];
            if (cch * 64 + ln < N) SHW[(size_t)(l * 9 + r) * 4096 + cch * 64 + ln] = s; }
    }
    __syncthreads();
}
__device__ __forceinline__ void phase_final(KArgs a0, const Fr& F0) {
    const Fr F = launder(F0); const KArgs a = klaunder(a0);
    const float* gam = INP(a, 7);
    for (int rp = F.gw; rp < MLAT / 2; rp += F.NGW) {
        float* xr0 = OUTP(a) + (size_t)(2 * rp) * 1024; float* xr1 = xr0 + 1024;
        f32x4 v[4], w[4]; float s0 = 0.f, s1 = 0.f;
#pragma unroll
        for (int j = 0; j < 4; ++j) { v[j] = ((const f32x4*)xr0)[F.lane + 64 * j]; w[j] = ((const f32x4*)xr1)[F.lane + 64 * j]; }
#pragma unroll
        for (int j = 0; j < 4; ++j) { s0 += (v[j].x * v[j].x + v[j].y * v[j].y) + (v[j].z * v[j].z + v[j].w * v[j].w); s1 += (w[j].x * w[j].x + w[j].y * w[j].y) + (w[j].z * w[j].z + w[j].w * w[j].w); }
        const float r0 = 1.0f / sqrtf(wave_sum(s0) * (1.f / 1024.f) + EPS), r1 = 1.0f / sqrtf(wave_sum(s1) * (1.f / 1024.f) + EPS);
#pragma unroll
        for (int j = 0; j < 4; ++j) { const f32x4 g4 = ((const f32x4*)gam)[F.lane + 64 * j];
            ((f32x4*)xr0)[F.lane + 64 * j] = (f32x4){v[j].x * r0 * g4.x, v[j].y * r0 * g4.y, v[j].z * r0 * g4.z, v[j].w * r0 * g4.w};
            ((f32x4*)xr1)[F.lane + 64 * j] = (f32x4){w[j].x * r1 * g4.x, w[j].y * r1 * g4.y, w[j].z * r1 * g4.z, w[j].w * r1 * g4.w}; }
    }
}

__device__ __forceinline__ void chunk_of_row(int row, int& R, int& s) {
    if (row < MLAT) { const int b = row >> 12, t = row & 4095; R = b * NCH + 8 + (t >> 5); s = t & 31; }
    else { const int r = row - MLAT, b = r >> 8, t = r & 255; R = b * NCH + (t >> 5); s = t & 31; }
}

__device__ __forceinline__ void phase_e2b(KArgs a0, const Fr& F0) {
    const Fr F = launder(F0); const KArgs a = klaunder(a0);
    const bf16_t* S = (const bf16_t*)(WSP(a) + WS_S); bf16_t* UX = (bf16_t*)(WSP(a) + WS_UX); const f32x2* POW = (const f32x2*)(WSP(a) + WS_POW);
    LAS bf16_t* T = (LAS bf16_t*)F.lds;
    for (int rep = 0; rep < PROBE_CARRY; ++rep)
    for (int it = blockIdx.x; it < NB * 32; it += gridDim.x) {
        const int b = it >> 5, g = it & 31;
        const size_t row0 = (size_t)g * NCHP + b * NCH;
        __syncthreads();
        { const u32x4* src4 = (const u32x4*)(S + row0 * 256); LAS u32x4* t4 = (LAS u32x4*)T;
          for (int t = F.tid; t < NCH * 32; t += NTHR) t4[t] = src4[t]; }
        __syncthreads();
        if (F.tid < 128) {
            const int di = F.tid >> 6, p = F.tid & 63;
            const f32x2 lt = POW[((size_t)(di * 32 + g) * 33 + 32) * 64 + p];
            float xr = 0.f, xi = 0.f;
#pragma unroll 8
            for (int k = 0; k < NCH; ++k) { const int cc = (di == 0) ? k : ((k < 8) ? 7 - k : 143 - k);
                LAS bf16_t* e = T + cc * 256 + di * 128 + p;
                const float sr = bf2f(e[0]), si = bf2f(e[64]);
                e[0] = (bf16_t)f2bf(xr); e[64] = (bf16_t)f2bf(xi);
                const float nr = lt.x * xr - lt.y * xi + sr, ni = lt.x * xi + lt.y * xr + si; xr = nr; xi = ni; }
        }
        __syncthreads();
        { const LAS u32x4* t4 = (const LAS u32x4*)T;
          for (int t = F.tid; t < NCH * 32; t += NTHR) { const int cc = t >> 5, c16 = t & 31; *(u32x4*)(UX + (row0 + cc) * 768 + 512 + c16 * 8) = t4[t]; } }
    }
    __syncthreads();
}

__device__ __forceinline__ void phase_krope(KArgs a0, const Fr& F0) {
    const Fr F = launder(F0); const KArgs a = klaunder(a0);
    bf16_t* KR = (bf16_t*)(WSP(a) + WS_KR);
    for (int t = F.gt; t < MLAT * 16; t += F.NGT) {
        const int row = t >> 4, axis = (t >> 3) & 1, ii = t & 7; const int tk = row & 4095;
        bf16_t* p0 = KR + (size_t)row * 32 + axis * 16 + ii;
        const float x0 = bf2f(p0[0]), x1 = bf2f(p0[8]);
        const float pos = (float)(axis ? (tk & 63) : (tk >> 6)); const float ang = pos * exp2f(-(float)ii * (13.287712379549449f / 8.f));
        float sn, cs; sincosf(ang, &sn, &cs);
        p0[0] = (bf16_t)f2bf(x0 * cs - x1 * sn); p0[8] = (bf16_t)f2bf(x1 * cs + x0 * sn);
    }
}

namespace mla {
using s16x4 = __attribute__((ext_vector_type(4))) short;
using f32x16 = __attribute__((ext_vector_type(16))) float;
constexpr int QBLK = 32, KVBLK = 64;
constexpr float SCALE = 0.10206207261596577f, THR = 8.f;
constexpr int SHM_V = 16384, SHM_K = 16384;
#define KSWZ(row, colB) ((row) * 256 + ((colB) ^ (((row) & 15) << 4)))
#define SBAR() __builtin_amdgcn_sched_barrier(0)
__device__ __forceinline__ int crow(int r, int hi) { return (r & 3) + 8 * (r >> 2) + 4 * hi; }
__device__ __forceinline__ unsigned cvtpk(float lo, float hi) { unsigned r; asm volatile("v_cvt_pk_bf16_f32 %0, %1, %2" : "=v"(r) : "v"(lo), "v"(hi)); return r; }
template <bool FIRST> __device__ __forceinline__ void partialSM(f32x16& p0, f32x16& p1, float& m_reg, float& alpha) {
  constexpr float THR2 = THR * 1.4426950408889634f;
  float pmax = p0[0];
#pragma unroll
  for (int r = 1; r < 16; ++r) pmax = fmaxf(pmax, p0[r]);
#pragma unroll
  for (int r = 0; r < 16; ++r) pmax = fmaxf(pmax, p1[r]);
  { auto rr = __builtin_amdgcn_permlane32_swap(__float_as_uint(pmax), __float_as_uint(pmax), false, false);
    pmax = fmaxf(__uint_as_float(rr[0]), __uint_as_float(rr[1])); }
  alpha = 1.f;
  if (FIRST || !__builtin_expect(__all(pmax <= THR2), 1)) {
    const float dl = FIRST ? pmax : fmaxf(pmax, 0.f);
    if (!FIRST) alpha = __builtin_amdgcn_exp2f(-dl);
    m_reg += dl;
#pragma unroll
    for (int r = 0; r < 16; ++r) { p0[r] -= dl; p1[r] -= dl; }
  }
#pragma unroll
  for (int r = 0; r < 16; ++r) p0[r] = __builtin_amdgcn_exp2f(p0[r]);
}
__device__ __forceinline__ void finishSM(f32x16& p0, f32x16& p1, float alpha, float& l_reg, bf16x8& pa0, bf16x8& pa1, bf16x8& pa2, bf16x8& pa3) {
#pragma unroll
  for (int r = 0; r < 16; ++r) p1[r] = __builtin_amdgcn_exp2f(p1[r]);
  float ps = 0;
#pragma unroll
  for (int r = 0; r < 16; ++r) ps += p0[r];
#pragma unroll
  for (int r = 0; r < 16; ++r) ps += p1[r];
  { auto rr = __builtin_amdgcn_permlane32_swap(__float_as_uint(ps), __float_as_uint(ps), false, false);
    ps = __uint_as_float(rr[0]) + __uint_as_float(rr[1]); }
  l_reg = l_reg * alpha + ps;
#define PK4(P, BASE, OUT) do { unsigned a0 = cvtpk(P[BASE + 0], P[BASE + 1]), a1 = cvtpk(P[BASE + 2], P[BASE + 3]);   \
    unsigned b0 = cvtpk(P[BASE + 4], P[BASE + 5]), b1 = cvtpk(P[BASE + 6], P[BASE + 7]);                              \
    auto r0 = __builtin_amdgcn_permlane32_swap(a0, b0, false, false); auto r1 = __builtin_amdgcn_permlane32_swap(a1, b1, false, false); \
    u32x4 w = {r0[0], r1[0], r0[1], r1[1]}; OUT = *reinterpret_cast<bf16x8*>(&w); } while (0)
  PK4(p0, 0, pa0); PK4(p0, 8, pa1); PK4(p1, 0, pa2); PK4(p1, 8, pa3);
#undef PK4
}
__device__ __forceinline__ void qkt(f32x16& p0, f32x16& p1, const char* Ks, const bf16x8* qr, int r32, int hi, float m_ref) {
#pragma unroll
  for (int r = 0; r < 16; ++r) { p0[r] = -m_ref; p1[r] = -m_ref; }
#pragma unroll
  for (int d0 = 0; d0 < 6; ++d0) { const int cb = (d0 * 16 + hi * 8) * 2;
    const bf16x8 b0 = *reinterpret_cast<const bf16x8*>(Ks + KSWZ(r32, cb));
    const bf16x8 b1 = *reinterpret_cast<const bf16x8*>(Ks + KSWZ(32 + r32, cb));
    p0 = __builtin_amdgcn_mfma_f32_32x32x16_bf16(b0, qr[d0], p0, 0, 0, 0);
    p1 = __builtin_amdgcn_mfma_f32_32x32x16_bf16(b1, qr[d0], p1, 0, 0, 0); }
}
__device__ __forceinline__ int v_st(int k, int c) { const int kk = (k & ~0xC) | ((k & 4) << 1) | ((k & 8) >> 1); return ((kk >> 3) * 4 + (c >> 5)) * 512 + ((kk & 7) * 32 + (c & 31)) * 2; }
__device__ __forceinline__ int v_rd_base(int lane) { return ((lane & 3) << 3) | (((lane >> 2) & 3) << 6) | (((lane >> 4) & 1) << 5) | (((lane >> 5) & 1) << 8); }
constexpr int v_rd_off(int d0, int ks, int half) { return d0 * 512 + ks * 4096 + half * 2048; }
template <int OFF> __device__ __forceinline__ s16x4 tr_read(int vb) { s16x4 r; asm volatile("ds_read_b64_tr_b16 %0, %1 offset:%2" : "=&v"(r) : "v"(vb), "i"(OFF) : "memory"); return r; }
template <int D0> __device__ __forceinline__ void pv_one(f32x16& od, int vb, bf16x8 pa0, bf16x8 pa1, bf16x8 pa2, bf16x8 pa3) {
  const s16x4 l0 = tr_read<v_rd_off(D0, 0, 0)>(vb), h0 = tr_read<v_rd_off(D0, 0, 1)>(vb), l1 = tr_read<v_rd_off(D0, 1, 0)>(vb), h1 = tr_read<v_rd_off(D0, 1, 1)>(vb);
  const s16x4 l2 = tr_read<v_rd_off(D0, 2, 0)>(vb), h2 = tr_read<v_rd_off(D0, 2, 1)>(vb), l3 = tr_read<v_rd_off(D0, 3, 0)>(vb), h3 = tr_read<v_rd_off(D0, 3, 1)>(vb);
  asm volatile("s_waitcnt lgkmcnt(0)" ::: "memory"); SBAR();
#define PK(L, H) (bf16x8){L[0], L[1], L[2], L[3], H[0], H[1], H[2], H[3]}
  od = __builtin_amdgcn_mfma_f32_32x32x16_bf16(pa0, PK(l0, h0), od, 0, 0, 0);
  od = __builtin_amdgcn_mfma_f32_32x32x16_bf16(pa1, PK(l1, h1), od, 0, 0, 0);
  od = __builtin_amdgcn_mfma_f32_32x32x16_bf16(pa2, PK(l2, h2), od, 0, 0, 0);
  od = __builtin_amdgcn_mfma_f32_32x32x16_bf16(pa3, PK(l3, h3), od, 0, 0, 0);
#undef PK
}
__device__ __forceinline__ void pv_d0(f32x16* o, int vb, bf16x8 pa0, bf16x8 pa1, bf16x8 pa2, bf16x8 pa3) { pv_one<0>(o[0], vb, pa0, pa1, pa2, pa3); pv_one<1>(o[1], vb, pa0, pa1, pa2, pa3); }

template <int FAKE> __device__ __forceinline__ void unit(const bf16_t* __restrict__ Q0, const bf16_t* __restrict__ KV0, const bf16_t* __restrict__ KR, const bf16_t* __restrict__ Z, bf16_t* __restrict__ BR,
                                     int qrow0, int b, int h, int nkeys, char* lds) {
  int tid_ = threadIdx.x; asm volatile("" : "+v"(tid_));
  const int tid = tid_, wid = tid >> 6, lane = tid & 63, r32 = lane & 31, hi = lane >> 5;
  char* V_lds = lds; char* K_lds = lds + 3 * SHM_V;
  float* ws = (float*)(lds + 3 * SHM_V + 3 * SHM_K) + wid * 64; float* li_l = ws; float* al_l = ws + 32;
  float m_reg = 0.f, l_reg = 0; f32x16 o[2] = {}; bf16x8 qr[6];
  const bf16_t* Qw = Q0 + (size_t)(qrow0 + wid * QBLK + r32) * 768 + h * 96 + hi * 8;
#pragma unroll
  for (int d0 = 0; d0 < 6; ++d0) qr[d0] = *reinterpret_cast<const bf16x8*>(Qw + d0 * 16);
  const int vrow = tid >> 3, vc = (tid & 7) * 8, vst = v_st(vrow, vc);
  const int kr0 = tid / 12, kc0 = tid % 12, kr1 = (512 + (tid & 255)) / 12, kc1 = (512 + (tid & 255)) % 12;
  const bf16_t* vsrc = KV0 + (size_t)vrow * 1024 + h * 128 + 64 + vc;
  const bf16_t* ksrc0 = (kc0 < 8) ? KV0 + (size_t)kr0 * 1024 + h * 128 + 8 * kc0 : KR + (size_t)kr0 * 32 + 8 * (kc0 - 8);
  const bf16_t* ksrc1 = (kc1 < 8) ? KV0 + (size_t)kr1 * 1024 + h * 128 + 8 * kc1 : KR + (size_t)kr1 * 32 + 8 * (kc1 - 8);
  const int kstr0 = (kc0 < 8) ? 1024 : 32, kstr1 = (kc1 < 8) ? 1024 : 32;
  const int kst0 = KSWZ(kr0, kc0 * 16), kst1 = KSWZ(kr1, kc1 * 16);
  const int vb0 = (int)(uintptr_t)V_lds + v_rd_base(lane);
  struct { bf16x8 vs, ks0, ks1; } sr_[2];
#define ROWB(k0) (((k0) < 256) ? (MLAT + b * 256 + (k0)) : (b * 4096 + (k0) - 256))
#define SLOAD(i, k0) do { if (FAKE == 1) break; const size_t rb_ = (size_t)ROWB(k0); sr_[i].vs = *reinterpret_cast<const bf16x8*>(vsrc + rb_ * 1024); \
    sr_[i].ks0 = *reinterpret_cast<const bf16x8*>(ksrc0 + rb_ * kstr0); sr_[i].ks1 = *reinterpret_cast<const bf16x8*>(ksrc1 + rb_ * kstr1); } while (0)
#define SWRITE(bf, i) do { *(bf16x8*)(V_lds + (bf) * SHM_V + vst) = sr_[i].vs; *(bf16x8*)(K_lds + (bf) * SHM_K + kst0) = sr_[i].ks0; \
    *(bf16x8*)(K_lds + (bf) * SHM_K + kst1) = sr_[i].ks1; } while (0)
#define RESC(a) do { if (__any((a) < 1.f)) { if (hi == 0) al_l[r32] = (a); asm volatile("s_waitcnt lgkmcnt(0)" ::: "memory"); \
    _Pragma("unroll") for (int d = 0; d < 2; ++d) _Pragma("unroll") for (int r = 0; r < 16; ++r) o[d][r] *= al_l[crow(r, hi)]; } } while (0)
#define BARX() do { if (FAKE != 3) __syncthreads(); } while (0)
#define QKT(P0, P1, KS) do { if (FAKE == 5) { P0 = f32x16{}; P1 = f32x16{}; } else qkt(P0, P1, KS, qr, r32, hi, m_reg); } while (0)
#define PSM(P0, P1, MN, AL) do { if (FAKE == 2) { AL = 1.f; } else partialSM<false>(P0, P1, m_reg, AL); } while (0)
#define PSM0(P0, P1, AL) do { if (FAKE == 2) { AL = 1.f; } else partialSM<true>(P0, P1, m_reg, AL); } while (0)
#define FSM(P0, P1, AL) do { if (FAKE == 2) { u32x4 w_ = {__float_as_uint(P0[0]), __float_as_uint(P0[1]), __float_as_uint(P1[0]), __float_as_uint(P1[1])}; pa0 = pa1 = pa2 = pa3 = *reinterpret_cast<bf16x8*>(&w_); } else finishSM(P0, P1, AL, l_reg, pa0, pa1, pa2, pa3); } while (0)
#define PVD(VB) do { if (FAKE != 4) pv_d0(o, VB, pa0, pa1, pa2, pa3); } while (0)
  f32x16 pA0, pA1, pB0, pB1; float mnA, mnB, alA, alB; bf16x8 pa0, pa1, pa2, pa3; const int NT = nkeys / KVBLK;
  int bo_prev = 0, bo_cur = 0, bo_next = SHM_V;
#define ROT3() do { bo_prev = bo_cur; bo_cur = bo_next; bo_next = (bo_next == 2 * SHM_V) ? 0 : bo_next + SHM_V; } while (0)
#define SWRITE3(off, i) do { if (FAKE == 1) break; *(bf16x8*)(V_lds + (off) + vst) = sr_[i].vs; *(bf16x8*)(K_lds + (off) + kst0) = sr_[i].ks0; *(bf16x8*)(K_lds + (off) + kst1) = sr_[i].ks1; } while (0)
  SLOAD(0, 0); SLOAD(1, KVBLK); SWRITE3(0, 0); SLOAD(0, 2 * KVBLK);
  BARX();
  SWRITE3(bo_next, 1); SLOAD(1, 3 * KVBLK);
  QKT(pA0, pA1, K_lds + bo_cur); PSM0(pA0, pA1, alA); RESC(alA);
  ROT3();
  for (int j = 1; j + 1 < NT; j += 2) {
    BARX();
    SWRITE3(bo_next, 0); { const int tn = (j + 3 < NT) ? j + 3 : NT - 1; SLOAD(0, tn * KVBLK); }
    QKT(pB0, pB1, K_lds + bo_cur);
    FSM(pA0, pA1, alA);
    PVD(vb0 + bo_prev); PSM(pB0, pB1, mnB, alB); RESC(alB);
    ROT3();
    BARX();
    SWRITE3(bo_next, 1); { const int tn = (j + 4 < NT) ? j + 4 : NT - 1; SLOAD(1, tn * KVBLK); }
    QKT(pA0, pA1, K_lds + bo_cur);
    FSM(pB0, pB1, alB);
    PVD(vb0 + bo_prev); PSM(pA0, pA1, mnA, alA); RESC(alA);
    ROT3();
  }
  BARX();
  QKT(pB0, pB1, K_lds + bo_cur);
  FSM(pA0, pA1, alA);
  PVD(vb0 + bo_prev); PSM(pB0, pB1, mnB, alB); RESC(alB);
  FSM(pB0, pB1, alB);
  PVD(vb0 + bo_cur);
#undef ROT3
#undef BARX
#undef QKT
#undef PSM
#undef PSM0
#undef FSM
#undef PVD
#undef SWRITE3
  if (hi == 0) li_l[r32] = l_reg; asm volatile("s_waitcnt lgkmcnt(0)" ::: "memory");
  float rli[16];
#pragma unroll
  for (int r = 0; r < 16; ++r) rli[r] = __builtin_amdgcn_rcpf(li_l[crow(r, hi)]);
  { LAS float* stg = (LAS float*)(unsigned)(uintptr_t)(lds + 3 * SHM_V + 3 * SHM_K + 2048) + wid * (32 * 36);
#pragma unroll
    for (int d0 = 0; d0 < 2; ++d0) {
      u32x4 gw[2];
#pragma unroll
      for (int i2 = 0; i2 < 2; ++i2) { const size_t qrow = (size_t)(qrow0 + wid * QBLK + 16 * i2 + (lane >> 2)); gw[i2] = *(const u32x4*)(Z + qrow * 1024 + h * 64 + d0 * 32 + 8 * (lane & 3)); }
#pragma unroll
      for (int r = 0; r < 16; ++r) stg[crow(r, hi) * 36 + r32] = o[d0][r] * rli[r];
      asm volatile("s_waitcnt lgkmcnt(0)" ::: "memory");
#pragma unroll
      for (int i2 = 0; i2 < 2; ++i2) { const size_t qrow = (size_t)(qrow0 + wid * QBLK + 16 * i2 + (lane >> 2));
        const LAS f32x4* sp = (const LAS f32x4*)(stg + (16 * i2 + (lane >> 2)) * 36 + 8 * (lane & 3)); const f32x4 a0 = sp[0], a1 = sp[1]; const u32x4 g = gw[i2];
        u32x4 w; w.x = pk2(a0[0] * silu_f(lo16(g.x)), a0[1] * silu_f(hi16(g.x))); w.y = pk2(a0[2] * silu_f(lo16(g.y)), a0[3] * silu_f(hi16(g.y)));
        w.z = pk2(a1[0] * silu_f(lo16(g.z)), a1[1] * silu_f(hi16(g.z))); w.w = pk2(a1[2] * silu_f(lo16(g.w)), a1[3] * silu_f(hi16(g.w)));
        *(u32x4*)(BR + qrow * 1024 + h * 64 + d0 * 32 + 8 * (lane & 3)) = w; }
      asm volatile("s_waitcnt lgkmcnt(0)" ::: "memory");
    } }
#undef ROWB
#undef SLOAD
#undef SWRITE
#undef RESC
}
#undef KSWZ
#undef SBAR
}

namespace mla2 {
using s16x4 = __attribute__((ext_vector_type(4))) short;
using f32x16 = __attribute__((ext_vector_type(16))) float;
typedef short v4i16_t __attribute__((ext_vector_type(4)));
typedef __attribute__((address_space(3))) const char* lds_cptr;
typedef float f32x2_t __attribute__((ext_vector_type(2))); typedef __bf16 bf16x2_t __attribute__((ext_vector_type(2)));
constexpr int NSLOT = 3, KSLOT = 12288, VSLOT = 8192;
constexpr int LDS_K = 0, LDS_V = NSLOT * KSLOT, LDS_WS = LDS_V + NSLOT * VSLOT, LDS_STG = LDS_WS + 2048, LDS_END = LDS_STG + 8 * 4608;
#define SBAR() __builtin_amdgcn_sched_barrier(0)
__device__ __forceinline__ int crow(int r, int hi) { return (r & 3) + 8 * (r >> 2) + 4 * hi; }
__device__ __forceinline__ void glds16(const void* gsrc, unsigned lds_dst) { unsigned keep;
  asm volatile("s_mov_b32 %0, m0\n\ts_mov_b32 m0, %2\n\ts_nop 0\n\tglobal_load_lds_dwordx4 %1, off\n\ts_mov_b32 m0, %0" : "=&s"(keep) : "v"(gsrc), "s"(lds_dst) : "memory"); }
__device__ __forceinline__ float max3f(float a, float b, float c) { float r; asm("v_max3_f32 %0, %1, %2, %3" : "=v"(r) : "v"(a), "v"(b), "v"(c)); return r; }
__device__ __forceinline__ float max2f(float a, float b) { float r; asm("v_max_f32_e32 %0, %1, %2" : "=v"(r) : "v"(a), "v"(b)); return r; }
__device__ __forceinline__ float fadd_s(float a, float b) { float r; asm("v_add_f32_e32 %0, %1, %2" : "=v"(r) : "v"(a), "v"(b)); return r; }
__device__ __forceinline__ float fsub_s(float a, float b) { float r; asm("v_sub_f32_e32 %0, %1, %2" : "=v"(r) : "v"(a), "v"(b)); return r; }
__device__ __forceinline__ unsigned cvtpk_s(float lo, float hi) { f32x2_t v = {lo, hi}; bf16x2_t b = __builtin_convertvector(v, bf16x2_t); return __builtin_bit_cast(unsigned, b); }
#define WAIT_BAR(N) asm volatile("s_waitcnt vmcnt(" #N ") lgkmcnt(0)\n\ts_barrier" ::: "memory")
__device__ __forceinline__ void qkt6(f32x16& p0, f32x16& p1, lds_cptr Kslot, const bf16x8* qr, const f32x16& negm, int r32, int hi) {
  lds_cptr kb = Kslot + hi * 1024 + r32 * 16;
#pragma unroll
  for (int d0 = 0; d0 < 6; ++d0) {
    const bf16x8 b0 = *(const LAS bf16x8*)(kb + d0 * 2048), b1 = *(const LAS bf16x8*)(kb + d0 * 2048 + 512);
    if (d0 == 0) { p0 = __builtin_amdgcn_mfma_f32_32x32x16_bf16(b0, qr[0], negm, 0, 0, 0); p1 = __builtin_amdgcn_mfma_f32_32x32x16_bf16(b1, qr[0], negm, 0, 0, 0); }
    else { p0 = __builtin_amdgcn_mfma_f32_32x32x16_bf16(b0, qr[d0], p0, 0, 0, 0); p1 = __builtin_amdgcn_mfma_f32_32x32x16_bf16(b1, qr[d0], p1, 0, 0, 0); } }
}
__device__ __forceinline__ void kload2(bf16x8* kf, lds_cptr kp, int j) { kf[2 * j] = *(const LAS bf16x8*)(kp + j * 2048); kf[2 * j + 1] = *(const LAS bf16x8*)(kp + j * 2048 + 512); }
__device__ __forceinline__ s16x4 vtr(lds_cptr p) { return __builtin_bit_cast(s16x4, __builtin_amdgcn_ds_read_tr16_b64_v4i16((__attribute__((address_space(3))) v4i16_t*)p)); }
__device__ __forceinline__ float rowmax(const f32x16& p0, const f32x16& p1) {
  float a = max3f(p0[0], p0[1], p1[0]), b = max3f(p0[2], p0[3], p1[1]); a = max3f(a, p1[2], p1[3]);
#pragma unroll
  for (int r = 4; r < 16; r += 4) { a = max3f(a, p0[r], p0[r + 1]); b = max3f(b, p0[r + 2], p0[r + 3]); a = max3f(a, p1[r], p1[r + 1]); b = max3f(b, p1[r + 2], p1[r + 3]); }
  const float m = max2f(a, b);
  auto rr = __builtin_amdgcn_permlane32_swap(__float_as_uint(m), __float_as_uint(m), false, false);
  return max2f(__uint_as_float(rr[0]), __uint_as_float(rr[1]));
}
template <int THRL> __device__ __forceinline__ void unit(const bf16_t* __restrict__ Q0, const bf16_t* __restrict__ KV0, const bf16_t* __restrict__ KR, const bf16_t* __restrict__ GATE, bf16_t* __restrict__ BR,
                                                         int qrow0, int b, int h, int nkeys, LAS unsigned char* lds) {
  int tid_ = threadIdx.x; asm volatile("" : "+v"(tid_));
  const int tid = tid_, lane = tid & 63, r32 = lane & 31, hi = lane >> 5; const int wid = __builtin_amdgcn_readfirstlane(tid >> 6);
  const unsigned lds0 = (unsigned)(uintptr_t)lds;
  LAS float* wsf = (LAS float*)(lds + LDS_WS) + wid * 64;
  const bf16_t* ks0 = KV0 + (size_t)lane * 1024 + h * 128 + wid * 8;
  const bf16_t* ks1 = KR + (size_t)lane * 32 + (wid & 3) * 8;
  const bf16_t* vs = KV0 + (size_t)(16 * (wid & 3) + (lane >> 2)) * 1024 + h * 128 + 64 + (wid >> 2) * 32 + (lane & 3) * 8;
  const unsigned kd0 = lds0 + LDS_K + wid * 1024, kd1 = lds0 + LDS_K + (8 + (wid & 3)) * 1024, vd = lds0 + LDS_V + wid * 1024;
#define ROWB(t) (((t) < 4) ? (MLAT + b * 256 + 64 * (t)) : (b * 4096 + 64 * ((t) - 4)))
#define DMA_K(t, slot) do { const size_t rb_ = (size_t)ROWB(t); glds16(ks0 + rb_ * 1024, (unsigned)__builtin_amdgcn_readfirstlane(kd0 + (slot))); glds16(ks1 + rb_ * 32, (unsigned)__builtin_amdgcn_readfirstlane(kd1 + (slot))); } while (0)
#define DMA_V(t, slot) do { const size_t rb_ = (size_t)ROWB(t); glds16(vs + rb_ * 1024, (unsigned)__builtin_amdgcn_readfirstlane(vd + (slot))); } while (0)
  const lds_cptr shm3 = (lds_cptr)lds; const lds_cptr kp0 = shm3 + LDS_K + hi * 1024 + r32 * 16;
  const lds_cptr vp0 = shm3 + LDS_V + ((lane >> 4) & 1) * 32 + (lane & 3) * 8 + (4 * hi + ((lane & 15) >> 2)) * 64;
  bf16x8 kf[12];
  const int NT = nkeys / 64;
  DMA_K(0, 0); DMA_V(0, 0); DMA_K(1, KSLOT);
  bf16x8 qr[6];
  { const bf16_t* Qw = Q0 + (size_t)(qrow0 + wid * 32 + r32) * 768 + h * 96 + hi * 8;
#pragma unroll
    for (int d0 = 0; d0 < 6; ++d0) qr[d0] = *reinterpret_cast<const bf16x8*>(Qw + d0 * 16); }
  float mhat = 0.f, l_reg = 0.f; f32x16 o[2]; o[0] = f32x16{}; o[1] = f32x16{}; f32x16 negm = f32x16{}; asm volatile("" : "+v"(negm));
  bool resc = false;
#define START(P0, P1) do { const float rm = rowmax(P0, P1); resc = false; \
    { const float dl = rm; mhat = fadd_s(mhat, dl); \
      _Pragma("unroll") for (int r = 0; r < 16; ++r) { P0[r] = fsub_s(P0[r], dl); P1[r] = fsub_s(P1[r], dl); } \
      _Pragma("unroll") for (int r = 0; r < 16; ++r) negm[r] = -mhat; asm volatile("" : "+v"(negm)); } \
    _Pragma("unroll") for (int r = 0; r < 16; ++r) P0[r] = __builtin_amdgcn_exp2f(P0[r]); } while (0)
#define RESC() do { if (resc) { asm volatile("s_waitcnt lgkmcnt(0)" ::: "memory"); \
      _Pragma("unroll") for (int d_ = 0; d_ < 2; ++d_) _Pragma("unroll") for (int r = 0; r < 16; ++r) o[d_][r] *= wsf[crow(r, hi)]; } } while (0)
  f32x16 pA0, pA1, pB0, pB1;
  int ks_cur = 0, ks_next = KSLOT, vs_prev = 0, vs_cur = 0, vs_next = VSLOT;
#define ROT() do { ks_cur = ks_next; ks_next = (ks_next == (NSLOT - 1) * KSLOT) ? 0 : ks_next + KSLOT; vs_prev = vs_cur; vs_cur = vs_next; vs_next = (vs_next == (NSLOT - 1) * VSLOT) ? 0 : vs_next + VSLOT; } while (0)
  DMA_K(2, 2 * KSLOT);
  WAIT_BAR(5);
  qkt6(pA0, pA1, shm3 + LDS_K, qr, negm, r32, hi); asm volatile("s_nop 15\n\ts_nop 7" : "+v"(pA0), "+v"(pA1));
  START(pA0, pA1);
#pragma unroll
  for (int r = 0; r < 16; ++r) pA1[r] = __builtin_amdgcn_exp2f(pA1[r]);
  WAIT_BAR(0);
  DMA_K(3, 0); DMA_V(1, VSLOT);
  ROT();
#pragma unroll
  for (int j = 0; j < 6; ++j) kload2(kf, kp0 + ks_cur, j);
  WAIT_BAR(3);
  s16x4 vlo[8], vhi[8]; u32x4 pw0, pw1, pw2, pw3;
#define PKW(P, B) cvtpk_s(P[B], P[B + 1])
#define PAF(k) __builtin_bit_cast(bf16x8, pw##k)
#define VFR(i) (bf16x8){vlo[i][0], vlo[i][1], vlo[i][2], vlo[i][3], vhi[i][0], vhi[i][1], vhi[i][2], vhi[i][3]}
#define PIN(x) asm volatile("" : "+v"(x))
#define MX3(a, b, c) __builtin_fmaxf(__builtin_fmaxf((a), (b)), (c))
#define GAPA(MF, A0, A1, A2, A3, W0, W1, PW) do { MF; sacc += A0; sacc += A1; sacc += A2; sacc += A3; PIN(sacc); W0; W1; PIN(PW); SBAR(); } while (0)
#define GAPM(MF) do { MF; SBAR(); } while (0)
#define EX(v) __builtin_amdgcn_exp2f(v)
#define GAPB(MF, X, B) do { MF; X[B] = EX(X[B]); X[B + 1] = EX(X[B + 1]); X[B + 2] = EX(X[B + 2]); X[B + 3] = EX(X[B + 3]); PIN(X); SBAR(); } while (0)
#define VRD(i) do { vlo[i] = vtr(vp_ + (((i) >> 2) * 4096 + ((i) & 3) * 1024)); vhi[i] = vtr(vp_ + (((i) >> 2) * 4096 + ((i) & 3) * 1024 + 512)); } while (0)
#define KRD(G, j) do { if (G) { kload2(kf, kp0 + ks_next, j); SBAR(); } } while (0)
#define MF32(A, B, C) __builtin_amdgcn_mfma_f32_32x32x16_bf16(A, B, C, 0, 0, 0)
#define STEP(C0, C1, P0, P1, t, GK, GV, GL) do { SBAR(); \
    const lds_cptr vp_ = vp0 + vs_prev; \
    VRD(0); SBAR(); float sacc = (P0[0] + P0[1]); \
    GAPA(C0 = MF32(kf[0], qr[0], negm), P0[2], P0[3], P0[4], P0[5],     pw0[0] = PKW(P0, 0), pw0[1] = PKW(P0, 2), pw0); \
    VRD(4); SBAR(); GAPA(C1 = MF32(kf[1], qr[0], negm), P0[6], P0[7], P0[8], P0[9],     pw0[2] = PKW(P0, 4), pw0[3] = PKW(P0, 6), pw0); \
    VRD(1); SBAR(); GAPA(C0 = MF32(kf[2], qr[1], C0),   P0[10], P0[11], P0[12], P0[13], pw1[0] = PKW(P0, 8), pw1[1] = PKW(P0, 10), pw1); \
    VRD(5); SBAR(); GAPA(C1 = MF32(kf[3], qr[1], C1),   P0[14], P0[15], P1[0], P1[1],   pw1[2] = PKW(P0, 12), pw1[3] = PKW(P0, 14), pw1); \
    VRD(2); SBAR(); GAPA(C0 = MF32(kf[4], qr[2], C0),   P1[2], P1[3], P1[4], P1[5],     pw2[0] = PKW(P1, 0), pw2[1] = PKW(P1, 2), pw2); \
    VRD(6); SBAR(); GAPA(C1 = MF32(kf[5], qr[2], C1),   P1[6], P1[7], P1[8], P1[9],     pw2[2] = PKW(P1, 4), pw2[3] = PKW(P1, 6), pw2); \
    VRD(3); SBAR(); GAPA(C0 = MF32(kf[6], qr[3], C0),   P1[10], P1[11], P1[12], P1[13], pw3[0] = PKW(P1, 8), pw3[1] = PKW(P1, 10), pw3); \
    VRD(7); SBAR(); GAPA(C1 = MF32(kf[7], qr[3], C1),   P1[14], P1[15], 0.f, 0.f,       pw3[2] = PKW(P1, 12), pw3[3] = PKW(P1, 14), pw3); \
    GAPM(C0 = MF32(kf[8], qr[4], C0)); GAPM(C1 = MF32(kf[9], qr[4], C1)); GAPM(C0 = MF32(kf[10], qr[5], C0)); GAPM(C1 = MF32(kf[11], qr[5], C1)); \
    l_reg += sacc; \
    if (GK) { DMA_K((t) + 3, ks_cur); } if (GV) { DMA_V((t) + 1, vs_next); } \
    { float a = MX3(C0[0], C0[1], C1[0]), bq = MX3(C0[2], C0[3], C1[1]); a = MX3(a, C1[2], C1[3]); \
      _Pragma("unroll") for (int r = 4; r < 16; r += 4) { a = MX3(a, C0[r], C0[r + 1]); bq = MX3(bq, C0[r + 2], C0[r + 3]); a = MX3(a, C1[r], C1[r + 1]); bq = MX3(bq, C1[r + 2], C1[r + 3]); } \
      float rm = __builtin_fmaxf(a, bq); { auto rr = __builtin_amdgcn_permlane32_swap(__float_as_uint(rm), __float_as_uint(rm), false, false); rm = __builtin_fmaxf(__uint_as_float(rr[0]), __uint_as_float(rr[1])); } \
      resc = false; \
      if (__builtin_expect(__any(rm > (float)THRL), 0)) { const float dl = __builtin_fmaxf(rm, 0.f); mhat += dl; \
        _Pragma("unroll") for (int r = 0; r < 16; ++r) { C0[r] -= dl; C1[r] -= dl; } \
        _Pragma("unroll") for (int r = 0; r < 16; ++r) negm[r] = -mhat; asm volatile("" : "+v"(negm)); \
        const float f = __builtin_amdgcn_exp2f(-dl); l_reg *= f; if (hi == 0) wsf[r32] = f; resc = true; } } \
    SBAR(); \
    KRD(GL, 0); GAPB(o[0] = MF32(PAF(0), VFR(0), o[0]), C0, 0); \
    KRD(GL, 1); GAPB(o[1] = MF32(PAF(0), VFR(4), o[1]), C0, 4); \
    KRD(GL, 2); GAPB(o[0] = MF32(PAF(1), VFR(1), o[0]), C0, 8); \
    KRD(GL, 3); GAPB(o[1] = MF32(PAF(1), VFR(5), o[1]), C0, 12); \
    KRD(GL, 4); GAPB(o[0] = MF32(PAF(2), VFR(2), o[0]), C1, 0); \
    KRD(GL, 5); GAPB(o[1] = MF32(PAF(2), VFR(6), o[1]), C1, 4); \
    GAPB(o[0] = MF32(PAF(3), VFR(3), o[0]), C1, 8); \
    GAPB(o[1] = MF32(PAF(3), VFR(7), o[1]), C1, 12); \
  } while (0)
  int t = 1;
  for (; t + 5 < NT; t += 2) {
    STEP(pB0, pB1, pA0, pA1, t, true, true, true);     WAIT_BAR(3); RESC(); ROT();
    STEP(pA0, pA1, pB0, pB1, t + 1, true, true, true); WAIT_BAR(3); RESC(); ROT();
  }
#define ENDW(tt) do { if ((tt) + 3 < NT) { WAIT_BAR(3); } else if ((tt) + 2 < NT) { WAIT_BAR(1); } else { WAIT_BAR(0); } } while (0)
  for (; t + 1 < NT; t += 2) {
    STEP(pB0, pB1, pA0, pA1, t, (t + 3 < NT), (t + 1 < NT), (t + 1 < NT));     ENDW(t);     RESC(); ROT();
    STEP(pA0, pA1, pB0, pB1, t + 1, (t + 4 < NT), (t + 2 < NT), (t + 2 < NT)); ENDW(t + 1); RESC(); ROT();
  }
  STEP(pB0, pB1, pA0, pA1, NT - 1, false, false, false); RESC();
  { float sacc = pB0[0] + pB0[1];
#pragma unroll
    for (int r = 2; r < 16; ++r) sacc += pB0[r];
#pragma unroll
    for (int r = 0; r < 16; ++r) sacc += pB1[r];
    l_reg += sacc;
    pw0 = (u32x4){PKW(pB0, 0), PKW(pB0, 2), PKW(pB0, 4), PKW(pB0, 6)}; pw1 = (u32x4){PKW(pB0, 8), PKW(pB0, 10), PKW(pB0, 12), PKW(pB0, 14)};
    pw2 = (u32x4){PKW(pB1, 0), PKW(pB1, 2), PKW(pB1, 4), PKW(pB1, 6)}; pw3 = (u32x4){PKW(pB1, 8), PKW(pB1, 10), PKW(pB1, 12), PKW(pB1, 14)};
    SBAR();
    const lds_cptr vp_ = vp0 + vs_cur;
    VRD(0); VRD(1); VRD(2); VRD(3); VRD(4); VRD(5); VRD(6); VRD(7);
    o[0] = MF32(PAF(0), VFR(0), o[0]); o[1] = MF32(PAF(0), VFR(4), o[1]); o[0] = MF32(PAF(1), VFR(1), o[0]); o[1] = MF32(PAF(1), VFR(5), o[1]);
    o[0] = MF32(PAF(2), VFR(2), o[0]); o[1] = MF32(PAF(2), VFR(6), o[1]); o[0] = MF32(PAF(3), VFR(3), o[0]); o[1] = MF32(PAF(3), VFR(7), o[1]); }
  { auto rr = __builtin_amdgcn_permlane32_swap(__float_as_uint(l_reg), __float_as_uint(l_reg), false, false); l_reg = __uint_as_float(rr[0]) + __uint_as_float(rr[1]); }
  if (hi == 0) wsf[32 + r32] = l_reg; asm volatile("s_waitcnt lgkmcnt(0)" ::: "memory");
  float rli[16];
#pragma unroll
  for (int r = 0; r < 16; ++r) rli[r] = __builtin_amdgcn_rcpf(wsf[32 + crow(r, hi)]);
  { LAS float* stg = (LAS float*)(lds + LDS_STG) + wid * (32 * 36);
#pragma unroll
    for (int d0 = 0; d0 < 2; ++d0) {
      u32x4 gw[2];
#pragma unroll
      for (int i2 = 0; i2 < 2; ++i2) { const size_t qrow = (size_t)(qrow0 + wid * 32 + 16 * i2 + (lane >> 2)); gw[i2] = *(const u32x4*)(GATE + qrow * 1024 + h * 64 + d0 * 32 + 8 * (lane & 3)); }
#pragma unroll
      for (int r = 0; r < 16; ++r) stg[crow(r, hi) * 36 + r32] = o[d0][r] * rli[r];
      asm volatile("s_waitcnt lgkmcnt(0)" ::: "memory");
#pragma unroll
      for (int i2 = 0; i2 < 2; ++i2) { const size_t qrow = (size_t)(qrow0 + wid * 32 + 16 * i2 + (lane >> 2));
        const LAS f32x4* sp = (const LAS f32x4*)(stg + (16 * i2 + (lane >> 2)) * 36 + 8 * (lane & 3)); const f32x4 a0 = sp[0], a1 = sp[1]; const u32x4 g = gw[i2];
        u32x4 w; w.x = pk2(a0[0] * silu_f(lo16(g.x)), a0[1] * silu_f(hi16(g.x))); w.y = pk2(a0[2] * silu_f(lo16(g.y)), a0[3] * silu_f(hi16(g.y)));
        w.z = pk2(a1[0] * silu_f(lo16(g.z)), a1[1] * silu_f(hi16(g.z))); w.w = pk2(a1[2] * silu_f(lo16(g.w)), a1[3] * silu_f(hi16(g.w)));
        *(u32x4*)(BR + qrow * 1024 + h * 64 + d0 * 32 + 8 * (lane & 3)) = w; }
      asm volatile("s_waitcnt lgkmcnt(0)" ::: "memory");
    } }
  asm volatile("s_waitcnt vmcnt(0) lgkmcnt(0)\n\ts_barrier" ::: "memory");
#undef ROWB
#undef DMA_K
#undef DMA_V
#undef START
#undef RESC
#undef ROT
#undef PKW
#undef PAF
#undef VFR
#undef PIN
#undef MX3
#undef GAPA
#undef GAPM
#undef EX
#undef GAPB
#undef VRD
#undef KRD
#undef MF32
#undef STEP
#undef ENDW
}
#undef SBAR
#undef WAIT_BAR
}

template <int FAKE> __device__ __forceinline__ void phase_mla(KArgs a0, const Fr& F0) {
    const Fr F = launder(F0); const KArgs a = klaunder(a0);
    const bf16_t* Q0 = (const bf16_t*)(WSP(a) + WS_Q0); const bf16_t* KV0 = (const bf16_t*)(WSP(a) + WS_KV0); const bf16_t* KR = (const bf16_t*)(WSP(a) + WS_KR);
    const bf16_t* Z = (const bf16_t*)(WSP(a) + WS_GATE); bf16_t* BR = (bf16_t*)(WSP(a) + WS_HB);
    const int vcu = (gridDim.x % 8 == 0) ? ((int)blockIdx.x % 8) * ((int)gridDim.x / 8) + (int)blockIdx.x / 8 : (int)blockIdx.x;
    for (int u = vcu; u < 1024 + 64; u += gridDim.x) {
        __syncthreads();
        if (u < 1024) { const int bh = u >> 4, qb = u & 15, b = bh >> 3, h = bh & 7; if (MLA_V2 && FAKE == 0) mla2::unit<11>(Q0, KV0, KR, Z, BR, b * 4096 + qb * 256, b, h, 4352, F.lds); else mla::unit<FAKE>(Q0, KV0, KR, Z, BR, b * 4096 + qb * 256, b, h, 4352, (char*)F.lds); }
        else { const int bh = u - 1024, b = bh >> 3, h = bh & 7; if (MLA_V2 && FAKE == 0) mla2::unit<11>(Q0, KV0, KR, Z, BR, MLAT + b * 256, b, h, 256, F.lds); else mla::unit<FAKE>(Q0, KV0, KR, Z, BR, MLAT + b * 256, b, h, 256, (char*)F.lds); }
    }
    __syncthreads();
}

namespace na {
using f32x16 = __attribute__((ext_vector_type(16))) float;
constexpr float C1 = 0.125f * 1.4426950408889634f, L2E = 1.4426950408889634f, THR2 = 11.5f;
__device__ __forceinline__ int crow(int r, int hi) { return (r & 3) + 8 * (r >> 2) + 4 * hi; }
__device__ __forceinline__ unsigned cvtpk(float lo, float hi) { unsigned r; asm volatile("v_cvt_pk_bf16_f32 %0, %1, %2" : "=v"(r) : "v"(lo), "v"(hi)); return r; }
constexpr int RING_OFF = 0, SLOT = 16384, NSLOT = 4, TAB_OFF = 69632, WSF_OFF = 73728, STG_OFF = 81920;
template <int FAKE> __device__ __forceinline__ void item(bf16_t* __restrict__ Z, const bf16_t* __restrict__ VT, LAS unsigned char* lds, int b, int h, bool lat, int q4) {
  int tid_ = threadIdx.x; asm volatile("" : "+v"(tid_));
  const int tid = tid_, lane = tid & 63, r32 = lane & 31, hi = lane >> 5, wid = __builtin_amdgcn_readfirstlane(tid >> 6);
  const LAS float* tab = (const LAS float*)(lds + TAB_OFF); LAS float* wsf = (LAS float*)(lds + WSF_OFF) + wid * 64;
  const int rp = 2 * q4 + (wid >> 2), ct = wid & 3;
  int rq = 0, cq = 0, qtok;
  if (lat) { rq = 2 * rp + (r32 >> 4); cq = 16 * ct + (r32 & 15); qtok = b * 4096 + rq * 64 + cq; } else qtok = MLAT + b * 256 + 32 * wid + r32;
  int rs0 = 2 * rp - 4; rs0 = rs0 < 0 ? 0 : (rs0 > 56 ? 56 : rs0);
  int rs1 = 2 * rp - 3; rs1 = rs1 < 0 ? 0 : (rs1 > 56 ? 56 : rs1);
  int u0 = 16 * ct - 8; u0 = u0 < 0 ? 0 : (u0 > 32 ? 32 : u0);
  int rsq = rq - 4; rsq = rsq < 0 ? 0 : (rsq > 56 ? 56 : rsq);
  int csq = cq - 8; csq = csq < 0 ? 0 : (csq > 48 ? 48 : csq);
  int rsA = 4 * q4 - 4; rsA = rsA < 0 ? 0 : (rsA > 56 ? 56 : rsA);
  int rsB = 4 * q4 - 1; rsB = rsB < 0 ? 0 : (rsB > 56 ? 56 : rsB);
  const int nst = lat ? 4 + (rsB - rsA + 8) : 4;
  bf16x8 qr[4];
  { const bf16_t* qp = Z + (size_t)qtok * 4096 + h * 64 + hi * 8;
#pragma unroll
    for (int d0 = 0; d0 < 4; ++d0) qr[d0] = *reinterpret_cast<const bf16x8*>(qp + d0 * 16); }
  const int srow = 8 * wid + (lane >> 3), sch = (lane & 7) ^ ((srow >> 1) & 7);
  const bf16_t* ksrc = Z + (size_t)srow * 4096 + 1024 + h * 64 + 8 * sch;
  const bf16_t* vsrc = VT + ((size_t)sch * 1024 + h * 64 + srow) * 8;
#define TOKB(s) (((s) < 4) ? (MLAT + b * 256 + 64 * (s)) : (b * 4096 + (rsA + (s) - 4) * 64))
  const unsigned ldsb = (unsigned)(uintptr_t)(lds + RING_OFF) + (unsigned)wid * 1024u;
#define GLDS16(gsrc, dst) do { unsigned keep_; asm volatile("s_mov_b32 %0, m0\n\ts_mov_b32 m0, %2\n\ts_nop 0\n\tglobal_load_lds_dwordx4 %1, off\n\ts_mov_b32 m0, %0" : "=&s"(keep_) : "v"(gsrc), "s"(dst) : "memory"); } while (0)
#define ISSUE(s) do { if (FAKE == 1) break; const int tb_ = TOKB(s); const unsigned sl_ = (unsigned)__builtin_amdgcn_readfirstlane(ldsb + (unsigned)(((s) & 3) * SLOT)); \
    GLDS16(ksrc + (size_t)tb_ * 4096, sl_); GLDS16(vsrc + (size_t)(tb_ >> 3) * 8192, sl_ + 8192u); } while (0)
  const int swz = (r32 >> 1) & 7;
  f32x16 o[2] = {}; float m_reg = 0.f, l_reg = 0.f;
#define PK4(P, BASE, OUT) do { unsigned a0 = cvtpk(P[BASE + 0], P[BASE + 1]), a1 = cvtpk(P[BASE + 2], P[BASE + 3]);   \
    unsigned b0 = cvtpk(P[BASE + 4], P[BASE + 5]), b1 = cvtpk(P[BASE + 6], P[BASE + 7]);                              \
    auto r0 = __builtin_amdgcn_permlane32_swap(a0, b0, false, false); auto r1 = __builtin_amdgcn_permlane32_swap(a1, b1, false, false); \
    u32x4 w = {r0[0], r1[0], r0[1], r1[1]}; OUT = *reinterpret_cast<bf16x8*>(&w); } while (0)
#define BLOCK(SL, krow0, kswz, vch0, WIN, kr, FIRSTB) do { \
    bf16x8 kf[4], vf[2][2]; \
    { const LAS unsigned char* kp_ = (SL) + ((krow0) + r32) * 128; \
      _Pragma("unroll") for (int d0 = 0; d0 < 4; ++d0) kf[d0] = *(const LAS bf16x8*)(kp_ + (((2 * d0 + hi) ^ (kswz)) << 4)); \
      _Pragma("unroll") for (int d0 = 0; d0 < 2; ++d0) _Pragma("unroll") for (int ks = 0; ks < 2; ++ks) \
        vf[d0][ks] = *(const LAS bf16x8*)((SL) + 8192 + (32 * d0 + r32) * 128 + ((((vch0) + 2 * ks + hi) ^ swz) << 4)); } \
    f32x16 p; \
    _Pragma("unroll") for (int r = 0; r < 16; ++r) p[r] = -m_reg;                   \
    if (FAKE != 5) { _Pragma("unroll") for (int d0 = 0; d0 < 4; ++d0) p = __builtin_amdgcn_mfma_f32_32x32x16_bf16(kf[d0], qr[d0], p, 0, 0, 0); } \
    if (FAKE != 2) { \
    if (WIN) { \
      const bool rowok = (unsigned)((kr) - rsq) < 8u; \
      const LAS float* tp = tab + ((kr) - rq + 7) * 31 + (u0 - cq + 15) + 4 * hi; \
      const int kc0 = u0 + 4 * hi - csq; \
      _Pragma("unroll") for (int r = 0; r < 16; ++r) { const int off = (r & 3) + 8 * (r >> 2); const bool ok = rowok && ((unsigned)(kc0 + off) < 16u); \
        const float bv = tp[off]; p[r] = ok ? (p[r] + bv) : -1e30f; } \
    } \
    float bmax = p[0]; \
    _Pragma("unroll") for (int r = 1; r < 16; ++r) bmax = fmaxf(bmax, p[r]); \
    { auto rr = __builtin_amdgcn_permlane32_swap(__float_as_uint(bmax), __float_as_uint(bmax), false, false); bmax = fmaxf(__uint_as_float(rr[0]), __uint_as_float(rr[1])); } \
    if ((FIRSTB) || !__all(bmax <= THR2)) { \
      const float dl = (FIRSTB) ? bmax : fmaxf(bmax, 0.f); m_reg += dl; \
      _Pragma("unroll") for (int r = 0; r < 16; ++r) p[r] -= dl; \
      if (!(FIRSTB)) { const float alpha = __builtin_amdgcn_exp2f(-dl); l_reg *= alpha; \
        if (hi == 0) wsf[r32] = alpha; asm volatile("s_waitcnt lgkmcnt(0)" ::: "memory"); \
        _Pragma("unroll") for (int d = 0; d < 2; ++d) _Pragma("unroll") for (int r = 0; r < 16; ++r) o[d][r] *= wsf[crow(r, hi)]; } \
    } \
    float ps = 0.f; \
    _Pragma("unroll") for (int r = 0; r < 16; ++r) { p[r] = __builtin_amdgcn_exp2f(p[r]); ps += p[r]; } \
    l_reg += ps; \
    } \
    bf16x8 pa0, pa1; PK4(p, 0, pa0); PK4(p, 8, pa1); \
    if (FAKE != 4) { _Pragma("unroll") for (int d0 = 0; d0 < 2; ++d0) { o[d0] = __builtin_amdgcn_mfma_f32_32x32x16_bf16(pa0, vf[d0][0], o[d0], 0, 0, 0); o[d0] = __builtin_amdgcn_mfma_f32_32x32x16_bf16(pa1, vf[d0][1], o[d0], 0, 0, 0); } } \
  } while (0)
  const int kswzw = ((u0 + r32) >> 1) & 7;
  ISSUE(0); ISSUE(1);
  for (int s = 0; s < nst; ++s) {
    if (s + 1 < nst) asm volatile("s_waitcnt vmcnt(2)" ::: "memory"); else asm volatile("s_waitcnt vmcnt(0)" ::: "memory");
    asm volatile("s_waitcnt lgkmcnt(0)" ::: "memory");
    if (FAKE != 3) __builtin_amdgcn_s_barrier();
    if (s + 2 < nst) ISSUE(s + 2);
    const LAS unsigned char* sl = lds + RING_OFF + (s & 3) * SLOT;
    if (s == 0) { BLOCK(sl, 0, swz, 0, false, 0, true); BLOCK(sl, 32, swz, 4, false, 0, false); }
    else if (s < 4) { BLOCK(sl, 0, swz, 0, false, 0, false); BLOCK(sl, 32, swz, 4, false, 0, false); }
    else { const int kr = rsA + s - 4; if (kr >= rs0 && kr <= rs1 + 7) BLOCK(sl, u0, kswzw, (u0 >> 3), true, kr, false); }
  }
#undef BLOCK
#undef PK4
#undef ISSUE
#undef GLDS16
#undef TOKB
  { auto rr = __builtin_amdgcn_permlane32_swap(__float_as_uint(l_reg), __float_as_uint(l_reg), false, false); l_reg = __uint_as_float(rr[0]) + __uint_as_float(rr[1]); }
  if (hi == 0) wsf[32 + r32] = l_reg; asm volatile("s_waitcnt lgkmcnt(0)" ::: "memory");
  if (FAKE == 6) return;
  { LAS float* stg = (LAS float*)(lds + STG_OFF) + wid * (32 * 36);
    float rli[16];
#pragma unroll
    for (int r = 0; r < 16; ++r) rli[r] = __builtin_amdgcn_rcpf(wsf[32 + crow(r, hi)]);
#pragma unroll
    for (int d0 = 0; d0 < 2; ++d0) {
      u32x4 gw[2]; size_t toks[2];
#pragma unroll
      for (int i2 = 0; i2 < 2; ++i2) { const int qi = 16 * i2 + (lane >> 2);
        toks[i2] = lat ? (size_t)(b * 4096 + (2 * rp + (qi >> 4)) * 64 + 16 * ct + (qi & 15)) : (size_t)(MLAT + b * 256 + 32 * wid + qi);
        gw[i2] = *(const u32x4*)(Z + toks[i2] * 4096 + 3072 + h * 64 + d0 * 32 + 8 * (lane & 3)); }
#pragma unroll
      for (int r = 0; r < 16; ++r) stg[crow(r, hi) * 36 + r32] = o[d0][r] * rli[r];
      asm volatile("s_waitcnt lgkmcnt(0)" ::: "memory");
#pragma unroll
      for (int i2 = 0; i2 < 2; ++i2) { const LAS f32x4* sp = (const LAS f32x4*)(stg + (16 * i2 + (lane >> 2)) * 36 + 8 * (lane & 3)); const f32x4 a0 = sp[0], a1 = sp[1]; const u32x4 g = gw[i2];
        u32x4 w; w.x = pk2(a0[0] * silu_f(lo16(g.x)), a0[1] * silu_f(hi16(g.x))); w.y = pk2(a0[2] * silu_f(lo16(g.y)), a0[3] * silu_f(hi16(g.y)));
        w.z = pk2(a1[0] * silu_f(lo16(g.z)), a1[1] * silu_f(hi16(g.z))); w.w = pk2(a1[2] * silu_f(lo16(g.w)), a1[3] * silu_f(hi16(g.w)));
        *(u32x4*)(Z + toks[i2] * 4096 + 2048 + h * 64 + d0 * 32 + 8 * (lane & 3)) = w; }
      asm volatile("s_waitcnt lgkmcnt(0)" ::: "memory");
    } }
}
}

template <int FAKE> __device__ __forceinline__ void phase_na(KArgs a0, const Fr& F0, int i, bool need_ctx) {
    const Fr F = launder(F0); const KArgs a = klaunder(a0);
    bf16_t* Z = (bf16_t*)(WSP(a) + WS_Z); const bf16_t* VT = (const bf16_t*)(WSP(a) + WS_VT);
    const float* rpb = INP(a, 25) + (size_t)i * 16 * 465;
    LAS float* tab = (LAS float*)(F.lds + na::TAB_OFF);
    const int vcu = (gridDim.x % 8 == 0) ? ((int)blockIdx.x % 8) * ((int)gridDim.x / 8) + (int)blockIdx.x / 8 : (int)blockIdx.x;
    const int nitems = 8 * 16 * 16 + (need_ctx ? 8 * 16 : 0);
    for (int it = vcu; it < nitems; it += gridDim.x) {
        const bool lat = it < 2048;
        int b, h, q4 = 0;
        if (lat) { q4 = it & 15; h = (it >> 4) & 15; b = it >> 8; } else { const int j = it - 2048; h = j & 15; b = j >> 4; }
        __syncthreads();
        for (int t = F.tid; t < 465; t += NTHR) tab[t] = rpb[h * 465 + t] * na::L2E;
        __syncthreads();
        na::item<FAKE>(Z, VT, F.lds, b, h, lat, q4);
    }
    __syncthreads();
}

__device__ __forceinline__ void run_gemm(const Fr& F, const pg8::GD& g, void* xl = nullptr, void* xc = nullptr, int site = 31, int rot = 0) {
    pg8::Sched S; S.init(g, (int)gridDim.x, (int)((blockIdx.x + rot) % gridDim.x));
    pg8::EpiBf16 E{g.O, g.ldc, g.split_cols, g.vtb, g.ek, g.p1, g.p2, g.p3, g.p4, g.p5, g.i1, xl, xc};
    if ((PROBE_NOEPI >> site) & 1) { pg8::EpiBf16 E0 = E; E0.ek = 99; pg8::gemm_phase<pg8::EpiBf16>(F.lds, g, S, E0); }
    for (int rep = 0; rep < (((PROBE_SITES >> site) & 1) ? 2 : 1); ++rep) pg8::gemm_phase<pg8::EpiBf16>(F.lds, g, S, E);
}

__global__ void __launch_bounds__(NTHR, 2) mega_fwd(Args a_unused) {
    const KArgs a_k = (KArgs)__builtin_amdgcn_kernarg_segment_ptr(); const KArgs a = a_k;
    extern __shared__ __attribute__((aligned(16))) unsigned char lds_raw[];
    cg::grid_group grid = cg::this_grid();
    Fr F; F.lds = (LAS unsigned char*)lds_raw; F.tid = threadIdx.x; F.lane = F.tid & 63; F.wave = __builtin_amdgcn_readfirstlane(F.tid >> 6);
    F.gw = blockIdx.x * NWAVES + F.wave; F.NGW = gridDim.x * NWAVES; F.gt = blockIdx.x * NTHR + F.tid; F.NGT = gridDim.x * NTHR;
    unsigned char* ws = WSP(klaunder(a));
    volatile LAS unsigned* bst = (volatile LAS unsigned*)(F.lds + LDS_BYTES - 64);
    if (F.tid < 16) bst[F.tid] = 0u;
    __syncthreads();
    const unsigned xcc_x = xcd_barrier_post((unsigned*)(ws + WS_CTL) + 4096, bst).x;
#define GSYNC() do { XcdBarrier xb_; xb_.bar = (unsigned*)(WSP(klaunder(a_k)) + WS_CTL) + 4096; { unsigned x_ = xcc_x; asm volatile("" : "+s"(x_)); xb_.x = x_; } xb_.st = (volatile LAS unsigned*)(F.lds + LDS_BYTES - 64); xcd_barrier(xb_); } while (0)
    for (int rep = 0; rep < PROBE_PRO; ++rep) { phase_mod(a, F); phase_s5_setup(a, F, 0); }
    { u32x4* ux = (u32x4*)(ws + WS_UX);
      for (int t = F.gt; t < 32 * (NCHP - NCHR) * 96; t += F.NGT) { const int g = t / ((NCHP - NCHR) * 96), rem = t % ((NCHP - NCHR) * 96); ux[((size_t)(g * NCHP + NCHR)) * 96 + rem] = (u32x4){0u, 0u, 0u, 0u}; } }
    grid.sync();
    for (int rep = 0; rep < PROBE_PRO; ++rep) { phase_weights(a, F, 0); __syncthreads();
    for (int rep2 = 0; rep2 < PROBE_S5; ++rep2) phase_s5_kt(a, F, 0);
    phase_shw(a, F);
    phase_rn0(a, F); }
    GSYNC();
    for (int l = 0; l < 4; ++l) {
        const int i = l >> 1;
        const KArgs a = klaunder(a_k); unsigned char* ws = WSP(a);
        float* Xctx = (float*)(ws + WS_XCTX);
        const float* MODp = (const float*)(ws + WS_MOD); const float* SSQp = (const float*)(ws + WS_SSQ);
        const float* SHWl = (const float*)(ws + WS_SHW) + (size_t)l * 9 * 4096;
        const float* xol = (l == 0) ? INP(a, 0) : (const float*)OUTP(a); const float* xoc = (l == 0) ? INP(a, 2) : (const float*)Xctx;
        const float* gnext = (l < 3) ? INP(a, 6) + (l + 1) * 1024 : nullptr;
        if (l < 3) for (int rep = 0; rep < PROBE_WGT; ++rep) { phase_weights(a, F, l + 1); if (((l + 1) & 1) == 0) phase_s5_setup(a, F, (l + 1) >> 1); __syncthreads(); }
        if ((l & 1) == 0) {
            if (l == 0) for (int rep = 0; rep < PROBE_S5; ++rep) phase_s5_tables(a, F, i);
            { pg8::GD g{(const bf16_t*)(ws + WS_HB), (const bf16_t*)(ws + WS_WEVIN), nullptr, 1024, 1024, EVEN_INP, MROWS / 256, EVEN_INP / 256, 0, 0, 0, 1, SSQp, SHWl, 0, (const void*)ws}; run_gemm(F, g, nullptr, nullptr, 0); }
            GSYNC();
            phase_krope(a, F);
            for (int j = 0; j < 3; ++j) {
                pg8::GD g;
                if (j == 0) g = pg8::GD{(const bf16_t*)(ws + WS_CQ), (const bf16_t*)(ws + WS_WUQ), (bf16_t*)(ws + WS_Q0), 256, 256, 768, MROWS / 256, 3, 0, 0, 0, 3, (const void*)(ws + WS_SSQQ), (const void*)ws, 0, (const void*)ws, (const void*)ws, (const void*)ws, 256};
                else if (j == 1) g = pg8::GD{(const bf16_t*)(ws + WS_CKV), (const bf16_t*)(ws + WS_WUKV), (bf16_t*)(ws + WS_KV0), 128, 128, 1024, MROWS / 256, 4, 0, 0, 0, 4, (const void*)(ws + WS_SSQKV), (const void*)ws, 0, (const void*)ws, (const void*)ws, (const void*)ws, 128};
                else g = pg8::GD{(const bf16_t*)(ws + WS_UX), (const bf16_t*)(ws + WS_BTA), (bf16_t*)(ws + WS_S), 768, 512, 256, 160, 1, 1, 256, 0, 0, (const void*)ws, (const void*)ws, 0, (const void*)ws, (const void*)ws, (const void*)ws, 0};
                run_gemm(F, g, nullptr, nullptr, 1 + j, (j == 0) ? 0 : (j == 1 ? 152 : 96));
            }
            GSYNC();
            phase_e2b(a, F);
            GSYNC();
            { pg8::GD g{(const bf16_t*)(ws + WS_UX), (const bf16_t*)(ws + WS_BTC), (bf16_t*)(ws + WS_G2), 768, 768, 512, 160, 2, 2, 512, 0, 6, nullptr, nullptr}; run_gemm(F, g, nullptr, nullptr, 4); }
#if PROBE_MLAFAKE
            phase_mla<PROBE_MLAFAKE>(a, F);
#endif
            for (int rep = 0; rep < PROBE_MLA; ++rep) phase_mla<0>(a, F);
            GSYNC();
            { pg8::GD g{(const bf16_t*)(ws + WS_G2), (const bf16_t*)(ws + WS_WGLU), (bf16_t*)(ws + WS_HB) + 512, 512, 512, 1024, MROWS / 256, 4, 0, 0, 0, 7, (const void*)(INP(a, 22) + i * 1024), (const void*)((const bf16_t*)(ws + WS_GATE) + 512), 0, nullptr, nullptr, nullptr, 1024}; run_gemm(F, g, nullptr, nullptr, 5); }
            GSYNC();
            { pg8::GD g{(const bf16_t*)(ws + WS_HB), (const bf16_t*)(ws + WS_WEVOUT), (bf16_t*)(ws + WS_Z) + 2048, 1024, 1024, 4096, MROWS / 256, 4, 0, 0, 0, 8, xol, xoc, 0, MODp, gnext, (void*)(ws + WS_SSQ), l}; run_gemm(F, g, OUTP(a), Xctx); }
            GSYNC();
        } else {
            for (int j = 0; j < 3; ++j) {
                pg8::GD g;
                if (j == 0) g = pg8::GD{(const bf16_t*)(ws + WS_Z) + 2048, (const bf16_t*)(ws + WS_WNAIN), (bf16_t*)(ws + WS_Z), 4096, 1024, 4096, MROWS / 256, 8, 0, 0, 0, 9, SSQp, SHWl, 0, (const void*)ws, (const void*)ws, (const void*)ws, 1024};
                else if (j == 1) g = pg8::GD{(const bf16_t*)(ws + WS_Z) + 2048, (const bf16_t*)(ws + WS_WNAIN) + (size_t)3072 * 1024, (bf16_t*)(ws + WS_Z) + 3072, 4096, 1024, 4096, MROWS / 256, 4, 0, 0, 0, 9, SSQp, SHWl + 3072, 0, (const void*)ws, (const void*)ws, (const void*)ws, 0};
                else g = pg8::GD{(const bf16_t*)(ws + WS_WNAIN) + (size_t)2048 * 1024, (const bf16_t*)(ws + WS_Z) + 2048, (bf16_t*)(ws + WS_VT), 1024, 1024, 1024, 4, MROWS / 256, 0, 0, 1, 10, SSQp, SHWl + 2048, 4096, (const void*)ws, (const void*)ws, (const void*)ws, 0};
                run_gemm(F, g, nullptr, nullptr, 7 + j, (j == 0) ? 0 : (j == 1 ? 64 : 96));
            }
            GSYNC();
            if (l == 1) for (int rep = 0; rep < PROBE_S5; ++rep) phase_s5_kt(a, F, 1);
#if PROBE_NAFAKE
            phase_na<PROBE_NAFAKE>(a, F, i, l < 3);
#endif
            for (int rep = 0; rep < PROBE_NA; ++rep) phase_na<0>(a, F, i, l < 3);
            GSYNC();
            if (l == 1) for (int rep = 0; rep < PROBE_S5; ++rep) phase_s5_tables(a, F, 1);
            { pg8::GD g{(const bf16_t*)(ws + WS_Z) + 2048, (const bf16_t*)(ws + WS_WNAOUT), (bf16_t*)(ws + WS_HB), 4096, 1024, 1024, (l < 3) ? MROWS / 256 : MLAT / 256, 4, 0, 0, 0, 8, xol, xoc, 0, MODp, gnext, (void*)(ws + WS_SSQ), l}; run_gemm(F, g, OUTP(a), Xctx); }
            GSYNC();
        }
    }
    phase_final(a, F);
}

extern "C" void kernel_launch(void* const* d_in, const int* in_sizes, int n_in, void* d_out, int out_size, void* d_ws, size_t ws_size, hipStream_t stream) {
    static int grid = 0;
    if (grid == 0) {
        if (n_in != 27 || ws_size < WS_END) { fprintf(stderr, "kernel_launch: unexpected n_in %d / ws_size %zu\n", n_in, ws_size); grid = -1; return; }
        int dev = 0, cus = 0, per_cu = 0;
        hipGetDevice(&dev);
        hipDeviceGetAttribute(&cus, hipDeviceAttributeMultiprocessorCount, dev);
        hipFuncSetAttribute((const void*)mega_fwd, hipFuncAttributeMaxDynamicSharedMemorySize, LDS_BYTES);
        hipOccupancyMaxActiveBlocksPerMultiprocessor(&per_cu, (const void*)mega_fwd, NTHR, LDS_BYTES);
        if (per_cu < 1) { fprintf(stderr, "kernel_launch: occupancy query says %d blocks per CU\n", per_cu); per_cu = 1; }
        grid = cus * 1;
        (void)hipGetLastError();
    }
    if (grid < 0) return;
    (void)hipMemsetAsync((char*)d_ws + WS_CTL, 0, 64 * 1024, stream);
    Args a{};
    for (int i = 0; i < 27; ++i) a.in[i] = (const float*)d_in[i];
    a.out = (float*)d_out; a.ws = (unsigned char*)d_ws;
    void* params[] = {&a};
    hipError_t e = hipLaunchCooperativeKernel((const void*)mega_fwd, dim3(grid), dim3(NTHR), params, LDS_BYTES, stream);
    if (e != hipSuccess) fprintf(stderr, "cooperative launch failed: %s (grid %d)\n", hipGetErrorString(e), grid);
}
```

```cpp
#include <hip/hip_runtime.h>
#include <hip/hip_cooperative_groups.h>
#include <cstdio>
#include <cstdint>
#include <cmath>
namespace cg = cooperative_groups;

#define LAS __attribute__((address_space(3)))
#define GASP __attribute__((address_space(1)))
template <class T> __device__ __forceinline__ T* gptr(const void* p) { return (T*)(GASP T*)(T*)p; }
typedef unsigned short bf16_t;
typedef short bf16x8 __attribute__((ext_vector_type(8)));
typedef float f32x4 __attribute__((ext_vector_type(4)));
typedef float f32x2 __attribute__((ext_vector_type(2)));
typedef unsigned u32x4 __attribute__((ext_vector_type(4)));
typedef unsigned u32x2 __attribute__((ext_vector_type(2)));

constexpr int DM = 1024, NB = 8, SEQ = 4096, CTXL = 256;
constexpr int MLAT = NB * SEQ, MCTX = NB * CTXL, MROWS = MLAT + MCTX;
constexpr int EVEN_IN = 1952, EVEN_INP = 2048;
constexpr int EV_S1 = 256, EV_S2 = 384, EV_S3 = 416, EV_S4 = 928, EV_S5 = 1440;
constexpr int NCH = 136, NCHP = 1280, NCHR = NB * NCH;
constexpr float EPS = 1e-6f;

constexpr size_t MiB = 1u << 20;
constexpr size_t WS_CTL = 0, WS_MOD = 1 * MiB, WS_BB = 2 * MiB + 256 * 1024, WS_POW = 3 * MiB, WS_KT = 5 * MiB, WS_BTA = 8 * MiB, WS_BTC = 16 * MiB;
constexpr size_t WS_WEVIN = 40 * MiB, WS_WUQ = 44 * MiB, WS_WUKV = 44 * MiB + 512 * 1024, WS_WGLU = 45 * MiB, WS_WEVOUT = 46 * MiB, WS_WNAIN = 48 * MiB, WS_WNAOUT = 56 * MiB;
constexpr size_t WS_XCTX = 58 * MiB, WS_HB = 66 * MiB, WS_Z = 134 * MiB;
constexpr size_t WS_GATE = 134 * MiB;
constexpr size_t WS_CQ = 202 * MiB, WS_CKV = 219 * MiB, WS_SSQQ = 228 * MiB, WS_SSQKV = 229 * MiB, WS_KR = 230 * MiB, WS_S = 233 * MiB;
constexpr size_t WS_UX = 289 * MiB, WS_Q0 = 350 * MiB, WS_KV0 = 402 * MiB;
constexpr size_t WS_G2 = 254 * MiB;
constexpr size_t WS_VT = 406 * MiB;
constexpr size_t WS_SSQ = 498 * MiB;
constexpr size_t WS_SHW = 501 * MiB;
constexpr size_t WS_END = 502 * MiB;

struct Args { const float* in[27]; float* out; unsigned char* ws; };
typedef const __attribute__((address_space(4))) Args* KArgs;
__device__ __forceinline__ KArgs klaunder(KArgs a) { asm volatile("" : "+s"(a)); return a; }
__device__ __forceinline__ unsigned char* WSP(KArgs a) { return (unsigned char*)(GASP unsigned char*)a->ws; }
__device__ __forceinline__ const float* INP(KArgs a, int k) { return (const float*)(GASP const float*)a->in[k]; }
__device__ __forceinline__ float* OUTP(KArgs a) { return (float*)(GASP float*)a->out; }

__device__ __forceinline__ float bf2f(bf16_t v) { return __uint_as_float(((unsigned)v) << 16); }
__device__ __forceinline__ unsigned f2bf(float f) { unsigned u = __float_as_uint(f); return (u + 0x7fffu + ((u >> 16) & 1u)) >> 16; }
__device__ __forceinline__ unsigned pk2(float lo, float hi) { return f2bf(lo) | (f2bf(hi) << 16); }
__device__ __forceinline__ float lo16(unsigned w) { return __uint_as_float(w << 16); }
__device__ __forceinline__ float hi16(unsigned w) { return __uint_as_float(w & 0xffff0000u); }
__device__ __forceinline__ float wave_sum(float v) {
#pragma unroll
    for (int o = 1; o < 64; o <<= 1) v += __shfl_xor(v, o);
    return v;
}
__device__ __forceinline__ float silu_f(float v) { return v / (1.f + expf(-v)); }
__device__ __forceinline__ float gelu_tanh_f(float v) { const float u = 0.7978845608028654f * (v + 0.044715f * v * v * v); return v * (1.f - __builtin_amdgcn_rcpf(1.f + __expf(2.f * u))); }

namespace pg8 {
constexpr int BM = 256, BK = 64, HALF = 128, HTB = HALF * BK * 2, STAGE_BYTES = 8 * HTB, NXCD = 8, WGM = 8;
__host__ __device__ __forceinline__ int lds_byte(int r, int c) { const int st = (r >> 4) * 2 + (c >> 5), rr = r & 15, cc = c & 31, ob = rr * 64 + cc * 2; return st * 1024 + (ob ^ (((ob >> 9) & 1) << 5)); }
__host__ __device__ __forceinline__ void stage_rc(int b, int& R, int& C) { const int st = b / 1024, sb = b % 1024, swz = sb ^ (((sb >> 9) & 1) << 5); R = (st >> 1) * 16 + swz / 64; C = (st & 1) * 32 + (swz % 64) / 2; }
__host__ __device__ __forceinline__ int perm32(int rho) { const int n = rho >> 4, i = rho & 15; return 8 * (i >> 2) + 4 * n + (i & 3); }

struct Unit { int pm, pn; };
struct GD { const bf16_t* A; const bf16_t* Bt; bf16_t* O; int lda, K, ldc, nM, nN, mode, split_cols, vtb, ek; const void* p1; const void* p2; int ldb; const void* p3; const void* p4; const void* p5; int i1; };

struct Sched {
    int nM, nN, nwg, G, c, mode;
    __device__ __forceinline__ void init(const GD& g, int G_, int c_) { nM = g.nM; nN = g.nN; mode = g.mode; nwg = (mode == 0) ? nM * nN : (mode == 1 ? 160 : 320); G = G_; c = c_; }
    __device__ __forceinline__ bool next(int i, Unit& u) const {
        const long L = (long)i * G + c; if (L >= nwg) return false;
        int wgid = (int)L;
        if (mode == 1) { u.pm = wgid; u.pn = wgid / 5; return true; }
        if (mode == 2) { const int g = wgid / 10, rem = wgid % 10; u.pm = g * 5 + (rem >> 1); u.pn = 2 * g + (rem & 1); return true; }
        { const int q = nwg / NXCD, r = nwg % NXCD, xcd = wgid % NXCD, off = wgid / NXCD; wgid = (xcd < r ? xcd * (q + 1) : r * (q + 1) + (xcd - r) * q) + off; }
        const int nig = WGM * nN, gid = wgid / nig, fm = gid * WGM, gsz = (nM - fm) < WGM ? (nM - fm) : WGM;
        u.pm = fm + ((wgid % nig) % gsz); u.pn = (wgid % nig) / gsz; return true;
    }
};

__device__ __forceinline__ unsigned cvt_pk_bf16(float lo, float hi) { unsigned r; asm volatile("v_cvt_pk_bf16_f32 %0, %1, %2" : "=v"(r) : "v"(lo), "v"(hi)); return r; }

struct EpiBf16 {
    static constexpr bool PERM = true;
    bf16_t* O_; int ldc; int split_cols; int vtb; int ek; const void* p1; const void* p2; const void* p3; const void* p4; const void* p5; int i1; void* xl_; void* xc_;
    __device__ __forceinline__ void operator()(const f32x4 (&acc)[2][2][4][2], const Unit& u, int wr, int wc, int fr, int fq) const {
        bf16_t* const O = gptr<bf16_t>(this->O_);
        if (ek == 99) {
            f32x4 s = {0.f, 0.f, 0.f, 0.f};
#pragma unroll
            for (int ai = 0; ai < 2; ++ai)
#pragma unroll
                for (int bj = 0; bj < 2; ++bj)
#pragma unroll
                    for (int m = 0; m < 4; ++m) s += acc[ai][bj][m][0] + acc[ai][bj][m][1];
            if (s[0] + s[1] + s[2] + s[3] == 12345.678f) ((float*)p5)[0] = s[0];
            return; }
        const int row0 = u.pm * BM + wr * 64 + fr; int colt = u.pn * BM;
        if (ek == 6) {
            const int g = u.pn >> 1, cl0 = (u.pn & 1) * BM + wc * 32 + 8 * fq;
#pragma unroll
            for (int ai = 0; ai < 2; ++ai)
#pragma unroll
                for (int m = 0; m < 4; ++m) { const int R = row0 + ai * HALF + m * 16 - g * NCHP;
                    if (R < NCHR) { const int b = R / NCH, cc = R - b * NCH; const int tok0 = (cc < 8) ? MLAT + b * 256 + cc * 32 : b * 4096 + (cc - 8) * 32;
#pragma unroll
                        for (int bj = 0; bj < 2; ++bj) { const int cl = cl0 + bj * HALF, t = cl >> 4, h0 = cl & 15; const f32x4 v0 = acc[ai][bj][m][0], v1 = acc[ai][bj][m][1];
                            u32x4 w; w.x = cvt_pk_bf16(gelu_tanh_f(v0[0]), gelu_tanh_f(v0[1])); w.y = cvt_pk_bf16(gelu_tanh_f(v0[2]), gelu_tanh_f(v0[3]));
                            w.z = cvt_pk_bf16(gelu_tanh_f(v1[0]), gelu_tanh_f(v1[1])); w.w = cvt_pk_bf16(gelu_tanh_f(v1[2]), gelu_tanh_f(v1[3]));
                            *(u32x4*)(O + (size_t)(tok0 + t) * 512 + 16 * g + h0) = w; } } }
            return;
        }
        if (ek == 7) {
            const float* bias = gptr<const float>(p1); const bf16_t* zg = gptr<const bf16_t>(p2);
            const int ch0 = u.pn * HALF + wc * 32 + 8 * fq;
            const f32x4 ba0 = *(const f32x4*)(bias + ch0), ba1 = *(const f32x4*)(bias + ch0 + 4), bg0 = *(const f32x4*)(bias + 512 + ch0), bg1 = *(const f32x4*)(bias + 512 + ch0 + 4);
            u32x4 wzv[2][4];
#pragma unroll
            for (int ai = 0; ai < 2; ++ai)
#pragma unroll
                for (int m = 0; m < 4; ++m) wzv[ai][m] = *(const u32x4*)(zg + (size_t)(row0 + ai * HALF + m * 16) * (size_t)i1 + ch0);
#pragma unroll
            for (int ai = 0; ai < 2; ++ai)
#pragma unroll
                for (int m = 0; m < 4; ++m) { const size_t row = (size_t)(row0 + ai * HALF + m * 16);
                    const u32x4 wz = wzv[ai][m];
                    const f32x4 a0 = acc[ai][0][m][0] + ba0, a1 = acc[ai][0][m][1] + ba1, g0 = acc[ai][1][m][0] + bg0, g1 = acc[ai][1][m][1] + bg1;
#define GLX(av, gv, zv) ((av) * __builtin_amdgcn_rcpf(1.f + __expf(-(gv))) * silu_f(zv))
                    u32x4 w; w.x = cvt_pk_bf16(GLX(a0[0], g0[0], lo16(wz.x)), GLX(a0[1], g0[1], hi16(wz.x))); w.y = cvt_pk_bf16(GLX(a0[2], g0[2], lo16(wz.y)), GLX(a0[3], g0[3], hi16(wz.y)));
                    w.z = cvt_pk_bf16(GLX(a1[0], g1[0], lo16(wz.z)), GLX(a1[1], g1[1], hi16(wz.z))); w.w = cvt_pk_bf16(GLX(a1[2], g1[2], lo16(wz.w)), GLX(a1[3], g1[3], hi16(wz.w)));
#undef GLX
                    *(u32x4*)(O + row * ldc + ch0) = w; }
            return;
        }
        if (ek == 1) {
            unsigned char* wsb = gptr<unsigned char>(p3);
            bf16_t* CQ = (bf16_t*)(wsb + WS_CQ); bf16_t* CKV = (bf16_t*)(wsb + WS_CKV); bf16_t* KRo = (bf16_t*)(wsb + WS_KR); bf16_t* GATE = (bf16_t*)(wsb + WS_GATE); bf16_t* UXo = (bf16_t*)(wsb + WS_UX);
            float* SSQQ = (float*)(wsb + WS_SSQQ); float* SSQKV = (float*)(wsb + WS_SSQKV);
            const int bi = (u.pm < 128) ? (u.pm >> 4) : 8;
            const float* ssq = gptr<const float>(p1);
            f32x4 sw[2][2];
#pragma unroll
            for (int bj = 0; bj < 2; ++bj) { const float* shw = gptr<const float>(p2) + (size_t)bi * 4096 + colt + bj * HALF + wc * 32 + 8 * fq; sw[bj][0] = *(const f32x4*)shw; sw[bj][1] = *(const f32x4*)(shw + 4); }
#pragma unroll
            for (int ai = 0; ai < 2; ++ai) {
                float rsv[4];
#pragma unroll
                for (int m = 0; m < 4; ++m) { const f32x4 s0 = *((const f32x4*)(ssq + (size_t)(row0 + ai * HALF + m * 16) * 16) + fq);
                    float tot = (s0[0] + s0[1]) + (s0[2] + s0[3]); tot += __shfl_xor(tot, 16); tot += __shfl_xor(tot, 32);
                    rsv[m] = 1.0f / sqrtf(tot * (1.f / 1024.f) + EPS); }
#pragma unroll
                for (int m = 0; m < 4; ++m) { const int row = row0 + ai * HALF + m * 16;
                    const float rs = rsv[m];
                    float ss = 0.f;
#pragma unroll
                    for (int bj = 0; bj < 2; ++bj) { const int cw = colt + bj * HALF + wc * 32, c0 = cw + 8 * fq;
                        const f32x4 v0 = acc[ai][bj][m][0] * rs + sw[bj][0], v1 = acc[ai][bj][m][1] * rs + sw[bj][1];
                        u32x4 w; w.x = cvt_pk_bf16(v0[0], v0[1]); w.y = cvt_pk_bf16(v0[2], v0[3]); w.z = cvt_pk_bf16(v1[0], v1[1]); w.w = cvt_pk_bf16(v1[2], v1[3]);
                        if (cw < EV_S1) { *(u32x4*)(CQ + (size_t)row * 256 + c0) = w; ss += (v0[0] * v0[0] + v0[1] * v0[1]) + (v0[2] * v0[2] + v0[3] * v0[3]) + (v1[0] * v1[0] + v1[1] * v1[1]) + (v1[2] * v1[2] + v1[3] * v1[3]); }
                        else if (cw < EV_S2) { *(u32x4*)(CKV + (size_t)row * 128 + (c0 - EV_S1)) = w; ss += (v0[0] * v0[0] + v0[1] * v0[1]) + (v0[2] * v0[2] + v0[3] * v0[3]) + (v1[0] * v1[0] + v1[1] * v1[1]) + (v1[2] * v1[2] + v1[3] * v1[3]); }
                        else if (cw < EV_S3) *(u32x4*)(KRo + (size_t)row * 32 + (c0 - EV_S2)) = w;
                        else if (cw < EV_S4) *(u32x4*)(GATE + (size_t)row * 1024 + (c0 - EV_S3)) = w;
                        else if (cw < EV_S5) { const int ch = c0 - EV_S4; int R, s;
                            if (row < MLAT) { const int b = row >> 12, t = row & 4095; R = b * NCH + 8 + (t >> 5); s = t & 31; } else { const int r = row - MLAT, b = r >> 8, t = r & 255; R = b * NCH + (t >> 5); s = t & 31; }
                            *(u32x4*)(UXo + ((size_t)((ch >> 4) * NCHP + R)) * 768 + s * 16 + (ch & 15)) = w; }
                        else if (cw < EVEN_IN) *(u32x4*)(GATE + (size_t)row * 1024 + 512 + (c0 - EV_S5)) = w;
                    }
                    if (u.pn <= 1) { ss += __shfl_xor(ss, 16); ss += __shfl_xor(ss, 32);
                        if (fq == 0) { if (u.pn == 0) SSQQ[(size_t)row * 4 + wc] = ss; else SSQKV[(size_t)row * 4 + wc] = ss; } }
                    asm volatile("" ::: "memory");
                }
            }
            return;
        }
        if (ek == 3 || ek == 4) {
            const float* ssp = gptr<const float>(p1); const float invw = 1.0f / (float)i1;
            const int c00 = colt + wc * 32 + 8 * fq;
            float rstdv[2][4];
#pragma unroll
            for (int ai = 0; ai < 2; ++ai)
#pragma unroll
                for (int m = 0; m < 4; ++m) { const f32x4 s4 = *(const f32x4*)(ssp + (size_t)(row0 + ai * HALF + m * 16) * 4);
                    rstdv[ai][m] = ((ek == 3) ? 0.14724444f : 1.0f) / sqrtf(((s4[0] + s4[1]) + (s4[2] + s4[3])) * invw + EPS); }
#pragma unroll
            for (int ai = 0; ai < 2; ++ai)
#pragma unroll
                for (int m = 0; m < 4; ++m) { const int row = row0 + ai * HALF + m * 16;
                    const float rstd = rstdv[ai][m];
                    const bool lat = row < MLAT; const int t = row & 4095;
#pragma unroll
                    for (int bj = 0; bj < 2; ++bj) { const int c0 = c00 + bj * HALF; f32x4 v0 = acc[ai][bj][m][0] * rstd, v1 = acc[ai][bj][m][1] * rstd;
                        if (ek == 3) { const int d0 = c0 % 96; const bool rope = lat && (d0 >= 64); const int r0 = d0 - 64;
                            float vv[8] = {v0[0], v0[1], v0[2], v0[3], v1[0], v1[1], v1[2], v1[3]}, pv[8];
#pragma unroll
                            for (int e = 0; e < 8; ++e) pv[e] = __shfl_xor(vv[e], 16);
                            if (rope) { const float pos = (float)((r0 >> 4) ? (t & 63) : (t >> 6)); const bool hf = (r0 >> 3) & 1;
#pragma unroll
                                for (int e = 0; e < 8; ++e) { const float ang = pos * exp2f(-(float)e * (13.287712379549449f / 8.f)); const float sn = __sinf(ang), cs = __cosf(ang);
                                    vv[e] = hf ? (vv[e] * cs + pv[e] * sn) : (vv[e] * cs - pv[e] * sn); }
                                v0 = (f32x4){vv[0], vv[1], vv[2], vv[3]}; v1 = (f32x4){vv[4], vv[5], vv[6], vv[7]}; } }
                        u32x4 w; w.x = cvt_pk_bf16(v0[0], v0[1]); w.y = cvt_pk_bf16(v0[2], v0[3]); w.z = cvt_pk_bf16(v1[0], v1[1]); w.w = cvt_pk_bf16(v1[2], v1[3]);
                        *(u32x4*)(O + (size_t)row * ldc + c0) = w; } }
            return;
        }
        if (ek == 8) {
            const int l = i1 & 7; float* Xl = gptr<float>(xl_); float* Xc = gptr<float>(xc_); const float* xol_ = gptr<const float>(p1); const float* xoc_ = gptr<const float>(p2);
            const int bi = (u.pm < 128) ? (u.pm >> 4) : 8;
            const float* modl = gptr<const float>(p3) + (size_t)(l * 9 + bi) * 3072; const float* modn = gptr<const float>(p3) + (size_t)((l + 1) * 9 + bi) * 3072;
            const float* gam = p4 ? gptr<const float>(p4) : nullptr; float* ssq = gptr<float>(p5);
            const int c0 = u.pn * BM + wc * 32 + 8 * fq;
            f32x4 gt[2][2], gm[2][2];
#pragma unroll
            for (int bj = 0; bj < 2; ++bj)
#pragma unroll
                for (int n = 0; n < 2; ++n) { const int c = c0 + bj * HALF + 4 * n; gt[bj][n] = *(const f32x4*)(modl + 2048 + c);
                    if (gam) { const f32x4 g4 = *(const f32x4*)(gam + c), s4 = *(const f32x4*)(modn + 1024 + c); gm[bj][n] = g4 * (s4 + 1.0f); } else gm[bj][n] = (f32x4){0.f, 0.f, 0.f, 0.f}; }
#pragma unroll
            for (int ai = 0; ai < 2; ++ai)
#pragma unroll
              for (int mh = 0; mh < 2; ++mh) {
                f32x4 xpre[2][2][2];
#pragma unroll
                for (int mm = 0; mm < 2; ++mm) { const int row = row0 + ai * HALF + (2 * mh + mm) * 16; const bool lat = row < MLAT;
                    const float* xo = (lat ? xol_ : xoc_) + (lat ? (size_t)row * 1024 : (size_t)(row - MLAT) * 1024);
#pragma unroll
                    for (int bj = 0; bj < 2; ++bj)
#pragma unroll
                        for (int n = 0; n < 2; ++n) xpre[mm][bj][n] = *(const f32x4*)(xo + c0 + bj * HALF + 4 * n); }
#pragma unroll
                for (int mm = 0; mm < 2; ++mm) { const int m = 2 * mh + mm; const int row = row0 + ai * HALF + m * 16; const bool lat = row < MLAT;
                    const size_t ro = lat ? (size_t)row * 1024 : (size_t)(row - MLAT) * 1024;
                    float* xw = (lat ? Xl : Xc) + ro;
                    float ss = 0.f;
#pragma unroll
                    for (int bj = 0; bj < 2; ++bj) { f32x4 xn[2];
#pragma unroll
                        for (int n = 0; n < 2; ++n) { const int c = c0 + bj * HALF + 4 * n; const f32x4 xv = xpre[mm][bj][n]; xn[n] = xv + gt[bj][n] * acc[ai][bj][m][n];
                            *(f32x4*)(xw + c) = xn[n]; ss += (xn[n][0] * xn[n][0] + xn[n][1] * xn[n][1]) + (xn[n][2] * xn[n][2] + xn[n][3] * xn[n][3]); }
                        if (gam) { const f32x4 a0 = xn[0] * gm[bj][0], a1 = xn[1] * gm[bj][1];
                            u32x4 w; w.x = cvt_pk_bf16(a0[0], a0[1]); w.y = cvt_pk_bf16(a0[2], a0[3]); w.z = cvt_pk_bf16(a1[0], a1[1]); w.w = cvt_pk_bf16(a1[2], a1[3]);
                            *(u32x4*)(O + (size_t)row * ldc + c0 + bj * HALF) = w; } }
                    ss += __shfl_xor(ss, 16); ss += __shfl_xor(ss, 32);
                    if (fq == 0) ssq[(size_t)row * 16 + u.pn * 4 + wc] = ss; }
            }
            return;
        }
        if (split_cols) { const int t = colt / split_cols; colt -= t * split_cols; }
        const int col0 = colt + wc * 32 + 8 * fq;
        if (ek == 9) {
            const int bi = (u.pm < 128) ? (u.pm >> 4) : 8;
            const float* shw = (const float*)p2 + (size_t)bi * 4096 + col0; const float* ssq = gptr<const float>(p1);
            f32x4 sw[2][2];
#pragma unroll
            for (int bj = 0; bj < 2; ++bj) { sw[bj][0] = *(const f32x4*)(shw + bj * HALF); sw[bj][1] = *(const f32x4*)(shw + bj * HALF + 4); }
            float rsv[2][4];
#pragma unroll
            for (int ai = 0; ai < 2; ++ai)
#pragma unroll
                for (int m = 0; m < 4; ++m) { const f32x4 s0 = *((const f32x4*)(ssq + (size_t)(row0 + ai * HALF + m * 16) * 16) + fq);
                    float tot = (s0[0] + s0[1]) + (s0[2] + s0[3]); tot += __shfl_xor(tot, 16); tot += __shfl_xor(tot, 32);
                    rsv[ai][m] = 1.0f / sqrtf(tot * (1.f / 1024.f) + EPS); }
#pragma unroll
            for (int ai = 0; ai < 2; ++ai)
#pragma unroll
                for (int m = 0; m < 4; ++m) { const int row = row0 + ai * HALF + m * 16;
                    const float rs = rsv[ai][m];
                    bf16_t* rowp = O + (size_t)row * ldc + col0;
#pragma unroll
                    for (int bj = 0; bj < 2; ++bj) { f32x4 v0 = acc[ai][bj][m][0] * rs + sw[bj][0], v1 = acc[ai][bj][m][1] * rs + sw[bj][1];
                        if (colt < i1) { v0 *= 0.18033688f; v1 *= 0.18033688f; }
                        u32x4 w; w.x = cvt_pk_bf16(v0[0], v0[1]); w.y = cvt_pk_bf16(v0[2], v0[3]); w.z = cvt_pk_bf16(v1[0], v1[1]); w.w = cvt_pk_bf16(v1[2], v1[3]);
                        *(u32x4*)(rowp + bj * HALF) = w; } }
            return;
        }
        if (ek == 10) {
            const int bi = (u.pn < 128) ? (u.pn >> 4) : 8;
            const float* shw = (const float*)p2 + (size_t)bi * 4096; const float* ssq = gptr<const float>(p1);
            f32x4 rs4[2][2];
#pragma unroll
            for (int bj = 0; bj < 2; ++bj)
#pragma unroll
                for (int n = 0; n < 2; ++n)
#pragma unroll
                    for (int j = 0; j < 4; ++j) { const f32x4* sp = (const f32x4*)(ssq + (size_t)(col0 + bj * HALF + 4 * n + j) * 16); const f32x4 s0 = sp[0], s1 = sp[1], s2 = sp[2], s3 = sp[3];
                        const float tot = ((s0[0] + s0[1]) + (s0[2] + s0[3])) + ((s1[0] + s1[1]) + (s1[2] + s1[3])) + ((s2[0] + s2[1]) + (s2[2] + s2[3])) + ((s3[0] + s3[1]) + (s3[2] + s3[3]));
                        rs4[bj][n][j] = 1.0f / sqrtf(tot * (1.f / 1024.f) + EPS); }
            float shv[2][4];
#pragma unroll
            for (int ai = 0; ai < 2; ++ai)
#pragma unroll
                for (int m = 0; m < 4; ++m) shv[ai][m] = shw[row0 + ai * HALF + m * 16];
#pragma unroll
            for (int ai = 0; ai < 2; ++ai)
#pragma unroll
                for (int m = 0; m < 4; ++m) { const int row = row0 + ai * HALF + m * 16; const float sh = shv[ai][m];
#pragma unroll
                    for (int bj = 0; bj < 2; ++bj) { const f32x4 v0 = acc[ai][bj][m][0] * rs4[bj][0] + sh, v1 = acc[ai][bj][m][1] * rs4[bj][1] + sh;
                        u32x4 w; w.x = cvt_pk_bf16(v0[0], v0[1]); w.y = cvt_pk_bf16(v0[2], v0[3]); w.z = cvt_pk_bf16(v1[0], v1[1]); w.w = cvt_pk_bf16(v1[2], v1[3]);
                        *(u32x4*)(O + ((size_t)((col0 + bj * HALF) >> 3) * ldc + row) * 8) = w; } }
            return;
        }
#pragma unroll
        for (int ai = 0; ai < 2; ++ai)
#pragma unroll
            for (int m = 0; m < 4; ++m) { bf16_t* rowp = O + (size_t)(row0 + ai * HALF + m * 16) * ldc + col0;
#pragma unroll
                for (int bj = 0; bj < 2; ++bj) { const f32x4 v0 = acc[ai][bj][m][0], v1 = acc[ai][bj][m][1];
                    u32x4 w; w.x = cvt_pk_bf16(v0[0], v0[1]); w.y = cvt_pk_bf16(v0[2], v0[3]); w.z = cvt_pk_bf16(v1[0], v1[1]); w.w = cvt_pk_bf16(v1[2], v1[3]);
                    if (vtb) *(u32x4*)(O + ((size_t)((col0 + bj * HALF) >> 3) * ldc + (row0 + ai * HALF + m * 16)) * 8) = w;
                    else *(u32x4*)(rowp + bj * HALF) = w; } }
    }
};

template <class Epi>
__device__ __forceinline__ void gemm_phase(LAS unsigned char* lds, const GD g, const Sched& S, const Epi& E) {
    int tid_ = threadIdx.x; asm volatile("" : "+v"(tid_));
    const int tid = tid_, wid = __builtin_amdgcn_readfirstlane(tid >> 6), lane = tid & 63, wr = wid >> 2, wc = wid & 3, fr = lane & 15, fq = lane >> 4;
    const int K = g.K, nt = K / BK, lda = g.lda, ldb = g.ldb ? g.ldb : g.K;
    unsigned voffA[2], voffB[2];
#pragma unroll
    for (int i = 0; i < 2; ++i) { int R, C; stage_rc(tid * 16 + i * 8192, R, C); const int Rb = Epi::PERM ? ((R & ~31) + perm32(R & 31)) : R;
        voffA[i] = (unsigned)(R * lda + C) * 2u; voffB[i] = (unsigned)(Rb * ldb + C) * 2u; }
    const size_t kstep = (size_t)(BK * 2);
    const size_t hstepA = (size_t)HALF * lda * 2, hstepB = (size_t)HALF * ldb * 2;
    const size_t tstepA = 2 * hstepA, tstepB = 2 * hstepB;
    const unsigned ldsw = (unsigned)wid * 1024u;
    const int aoff = lds_byte(wr * 64 + fr, fq * 8), boff = lds_byte(wc * 32 + fr, fq * 8);
#define PG8_SA(b, h) (((b) * 2 + (h)) * HTB)
#define PG8_SB(b, h) ((4 + (b) * 2 + (h)) * HTB)
#define PG8_STAGE(bufoff, gbase, voff) do { _Pragma("unroll") for (int _i = 0; _i < 2; ++_i) \
        __builtin_amdgcn_global_load_lds((const unsigned*)((const char*)(gbase) + (voff)[_i]), (LAS unsigned*)(lds + (bufoff) + ldsw + _i * 8192), 16, 0, 0); } while (0)
#define PG8_LDA(dst, b, h) do { _Pragma("unroll") for (int m = 0; m < 4; ++m) _Pragma("unroll") for (int k = 0; k < 2; ++k) dst[m][k] = *(const LAS bf16x8*)(lds + PG8_SA(b, h) + aoff + m * 2048 + k * 1024); } while (0)
#define PG8_LDB(dst, b, h) do { _Pragma("unroll") for (int n = 0; n < 2; ++n) _Pragma("unroll") for (int k = 0; k < 2; ++k) dst[n][k] = *(const LAS bf16x8*)(lds + PG8_SB(b, h) + boff + n * 2048 + k * 1024); } while (0)
#define PG8_MMA(ai, bj, At, Bt) do { __builtin_amdgcn_s_setprio(1); _Pragma("unroll") for (int m = 0; m < 4; ++m) _Pragma("unroll") for (int n = 0; n < 2; ++n) _Pragma("unroll") for (int k = 0; k < 2; ++k) \
        acc[ai][bj][m][n] = __builtin_amdgcn_mfma_f32_16x16x32_bf16(Bt[n][k], At[m][k], acc[ai][bj][m][n], 0, 0, 0); __builtin_amdgcn_s_setprio(0); } while (0)
#define PG8_WAIT_V(n) asm volatile("s_waitcnt vmcnt(" #n ")" ::: "memory")
#define PG8_WAIT_L(n) asm volatile("s_waitcnt lgkmcnt(" #n ")" ::: "memory")
#define PG8_BAR __builtin_amdgcn_s_barrier()
#define PG8_SCHED __builtin_amdgcn_sched_barrier(0)
    Unit cur, nxt; int ui = 0;
    if (!S.next(0, cur)) return;
    f32x4 acc[2][2][4][2];
#pragma unroll
    for (int a = 0; a < 2; ++a)
#pragma unroll
        for (int b = 0; b < 2; ++b)
#pragma unroll
            for (int m = 0; m < 4; ++m)
#pragma unroll
                for (int n = 0; n < 2; ++n) acc[a][b][m][n] = (f32x4){0.f, 0.f, 0.f, 0.f};
    bf16x8 At[4][2], B0[2][2], B1[2][2];
    const char* cA = (const char*)g.A + (size_t)cur.pm * tstepA; const char* cB = (const char*)g.Bt + (size_t)cur.pn * tstepB;
    PG8_STAGE(PG8_SB(0, 0), cB, voffB); PG8_STAGE(PG8_SB(0, 1), cB + hstepB, voffB); PG8_STAGE(PG8_SA(0, 0), cA, voffA); PG8_STAGE(PG8_SA(0, 1), cA + hstepA, voffA);
    if (wr == 1) PG8_BAR;
    PG8_WAIT_V(2); PG8_BAR;
    PG8_STAGE(PG8_SB(1, 0), cB + kstep, voffB); PG8_STAGE(PG8_SA(1, 0), cA + kstep, voffA); PG8_STAGE(PG8_SB(1, 1), cB + hstepB + kstep, voffB);
    PG8_WAIT_V(6); PG8_BAR;
    for (;;) {
        const bool has_next = S.next(ui + 1, nxt);
        const char* nA = has_next ? (const char*)g.A + (size_t)nxt.pm * tstepA : cA; const char* nB = has_next ? (const char*)g.Bt + (size_t)nxt.pn * tstepB : cB;
        for (int t = 0; t < nt; t += 2) {
            const bool last = (t == nt - 2);
            const char* a1 = cA + (size_t)(t + 1) * kstep;
            const char* a2 = last ? nA : cA + (size_t)(t + 2) * kstep; const char* b2 = last ? nB : cB + (size_t)(t + 2) * kstep;
            const char* a3 = a2 + kstep; const char* b3 = b2 + kstep;
            PG8_LDB(B0, 0, 0); PG8_LDB(B1, 0, 1); PG8_SCHED; PG8_LDA(At, 0, 0); PG8_STAGE(PG8_SA(1, 1), a1 + hstepA, voffA);
            PG8_WAIT_V(8); PG8_WAIT_L(0); PG8_BAR; PG8_MMA(0, 0, At, B0); PG8_MMA(0, 1, At, B1); PG8_BAR; PG8_SCHED;
            PG8_LDA(At, 0, 1); PG8_STAGE(PG8_SB(0, 0), b2, voffB); PG8_STAGE(PG8_SB(0, 1), b2 + hstepB, voffB); PG8_STAGE(PG8_SA(0, 0), a2, voffA);
            PG8_WAIT_V(8); PG8_WAIT_L(0); PG8_BAR; PG8_MMA(1, 0, At, B0); PG8_MMA(1, 1, At, B1); PG8_BAR; PG8_SCHED;
            PG8_LDB(B0, 1, 0); PG8_LDB(B1, 1, 1); PG8_SCHED; PG8_LDA(At, 1, 0); PG8_STAGE(PG8_SA(0, 1), a2 + hstepA, voffA);
            PG8_WAIT_V(8); PG8_WAIT_L(0); PG8_BAR; PG8_MMA(0, 0, At, B0); PG8_MMA(0, 1, At, B1); PG8_BAR; PG8_SCHED;
            PG8_LDA(At, 1, 1); PG8_STAGE(PG8_SB(1, 0), b3, voffB); PG8_STAGE(PG8_SB(1, 1), b3 + hstepB, voffB); PG8_STAGE(PG8_SA(1, 0), a3, voffA);
            PG8_WAIT_V(8); PG8_WAIT_L(0); PG8_BAR; PG8_MMA(1, 0, At, B0); PG8_MMA(1, 1, At, B1); PG8_BAR; PG8_SCHED;
        }
        if (wr == 0) PG8_BAR;
        E(acc, cur, wr, wc, fr, fq);
        if (!has_next) break;
#pragma unroll
        for (int a = 0; a < 2; ++a)
#pragma unroll
            for (int b = 0; b < 2; ++b)
#pragma unroll
                for (int m = 0; m < 4; ++m)
#pragma unroll
                    for (int n = 0; n < 2; ++n) acc[a][b][m][n] = (f32x4){0.f, 0.f, 0.f, 0.f};
        cur = nxt; cA = nA; cB = nB; ++ui;
        if (wr == 1) PG8_BAR;
    }
    PG8_WAIT_V(0);
    PG8_BAR;
#undef PG8_SA
#undef PG8_SB
#undef PG8_STAGE
#undef PG8_LDA
#undef PG8_LDB
#undef PG8_MMA
#undef PG8_WAIT_V
#undef PG8_WAIT_L
#undef PG8_BAR
#undef PG8_SCHED
}
}

#define XB_TMO      128
#define XB_XCNT(j)  (256  + 64 * (j))
#define XB_XSUB(j)  (1280 + 64 * (j))
#define XB_XGEN(j)  (2304 + 64 * (j))
#define XB_TOP      3328
#define XB_TOPGEN   3392
#define XCD_BAR_WORDS 3456
#define XB_SPIN_CAP (1u << 22)
__device__ __forceinline__ unsigned xb_ld(unsigned* p)              { return __hip_atomic_load(p, __ATOMIC_RELAXED, __HIP_MEMORY_SCOPE_AGENT); }
__device__ __forceinline__ unsigned xb_add(unsigned* p, unsigned v) { return __hip_atomic_fetch_add(p, v, __ATOMIC_RELAXED, __HIP_MEMORY_SCOPE_AGENT); }
__device__ __forceinline__ unsigned xb_xcc_id() { return (unsigned)__builtin_amdgcn_s_getreg((3 << 11) | 20) & 0xFu; }
#define XB_SPIN(cond, bar) do { unsigned _sp = 0; while (cond) { __builtin_amdgcn_s_sleep(1); \
    if ((++_sp & 255u) == 0u) { if (xb_ld(&(bar)[XB_TMO])) break; if (_sp > XB_SPIN_CAP) { atomicAdd(&(bar)[XB_TMO], 1u); break; } } } } while (0)
struct XcdBarrier { unsigned* bar; unsigned x; volatile LAS unsigned* st; };
__device__ __forceinline__ XcdBarrier xcd_barrier_post(unsigned* bar, volatile LAS unsigned* st) {
    XcdBarrier b; b.bar = bar; b.x = xb_xcc_id(); b.st = st;
    if (threadIdx.x == 0) (void)xb_add(&bar[XB_XCNT(b.x)], 1u);
    return b;
}
__device__ __forceinline__ void xcd_barrier_complete(unsigned* bar, unsigned x, unsigned& nloc, unsigned& nx) {
    const unsigned G = gridDim.x * gridDim.y * gridDim.z;
    unsigned sum, cnt, mine, sp = 0u;
    for (;;) {
        sum = 0u; cnt = 0u; mine = 0u;
#pragma unroll
        for (unsigned j = 0; j < 16; ++j) { const unsigned c = xb_ld(&bar[XB_XCNT(j)]); sum += c; cnt += (c > 0u) ? 1u : 0u; mine = (j == x) ? c : mine; }
        if (sum == G) break;
        __builtin_amdgcn_s_sleep(1);
        if ((++sp & 255u) == 0u) { if (xb_ld(&bar[XB_TMO])) break; if (sp > XB_SPIN_CAP) { atomicAdd(&bar[XB_TMO], 1u); break; } }
    }
    nloc = mine > 0u ? mine : 1u; nx = cnt > 0u ? cnt : 1u;
}
__device__ __forceinline__ void xcd_barrier(const XcdBarrier& b) {
    asm volatile("s_waitcnt vmcnt(0)" ::: "memory");
    __syncthreads();
    if (threadIdx.x == 0) {
        unsigned* bar = b.bar;
        __builtin_amdgcn_s_waitcnt(0);
        unsigned nloc = b.st[0], nx = b.st[1];
        if (nloc == 0u) { xcd_barrier_complete(bar, b.x, nloc, nx); b.st[0] = nloc; b.st[1] = nx; }
        const unsigned old = xb_add(&bar[XB_XSUB(b.x)], 1u);
        const unsigned gen = old / nloc;
        if (old + 1u == (gen + 1u) * nloc) {
            __builtin_amdgcn_fence(__ATOMIC_RELEASE, "agent");
            asm volatile("s_waitcnt vmcnt(0)" ::: "memory");
            const unsigned og = xb_add(&bar[XB_TOP], 1u);
            const unsigned tg = og / nx;
            if (og + 1u == (tg + 1u) * nx) xb_add(&bar[XB_TOPGEN], 1u);
            else XB_SPIN(xb_ld(&bar[XB_TOPGEN]) == tg, bar);
            __builtin_amdgcn_fence(__ATOMIC_ACQUIRE, "agent");
            xb_add(&bar[XB_XGEN(b.x)], 1u);
            asm volatile("s_waitcnt vmcnt(0)" ::: "memory");
        } else {
            XB_SPIN(xb_ld(&bar[XB_XGEN(b.x)]) == gen, bar);
            __builtin_amdgcn_fence(__ATOMIC_ACQUIRE, "agent");
            asm volatile("s_waitcnt vmcnt(0)" ::: "memory");
        }
    }
    __syncthreads();
}

#ifndef PROBE_NOEPI
#define PROBE_NOEPI 0
#endif
#ifndef PROBE_SITES
#define PROBE_SITES 0
#endif
#ifndef PROBE_PRO
#define PROBE_PRO 1
#endif
#ifndef PROBE_WGT
#define PROBE_WGT 1
#endif
#ifndef PROBE_NAFAKE
#define PROBE_NAFAKE 0
#endif
#ifndef MLA_V2
#define MLA_V2 1
#endif
#ifndef PROBE_MLAFAKE
#define PROBE_MLAFAKE 0
#endif
#ifndef PROBE_MLA
#define PROBE_MLA 1
#endif
#ifndef PROBE_NA
#define PROBE_NA 1
#endif
#ifndef PROBE_EW
#define PROBE_EW 1
#endif
#ifndef PROBE_S5
#define PROBE_S5 1
#endif
#ifndef PROBE_CARRY
#define PROBE_CARRY 1
#endif
constexpr int NWAVES = 8, NTHR = 512;
constexpr int LDS_BYTES = 147456;
struct Fr {
    LAS unsigned char* lds; int tid, lane, wave, gw, NGW, gt, NGT;
};
__device__ __forceinline__ Fr launder(Fr F) { asm volatile("" : "+v"(F.tid), "+v"(F.lane), "+v"(F.gt)); asm volatile("" : "+s"(F.wave), "+s"(F.gw)); return F; }

__device__ __forceinline__ void transpose_item(const float* W, int K, int N, bf16_t* WT, LAS float* scr, int item, int lane, int perm = 0, const float* kscale = nullptr) {
    const int nblk = N / 32, kb = item / nblk, nb = item % nblk, k0 = 64 * kb, n0 = 32 * nb;
#pragma unroll 8
    for (int i = 0; i < 32; ++i) { const int kk = 2 * i + (lane >> 5); float wv = W[(size_t)(k0 + kk) * N + n0 + (lane & 31)]; if (kscale) wv *= kscale[k0 + kk]; scr[kk * 33 + (lane & 31)] = wv; }
    asm volatile("s_waitcnt lgkmcnt(0)" ::: "memory");
    const int c = lane & 7;
#pragma unroll
    for (int j = 0; j < 4; ++j) { const int n = (lane >> 3) + 8 * j; const LAS float* s = scr + (8 * c) * 33 + n;
        u32x4 o; o.x = pk2(s[0 * 33], s[1 * 33]); o.y = pk2(s[2 * 33], s[3 * 33]); o.z = pk2(s[4 * 33], s[5 * 33]); o.w = pk2(s[6 * 33], s[7 * 33]);
        int nr = n0 + n; if (perm == 1) { const int cp = nr & 511; nr = 256 * (cp >> 7) + ((nr >> 9) << 7) + (cp & 127); }
        *(u32x4*)(WT + (size_t)nr * K + k0 + 8 * c) = o; }
    asm volatile("s_waitcnt lgkmcnt(0)" ::: "memory");
}

__device__ __forceinline__ void phase_mod(KArgs a0, const Fr& F0) {
    const Fr F = launder(F0); const KArgs a = klaunder(a0);
    LAS float* sc = (LAS float*)F.lds;
    LAS float* red = sc + 9 * 1024;
    float* MOD = (float*)(WSP(a) + WS_MOD);
    const float* c = INP(a, 1); const float* cc = INP(a, 3); const float* ada_w = INP(a, 4); const float* ada_b = INP(a, 5);
    if ((int)blockIdx.x < 192) {
        for (int i = F.tid; i < 9 * 1024; i += NTHR) { const int r = i >> 10, k = i & 1023; const float v = (r < 8) ? c[r * 1024 + k] : cc[k]; sc[i] = silu_f(v); }
    }
    __syncthreads();
    for (int item = blockIdx.x; item < 192; item += gridDim.x) {
        const int l = item / 48, cch = item % 48, col = cch * 64 + F.lane;
        const float* W = ada_w + (size_t)l * 1024 * 3072 + col;
        float acc[9];
#pragma unroll
        for (int r = 0; r < 9; ++r) acc[r] = 0.f;
        const int k0 = F.wave * 128;
#pragma unroll 16
        for (int k = k0; k < k0 + 128; ++k) { const float w = W[(size_t)k * 3072];
#pragma unroll
            for (int r = 0; r < 9; ++r) acc[r] += sc[r * 1024 + k] * w; }
#pragma unroll
        for (int r = 0; r < 9; ++r) red[(F.wave * 9 + r) * 64 + F.lane] = acc[r];
        __syncthreads();
        for (int i = F.tid; i < 576; i += NTHR) { const int r = i >> 6, ln = i & 63; float s = 0.f;
#pragma unroll
            for (int w = 0; w < 8; ++w) s += red[(w * 9 + r) * 64 + ln];
            MOD[(size_t)(l * 9 + r) * 3072 + cch * 64 + ln] = s + ada_b[l * 3072 + cch * 64 + ln]; }
        __syncthreads();
    }
}

__device__ __forceinline__ void phase_weights(KArgs a0, const Fr& F0, int l) {
    const Fr F = launder(F0); const KArgs a = klaunder(a0);
    LAS float* scr = (LAS float*)(F.lds + F.wave * 16384);
    const int i = l >> 1;
    if ((l & 1) == 0) {
        const float* w_in = INP(a, 8) + (size_t)i * 1024 * EVEN_IN; const float* w_uq = INP(a, 11) + (size_t)i * 256 * 768; const float* w_ukv = INP(a, 12) + (size_t)i * 128 * 1024;
        const float* w_glu = INP(a, 21) + (size_t)i * 512 * 1024; const float* w_out = INP(a, 23) + (size_t)i * 1024 * 1024;
        constexpr int I0 = 16 * 61, I1 = 4 * 24, I2 = 2 * 32, I3 = 8 * 32, I4 = 16 * 32, NI = I0 + I1 + I2 + I3 + I4;
        for (int it = F.gw; it < NI; it += F.NGW) {
            int r = it;
            if (r < I0) { transpose_item(w_in, 1024, EVEN_IN, (bf16_t*)(WSP(a) + WS_WEVIN), scr, r, F.lane); continue; } r -= I0;
            if (r < I1) { transpose_item(w_uq, 256, 768, (bf16_t*)(WSP(a) + WS_WUQ), scr, r, F.lane, 0, INP(a, 9) + i * 256); continue; } r -= I1;
            if (r < I2) { transpose_item(w_ukv, 128, 1024, (bf16_t*)(WSP(a) + WS_WUKV), scr, r, F.lane, 0, INP(a, 10) + i * 128); continue; } r -= I2;
            if (r < I3) { transpose_item(w_glu, 512, 1024, (bf16_t*)(WSP(a) + WS_WGLU), scr, r, F.lane, 1); continue; } r -= I3;
            transpose_item(w_out, 1024, 1024, (bf16_t*)(WSP(a) + WS_WEVOUT), scr, r, F.lane);
        }
        u32x4* pad = (u32x4*)((bf16_t*)(WSP(a) + WS_WEVIN) + (size_t)EVEN_IN * 1024);
        for (int t = F.gt; t < (EVEN_INP - EVEN_IN) * 1024 / 8; t += F.NGT) pad[t] = (u32x4){0u, 0u, 0u, 0u};
    } else {
        const float* w_in = INP(a, 24) + (size_t)i * 1024 * 4096; const float* w_out = INP(a, 26) + (size_t)i * 1024 * 1024;
        constexpr int I0 = 16 * 128, I1 = 16 * 32, NI = I0 + I1;
        for (int it = F.gw; it < NI; it += F.NGW) {
            int r = it;
            if (r < I0) { transpose_item(w_in, 1024, 4096, (bf16_t*)(WSP(a) + WS_WNAIN), scr, r, F.lane); continue; } r -= I0;
            transpose_item(w_out, 1024, 1024, (bf16_t*)(WSP(a) + WS_WNAOUT), scr, r, F.lane);
        }
    }
}

__device__ __forceinline__ void phase_s5_setup(KArgs a0, const Fr& F0, int i) {
    const Fr F = launder(F0); const KArgs a = klaunder(a0);
    f32x2* BB = (f32x2*)(WSP(a) + WS_BB); f32x2* POW = (f32x2*)(WSP(a) + WS_POW);
    const float* lam_re = INP(a, 13) + (size_t)i * 4096; const float* lam_im = INP(a, 14) + (size_t)i * 4096; const float* log_dt = INP(a, 15) + i * 64;
    const float* b_re = INP(a, 16) + (size_t)i * 65536; const float* b_im = INP(a, 17) + (size_t)i * 65536;
    for (int t = F.gt; t < 4096; t += F.NGT) {
        const int dg = t >> 6;
        const float dt = expf(log_dt[dg]);
        const float lr = fminf(lam_re[t], -1e-4f), li = lam_im[t];
        const float aa = lr * dt, th = li * dt;
        float sn, cs; sincosf(th, &sn, &cs);
        const float mag = expf(aa);
        const float lbr = mag * cs, lbi = mag * sn;
        const float sh = sinf(0.5f * th);
        const float nr = expm1f(aa) * cs - 2.f * sh * sh;
        const float den = lr * lr + li * li;
        const float kre = (nr * lr + lbi * li) / den, kim = (lbi * lr - nr * li) / den;
#pragma unroll
        for (int h = 0; h < 16; ++h) { const float br = b_re[(size_t)t * 16 + h], bi = b_im[(size_t)t * 16 + h];
            BB[(size_t)t * 16 + h] = (f32x2){kre * br - kim * bi, kre * bi + kim * br}; }
    }
    for (int t = F.gt; t < 4096 * 33; t += F.NGT) {
        const int p = t & 63, tau = (t >> 6) % 33, dg = t / (64 * 33); const int tp = dg * 64 + p;
        const float dt = expf(log_dt[dg]); const float lr = fminf(lam_re[tp], -1e-4f), li = lam_im[tp];
        const float aa = lr * dt, th = li * dt;
        float s2, c2; sincosf(th * (float)tau, &s2, &c2); const float m2 = expf(aa * (float)tau);
        POW[((size_t)dg * 33 + tau) * 64 + p] = (f32x2){m2 * c2, m2 * s2};
    }
}
__device__ __forceinline__ void phase_s5_kt(KArgs a0, const Fr& F0, int i) {
    const Fr F = launder(F0); const KArgs a = klaunder(a0);
    const f32x2* BB = (const f32x2*)(WSP(a) + WS_BB); const f32x2* POW = (const f32x2*)(WSP(a) + WS_POW); float* KT = (float*)(WSP(a) + WS_KT);
    const float* c_re = INP(a, 18) + (size_t)i * 65536; const float* c_im = INP(a, 19) + (size_t)i * 65536;
    for (int t = F.gt; t < 32 * 2 * 8 * 256; t += F.NGT) {
        const int hp = t & 15, h = (t >> 4) & 15, tau = (t >> 8) & 7, di = (t >> 11) & 1, g = t >> 12;
        const int dg = di * 32 + g;
        const float* cr = c_re + ((size_t)dg * 16 + h) * 64; const float* ci = c_im + ((size_t)dg * 16 + h) * 64;
        const f32x2* pw = POW + ((size_t)dg * 33 + tau) * 64; const f32x2* bb = BB + (size_t)dg * 64 * 16 + hp;
        float s0 = 0.f, s1 = 0.f, s2 = 0.f, s3 = 0.f;
#pragma unroll 8
        for (int p = 0; p < 64; ++p) { const f32x2 b = bb[p * 16]; const float c_r = cr[p], c_i = ci[p];
            const float ur = c_r * b.x - c_i * b.y, ui = c_r * b.y + c_i * b.x;
            const f32x2 w0 = pw[p], w1 = pw[8 * 64 + p], w2 = pw[16 * 64 + p], w3 = pw[24 * 64 + p];
            s0 += ur * w0.x - ui * w0.y; s1 += ur * w1.x - ui * w1.y; s2 += ur * w2.x - ui * w2.y; s3 += ur * w3.x - ui * w3.y; }
        float* kt = KT + ((((size_t)(g * 2 + di) * 32 + tau) * 16 + h) * 16 + hp);
        kt[0] = s0; kt[8 * 256] = s1; kt[16 * 256] = s2; kt[24 * 256] = s3;
    }
}
__device__ __forceinline__ void phase_s5_tables(KArgs a0, const Fr& F0, int i) {
    const Fr F = launder(F0); const KArgs a = klaunder(a0);
    const f32x2* BB = (const f32x2*)(WSP(a) + WS_BB); const f32x2* POW = (const f32x2*)(WSP(a) + WS_POW); const float* KT = (const float*)(WSP(a) + WS_KT);
    const float* c_re = INP(a, 18) + (size_t)i * 65536; const float* c_im = INP(a, 19) + (size_t)i * 65536; const float* dsk = INP(a, 20) + i * 512;
    bf16_t* BTA = (bf16_t*)(WSP(a) + WS_BTA); bf16_t* BTC = (bf16_t*)(WSP(a) + WS_BTC);
    for (int t = F.gt; t < 32 * 256 * 64; t += F.NGT) {
        const int c8 = t & 63, row = (t >> 6) & 255, g = t >> 14;
        const int di = row >> 7, ri = (row >> 6) & 1, p = row & 63, s = c8 >> 1, h0 = (c8 & 1) * 8;
        const int dg = di * 32 + g, tau = di ? s : 31 - s;
        const f32x2 w = POW[((size_t)dg * 33 + tau) * 64 + p]; const f32x4* bb4 = (const f32x4*)(BB + ((size_t)dg * 64 + p) * 16 + h0);
        const f32x4 q0 = bb4[0], q1 = bb4[1], q2 = bb4[2], q3 = bb4[3];
        const float bx[8] = {q0[0], q0[2], q1[0], q1[2], q2[0], q2[2], q3[0], q3[2]}, by[8] = {q0[1], q0[3], q1[1], q1[3], q2[1], q2[3], q3[1], q3[3]};
        float v[8];
#pragma unroll
        for (int j = 0; j < 8; ++j) v[j] = ri ? (w.x * by[j] + w.y * bx[j]) : (w.x * bx[j] - w.y * by[j]);
        *(u32x4*)(BTA + ((size_t)(g * 256 + row)) * 512 + c8 * 8) = (u32x4){pk2(v[0], v[1]), pk2(v[2], v[3]), pk2(v[4], v[5]), pk2(v[6], v[7])};
    }
    for (int t = F.gt; t < 32 * 512 * 96; t += F.NGT) {
        const int c8 = t % 96, row = (t / 96) & 511, g = t / (96 * 512);
        const int tt = row >> 4, h = row & 15;
        float v[8];
        if (c8 < 64) {
            const int s = c8 >> 1, h0 = (c8 & 1) * 8;
            const int tau = (tt > s) ? tt - s : s - tt; const int dsel = (tt >= s) ? 0 : 1;
            const f32x4* k0 = (const f32x4*)(KT + ((((size_t)(g * 2 + dsel) * 32 + tau) * 16 + h) * 16 + h0));
            const f32x4 a0 = k0[0], a1 = k0[1];
            v[0] = a0[0]; v[1] = a0[1]; v[2] = a0[2]; v[3] = a0[3]; v[4] = a1[0]; v[5] = a1[1]; v[6] = a1[2]; v[7] = a1[3];
            if (tt == s) {
                const f32x4* k1 = (const f32x4*)(KT + ((((size_t)(g * 2 + 1) * 32) * 16 + h) * 16 + h0)); const f32x4 b0 = k1[0], b1 = k1[1];
                v[0] += b0[0]; v[1] += b0[1]; v[2] += b0[2]; v[3] += b0[3]; v[4] += b1[0]; v[5] += b1[1]; v[6] += b1[2]; v[7] += b1[3];
                const float dk = dsk[g * 16 + h];
#pragma unroll
                for (int j = 0; j < 8; ++j) if (h0 + j == h) v[j] += dk; }
        } else {
            const int cc = (c8 - 64) * 8, di = cc >> 7, ri = (cc >> 6) & 1, p0 = cc & 63;
            const int dg = di * 32 + g, tau = di ? 32 - tt : tt + 1;
            const f32x4* pw4 = (const f32x4*)(POW + ((size_t)dg * 33 + tau) * 64 + p0);
            const f32x4* cr4 = (const f32x4*)(c_re + ((size_t)dg * 16 + h) * 64 + p0); const f32x4* ci4 = (const f32x4*)(c_im + ((size_t)dg * 16 + h) * 64 + p0);
            const f32x4 w0 = pw4[0], w1 = pw4[1], w2 = pw4[2], w3 = pw4[3], r0 = cr4[0], r1 = cr4[1], i0 = ci4[0], i1 = ci4[1];
            const float wx[8] = {w0[0], w0[2], w1[0], w1[2], w2[0], w2[2], w3[0], w3[2]}, wy[8] = {w0[1], w0[3], w1[1], w1[3], w2[1], w2[3], w3[1], w3[3]};
            const float crv[8] = {r0[0], r0[1], r0[2], r0[3], r1[0], r1[1], r1[2], r1[3]}, civ[8] = {i0[0], i0[1], i0[2], i0[3], i1[0], i1[1], i1[2], i1[3]};
#pragma unroll
            for (int j = 0; j < 8; ++j) v[j] = ri ? -(crv[j] * wy[j] + civ[j] * wx[j]) : (crv[j] * wx[j] - civ[j] * wy[j]);
        }
        *(u32x4*)(BTC + ((size_t)(g * 512 + row)) * 768 + c8 * 8) = (u32x4){pk2(v[0], v[1]), pk2(v[2], v[3]), pk2(v[4], v[5]), pk2(v[6], v[7])};
    }
}

__device__ __forceinline__ void phase_rn0(KArgs a0, const Fr& F0) {
    const Fr F = launder(F0); const KArgs a = klaunder(a0);
    const float* MOD = (const float*)(WSP(a) + WS_MOD); bf16_t* H = (bf16_t*)(WSP(a) + WS_HB); float* SSQ = (float*)(WSP(a) + WS_SSQ);
    const float* gam = INP(a, 6);
    for (int row = F.gw; row < MROWS; row += F.NGW) {
        const bool lat = row < MLAT; const int bi = lat ? (row >> 12) : 8;
        const float* xo = lat ? INP(a, 0) + (size_t)row * 1024 : INP(a, 2) + (size_t)(row - MLAT) * 1024;
        const float* md = MOD + (size_t)bi * 3072;
        f32x4 v[4]; float ss = 0.f;
#pragma unroll
        for (int j = 0; j < 4; ++j) { v[j] = ((const f32x4*)xo)[F.lane + 64 * j]; ss += (v[j].x * v[j].x + v[j].y * v[j].y) + (v[j].z * v[j].z + v[j].w * v[j].w); }
        ss = wave_sum(ss);
        u32x2* hrow = (u32x2*)(H + (size_t)row * 1024);
#pragma unroll
        for (int j = 0; j < 4; ++j) { const f32x4 g4 = ((const f32x4*)gam)[F.lane + 64 * j], s4 = ((const f32x4*)(md + 1024))[F.lane + 64 * j];
            hrow[F.lane + 64 * j] = (u32x2){pk2(v[j].x * g4.x * (1.f + s4.x), v[j].y * g4.y * (1.f + s4.y)), pk2(v[j].z * g4.z * (1.f + s4.z), v[j].w * g4.w * (1.f + s4.w))}; }
        if (F.lane < 16) SSQ[(size_t)row * 16 + F.lane] = (F.lane == 0) ? ss : 0.f;
    }
}
__device__ __forceinline__ void phase_shw(KArgs a0, const Fr& F0) {
    const Fr F = launder(F0); const KArgs a = klaunder(a0);
    LAS float* sc = (LAS float*)F.lds; LAS float* red = sc + 9 * 1024;
    const float* MOD = (const float*)(WSP(a) + WS_MOD); float* SHW = (float*)(WSP(a) + WS_SHW);
    for (int item = blockIdx.x; item < 190; item += gridDim.x) {
        int l, cch; if (item < 31) { l = 0; cch = item; } else if (item < 95) { l = 1; cch = item - 31; } else if (item < 126) { l = 2; cch = item - 95; } else { l = 3; cch = item - 126; }
        const int N = (l & 1) ? 4096 : EVEN_IN; const float* W = (l & 1) ? INP(a, 24) + (size_t)(l >> 1) * 1024 * 4096 : INP(a, 8) + (size_t)(l >> 1) * 1024 * EVEN_IN;
        __syncthreads();
        for (int t = F.tid; t < 9 * 1024; t += NTHR) sc[t] = MOD[(size_t)(l * 9 + (t >> 10)) * 3072 + (t & 1023)];
        __syncthreads();
        const int col = cch * 64 + F.lane; const bool ok = col < N; const float* Wc = W + (ok ? col : 0);
        float acc[9];
#pragma unroll
        for (int r = 0; r < 9; ++r) acc[r] = 0.f;
        const int k0 = F.wave * 128;
#pragma unroll 16
        for (int k = k0; k < k0 + 128; ++k) { const float w = Wc[(size_t)k * N];
#pragma unroll
            for (int r = 0; r < 9; ++r) acc[r] += sc[r * 1024 + k] * w; }
#pragma unroll
        for (int r = 0; r < 9; ++r) red[(F.wave * 9 + r) * 64 + F.lane] = acc[r];
        __syncthreads();
        for (int t = F.tid; t < 576; t += NTHR) { const int r = t >> 6, ln = t & 63; float s = 0.f;
#pragma unroll
            for (int w = 0; w < 8; ++w) s += red[(w * 9 + r) * 64 + ln];
            if (cch * 64 + ln < N) SHW[(size_t)(l * 9 + r) * 4096 + cch * 64 + ln] = s; }
    }
    __syncthreads();
}
__device__ __forceinline__ void phase_final(KArgs a0, const Fr& F0) {
    const Fr F = launder(F0); const KArgs a = klaunder(a0);
    const float* gam = INP(a, 7);
    for (int rp = F.gw; rp < MLAT / 2; rp += F.NGW) {
        float* xr0 = OUTP(a) + (size_t)(2 * rp) * 1024; float* xr1 = xr0 + 1024;
        f32x4 v[4], w[4]; float s0 = 0.f, s1 = 0.f;
#pragma unroll
        for (int j = 0; j < 4; ++j) { v[j] = ((const f32x4*)xr0)[F.lane + 64 * j]; w[j] = ((const f32x4*)xr1)[F.lane + 64 * j]; }
#pragma unroll
        for (int j = 0; j < 4; ++j) { s0 += (v[j].x * v[j].x + v[j].y * v[j].y) + (v[j].z * v[j].z + v[j].w * v[j].w); s1 += (w[j].x * w[j].x + w[j].y * w[j].y) + (w[j].z * w[j].z + w[j].w * w[j].w); }
        const float r0 = 1.0f / sqrtf(wave_sum(s0) * (1.f / 1024.f) + EPS), r1 = 1.0f / sqrtf(wave_sum(s1) * (1.f / 1024.f) + EPS);
#pragma unroll
        for (int j = 0; j < 4; ++j) { const f32x4 g4 = ((const f32x4*)gam)[F.lane + 64 * j];
            ((f32x4*)xr0)[F.lane + 64 * j] = (f32x4){v[j].x * r0 * g4.x, v[j].y * r0 * g4.y, v[j].z * r0 * g4.z, v[j].w * r0 * g4.w};
            ((f32x4*)xr1)[F.lane + 64 * j] = (f32x4){w[j].x * r1 * g4.x, w[j].y * r1 * g4.y, w[j].z * r1 * g4.z, w[j].w * r1 * g4.w}; }
    }
}

__device__ __forceinline__ void chunk_of_row(int row, int& R, int& s) {
    if (row < MLAT) { const int b = row >> 12, t = row & 4095; R = b * NCH + 8 + (t >> 5); s = t & 31; }
    else { const int r = row - MLAT, b = r >> 8, t = r & 255; R = b * NCH + (t >> 5); s = t & 31; }
}

__device__ __forceinline__ void phase_e2b(KArgs a0, const Fr& F0) {
    const Fr F = launder(F0); const KArgs a = klaunder(a0);
    const bf16_t* S = (const bf16_t*)(WSP(a) + WS_S); bf16_t* UX = (bf16_t*)(WSP(a) + WS_UX); const f32x2* POW = (const f32x2*)(WSP(a) + WS_POW);
    LAS bf16_t* T = (LAS bf16_t*)F.lds;
    for (int rep = 0; rep < PROBE_CARRY; ++rep)
    for (int it = blockIdx.x; it < NB * 32; it += gridDim.x) {
        const int b = it >> 5, g = it & 31;
        const size_t row0 = (size_t)g * NCHP + b * NCH;
        __syncthreads();
        { const u32x4* src4 = (const u32x4*)(S + row0 * 256); LAS u32x4* t4 = (LAS u32x4*)T;
          for (int t = F.tid; t < NCH * 32; t += NTHR) t4[t] = src4[t]; }
        __syncthreads();
        if (F.tid < 128) {
            const int di = F.tid >> 6, p = F.tid & 63;
            const f32x2 lt = POW[((size_t)(di * 32 + g) * 33 + 32) * 64 + p];
            float xr = 0.f, xi = 0.f;
#pragma unroll 8
            for (int k = 0; k < NCH; ++k) { const int cc = (di == 0) ? k : ((k < 8) ? 7 - k : 143 - k);
                LAS bf16_t* e = T + cc * 256 + di * 128 + p;
                const float sr = bf2f(e[0]), si = bf2f(e[64]);
                e[0] = (bf16_t)f2bf(xr); e[64] = (bf16_t)f2bf(xi);
                const float nr = lt.x * xr - lt.y * xi + sr, ni = lt.x * xi + lt.y * xr + si; xr = nr; xi = ni; }
        }
        __syncthreads();
        { const LAS u32x4* t4 = (const LAS u32x4*)T;
          for (int t = F.tid; t < NCH * 32; t += NTHR) { const int cc = t >> 5, c16 = t & 31; *(u32x4*)(UX + (row0 + cc) * 768 + 512 + c16 * 8) = t4[t]; } }
    }
    __syncthreads();
}

__device__ __forceinline__ void phase_krope(KArgs a0, const Fr& F0) {
    const Fr F = launder(F0); const KArgs a = klaunder(a0);
    bf16_t* KR = (bf16_t*)(WSP(a) + WS_KR);
    for (int t = F.gt; t < MLAT * 16; t += F.NGT) {
        const int row = t >> 4, axis = (t >> 3) & 1, ii = t & 7; const int tk = row & 4095;
        bf16_t* p0 = KR + (size_t)row * 32 + axis * 16 + ii;
        const float x0 = bf2f(p0[0]), x1 = bf2f(p0[8]);
        const float pos = (float)(axis ? (tk & 63) : (tk >> 6)); const float ang = pos * exp2f(-(float)ii * (13.287712379549449f / 8.f));
        float sn, cs; sincosf(ang, &sn, &cs);
        p0[0] = (bf16_t)f2bf(x0 * cs - x1 * sn); p0[8] = (bf16_t)f2bf(x1 * cs + x0 * sn);
    }
}

namespace mla {
using s16x4 = __attribute__((ext_vector_type(4))) short;
using f32x16 = __attribute__((ext_vector_type(16))) float;
constexpr int QBLK = 32, KVBLK = 64;
constexpr float SCALE = 0.10206207261596577f, THR = 8.f;
constexpr int SHM_V = 16384, SHM_K = 16384;
#define KSWZ(row, colB) ((row) * 256 + ((colB) ^ (((row) & 15) << 4)))
#define SBAR() __builtin_amdgcn_sched_barrier(0)
__device__ __forceinline__ int crow(int r, int hi) { return (r & 3) + 8 * (r >> 2) + 4 * hi; }
__device__ __forceinline__ unsigned cvtpk(float lo, float hi) { unsigned r; asm volatile("v_cvt_pk_bf16_f32 %0, %1, %2" : "=v"(r) : "v"(lo), "v"(hi)); return r; }
template <bool FIRST> __device__ __forceinline__ void partialSM(f32x16& p0, f32x16& p1, float& m_reg, float& alpha) {
  constexpr float THR2 = THR * 1.4426950408889634f;
  float pmax = p0[0];
#pragma unroll
  for (int r = 1; r < 16; ++r) pmax = fmaxf(pmax, p0[r]);
#pragma unroll
  for (int r = 0; r < 16; ++r) pmax = fmaxf(pmax, p1[r]);
  { auto rr = __builtin_amdgcn_permlane32_swap(__float_as_uint(pmax), __float_as_uint(pmax), false, false);
    pmax = fmaxf(__uint_as_float(rr[0]), __uint_as_float(rr[1])); }
  alpha = 1.f;
  if (FIRST || !__builtin_expect(__all(pmax <= THR2), 1)) {
    const float dl = FIRST ? pmax : fmaxf(pmax, 0.f);
    if (!FIRST) alpha = __builtin_amdgcn_exp2f(-dl);
    m_reg += dl;
#pragma unroll
    for (int r = 0; r < 16; ++r) { p0[r] -= dl; p1[r] -= dl; }
  }
#pragma unroll
  for (int r = 0; r < 16; ++r) p0[r] = __builtin_amdgcn_exp2f(p0[r]);
}
__device__ __forceinline__ void finishSM(f32x16& p0, f32x16& p1, float alpha, float& l_reg, bf16x8& pa0, bf16x8& pa1, bf16x8& pa2, bf16x8& pa3) {
#pragma unroll
  for (int r = 0; r < 16; ++r) p1[r] = __builtin_amdgcn_exp2f(p1[r]);
  float ps = 0;
#pragma unroll
  for (int r = 0; r < 16; ++r) ps += p0[r];
#pragma unroll
  for (int r = 0; r < 16; ++r) ps += p1[r];
  { auto rr = __builtin_amdgcn_permlane32_swap(__float_as_uint(ps), __float_as_uint(ps), false, false);
    ps = __uint_as_float(rr[0]) + __uint_as_float(rr[1]); }
  l_reg = l_reg * alpha + ps;
#define PK4(P, BASE, OUT) do { unsigned a0 = cvtpk(P[BASE + 0], P[BASE + 1]), a1 = cvtpk(P[BASE + 2], P[BASE + 3]);   \
    unsigned b0 = cvtpk(P[BASE + 4], P[BASE + 5]), b1 = cvtpk(P[BASE + 6], P[BASE + 7]);                              \
    auto r0 = __builtin_amdgcn_permlane32_swap(a0, b0, false, false); auto r1 = __builtin_amdgcn_permlane32_swap(a1, b1, false, false); \
    u32x4 w = {r0[0], r1[0], r0[1], r1[1]}; OUT = *reinterpret_cast<bf16x8*>(&w); } while (0)
  PK4(p0, 0, pa0); PK4(p0, 8, pa1); PK4(p1, 0, pa2); PK4(p1, 8, pa3);
#undef PK4
}
__device__ __forceinline__ void qkt(f32x16& p0, f32x16& p1, const char* Ks, const bf16x8* qr, int r32, int hi, float m_ref) {
#pragma unroll
  for (int r = 0; r < 16; ++r) { p0[r] = -m_ref; p1[r] = -m_ref; }
#pragma unroll
  for (int d0 = 0; d0 < 6; ++d0) { const int cb = (d0 * 16 + hi * 8) * 2;
    const bf16x8 b0 = *reinterpret_cast<const bf16x8*>(Ks + KSWZ(r32, cb));
    const bf16x8 b1 = *reinterpret_cast<const bf16x8*>(Ks + KSWZ(32 + r32, cb));
    p0 = __builtin_amdgcn_mfma_f32_32x32x16_bf16(b0, qr[d0], p0, 0, 0, 0);
    p1 = __builtin_amdgcn_mfma_f32_32x32x16_bf16(b1, qr[d0], p1, 0, 0, 0); }
}
__device__ __forceinline__ int v_st(int k, int c) { const int kk = (k & ~0xC) | ((k & 4) << 1) | ((k & 8) >> 1); return ((kk >> 3) * 4 + (c >> 5)) * 512 + ((kk & 7) * 32 + (c & 31)) * 2; }
__device__ __forceinline__ int v_rd_base(int lane) { return ((lane & 3) << 3) | (((lane >> 2) & 3) << 6) | (((lane >> 4) & 1) << 5) | (((lane >> 5) & 1) << 8); }
constexpr int v_rd_off(int d0, int ks, int half) { return d0 * 512 + ks * 4096 + half * 2048; }
template <int OFF> __device__ __forceinline__ s16x4 tr_read(int vb) { s16x4 r; asm volatile("ds_read_b64_tr_b16 %0, %1 offset:%2" : "=&v"(r) : "v"(vb), "i"(OFF) : "memory"); return r; }
template <int D0> __device__ __forceinline__ void pv_one(f32x16& od, int vb, bf16x8 pa0, bf16x8 pa1, bf16x8 pa2, bf16x8 pa3) {
  const s16x4 l0 = tr_read<v_rd_off(D0, 0, 0)>(vb), h0 = tr_read<v_rd_off(D0, 0, 1)>(vb), l1 = tr_read<v_rd_off(D0, 1, 0)>(vb), h1 = tr_read<v_rd_off(D0, 1, 1)>(vb);
  const s16x4 l2 = tr_read<v_rd_off(D0, 2, 0)>(vb), h2 = tr_read<v_rd_off(D0, 2, 1)>(vb), l3 = tr_read<v_rd_off(D0, 3, 0)>(vb), h3 = tr_read<v_rd_off(D0, 3, 1)>(vb);
  asm volatile("s_waitcnt lgkmcnt(0)" ::: "memory"); SBAR();
#define PK(L, H) (bf16x8){L[0], L[1], L[2], L[3], H[0], H[1], H[2], H[3]}
  od = __builtin_amdgcn_mfma_f32_32x32x16_bf16(pa0, PK(l0, h0), od, 0, 0, 0);
  od = __builtin_amdgcn_mfma_f32_32x32x16_bf16(pa1, PK(l1, h1), od, 0, 0, 0);
  od = __builtin_amdgcn_mfma_f32_32x32x16_bf16(pa2, PK(l2, h2), od, 0, 0, 0);
  od = __builtin_amdgcn_mfma_f32_32x32x16_bf16(pa3, PK(l3, h3), od, 0, 0, 0);
#undef PK
}
__device__ __forceinline__ void pv_d0(f32x16* o, int vb, bf16x8 pa0, bf16x8 pa1, bf16x8 pa2, bf16x8 pa3) { pv_one<0>(o[0], vb, pa0, pa1, pa2, pa3); pv_one<1>(o[1], vb, pa0, pa1, pa2, pa3); }

template <int FAKE> __device__ __forceinline__ void unit(const bf16_t* __restrict__ Q0, const bf16_t* __restrict__ KV0, const bf16_t* __restrict__ KR, const bf16_t* __restrict__ Z, bf16_t* __restrict__ BR,
                                     int qrow0, int b, int h, int nkeys, char* lds) {
  int tid_ = threadIdx.x; asm volatile("" : "+v"(tid_));
  const int tid = tid_, wid = tid >> 6, lane = tid & 63, r32 = lane & 31, hi = lane >> 5;
  char* V_lds = lds; char* K_lds = lds + 3 * SHM_V;
  float* ws = (float*)(lds + 3 * SHM_V + 3 * SHM_K) + wid * 64; float* li_l = ws; float* al_l = ws + 32;
  float m_reg = 0.f, l_reg = 0; f32x16 o[2] = {}; bf16x8 qr[6];
  const bf16_t* Qw = Q0 + (size_t)(qrow0 + wid * QBLK + r32) * 768 + h * 96 + hi * 8;
#pragma unroll
  for (int d0 = 0; d0 < 6; ++d0) qr[d0] = *reinterpret_cast<const bf16x8*>(Qw + d0 * 16);
  const int vrow = tid >> 3, vc = (tid & 7) * 8, vst = v_st(vrow, vc);
  const int kr0 = tid / 12, kc0 = tid % 12, kr1 = (512 + (tid & 255)) / 12, kc1 = (512 + (tid & 255)) % 12;
  const bf16_t* vsrc = KV0 + (size_t)vrow * 1024 + h * 128 + 64 + vc;
  const bf16_t* ksrc0 = (kc0 < 8) ? KV0 + (size_t)kr0 * 1024 + h * 128 + 8 * kc0 : KR + (size_t)kr0 * 32 + 8 * (kc0 - 8);
  const bf16_t* ksrc1 = (kc1 < 8) ? KV0 + (size_t)kr1 * 1024 + h * 128 + 8 * kc1 : KR + (size_t)kr1 * 32 + 8 * (kc1 - 8);
  const int kstr0 = (kc0 < 8) ? 1024 : 32, kstr1 = (kc1 < 8) ? 1024 : 32;
  const int kst0 = KSWZ(kr0, kc0 * 16), kst1 = KSWZ(kr1, kc1 * 16);
  const int vb0 = (int)(uintptr_t)V_lds + v_rd_base(lane);
  struct { bf16x8 vs, ks0, ks1; } sr_[2];
#define ROWB(k0) (((k0) < 256) ? (MLAT + b * 256 + (k0)) : (b * 4096 + (k0) - 256))
#define SLOAD(i, k0) do { if (FAKE == 1) break; const size_t rb_ = (size_t)ROWB(k0); sr_[i].vs = *reinterpret_cast<const bf16x8*>(vsrc + rb_ * 1024); \
    sr_[i].ks0 = *reinterpret_cast<const bf16x8*>(ksrc0 + rb_ * kstr0); sr_[i].ks1 = *reinterpret_cast<const bf16x8*>(ksrc1 + rb_ * kstr1); } while (0)
#define SWRITE(bf, i) do { *(bf16x8*)(V_lds + (bf) * SHM_V + vst) = sr_[i].vs; *(bf16x8*)(K_lds + (bf) * SHM_K + kst0) = sr_[i].ks0; \
    *(bf16x8*)(K_lds + (bf) * SHM_K + kst1) = sr_[i].ks1; } while (0)
#define RESC(a) do { if (__any((a) < 1.f)) { if (hi == 0) al_l[r32] = (a); asm volatile("s_waitcnt lgkmcnt(0)" ::: "memory"); \
    _Pragma("unroll") for (int d = 0; d < 2; ++d) _Pragma("unroll") for (int r = 0; r < 16; ++r) o[d][r] *= al_l[crow(r, hi)]; } } while (0)
#define BARX() do { if (FAKE != 3) __syncthreads(); } while (0)
#define QKT(P0, P1, KS) do { if (FAKE == 5) { P0 = f32x16{}; P1 = f32x16{}; } else qkt(P0, P1, KS, qr, r32, hi, m_reg); } while (0)
#define PSM(P0, P1, MN, AL) do { if (FAKE == 2) { AL = 1.f; } else partialSM<false>(P0, P1, m_reg, AL); } while (0)
#define PSM0(P0, P1, AL) do { if (FAKE == 2) { AL = 1.f; } else partialSM<true>(P0, P1, m_reg, AL); } while (0)
#define FSM(P0, P1, AL) do { if (FAKE == 2) { u32x4 w_ = {__float_as_uint(P0[0]), __float_as_uint(P0[1]), __float_as_uint(P1[0]), __float_as_uint(P1[1])}; pa0 = pa1 = pa2 = pa3 = *reinterpret_cast<bf16x8*>(&w_); } else finishSM(P0, P1, AL, l_reg, pa0, pa1, pa2, pa3); } while (0)
#define PVD(VB) do { if (FAKE != 4) pv_d0(o, VB, pa0, pa1, pa2, pa3); } while (0)
  f32x16 pA0, pA1, pB0, pB1; float mnA, mnB, alA, alB; bf16x8 pa0, pa1, pa2, pa3; const int NT = nkeys / KVBLK;
  int bo_prev = 0, bo_cur = 0, bo_next = SHM_V;
#define ROT3() do { bo_prev = bo_cur; bo_cur = bo_next; bo_next = (bo_next == 2 * SHM_V) ? 0 : bo_next + SHM_V; } while (0)
#define SWRITE3(off, i) do { if (FAKE == 1) break; *(bf16x8*)(V_lds + (off) + vst) = sr_[i].vs; *(bf16x8*)(K_lds + (off) + kst0) = sr_[i].ks0; *(bf16x8*)(K_lds + (off) + kst1) = sr_[i].ks1; } while (0)
  SLOAD(0, 0); SLOAD(1, KVBLK); SWRITE3(0, 0); SLOAD(0, 2 * KVBLK);
  BARX();
  SWRITE3(bo_next, 1); SLOAD(1, 3 * KVBLK);
  QKT(pA0, pA1, K_lds + bo_cur); PSM0(pA0, pA1, alA); RESC(alA);
  ROT3();
  for (int j = 1; j + 1 < NT; j += 2) {
    BARX();
    SWRITE3(bo_next, 0); { const int tn = (j + 3 < NT) ? j + 3 : NT - 1; SLOAD(0, tn * KVBLK); }
    QKT(pB0, pB1, K_lds + bo_cur);
    FSM(pA0, pA1, alA);
    PVD(vb0 + bo_prev); PSM(pB0, pB1, mnB, alB); RESC(alB);
    ROT3();
    BARX();
    SWRITE3(bo_next, 1); { const int tn = (j + 4 < NT) ? j + 4 : NT - 1; SLOAD(1, tn * KVBLK); }
    QKT(pA0, pA1, K_lds + bo_cur);
    FSM(pB0, pB1, alB);
    PVD(vb0 + bo_prev); PSM(pA0, pA1, mnA, alA); RESC(alA);
    ROT3();
  }
  BARX();
  QKT(pB0, pB1, K_lds + bo_cur);
  FSM(pA0, pA1, alA);
  PVD(vb0 + bo_prev); PSM(pB0, pB1, mnB, alB); RESC(alB);
  FSM(pB0, pB1, alB);
  PVD(vb0 + bo_cur);
#undef ROT3
#undef BARX
#undef QKT
#undef PSM
#undef PSM0
#undef FSM
#undef PVD
#undef SWRITE3
  if (hi == 0) li_l[r32] = l_reg; asm volatile("s_waitcnt lgkmcnt(0)" ::: "memory");
  float rli[16];
#pragma unroll
  for (int r = 0; r < 16; ++r) rli[r] = __builtin_amdgcn_rcpf(li_l[crow(r, hi)]);
  { LAS float* stg = (LAS float*)(unsigned)(uintptr_t)(lds + 3 * SHM_V + 3 * SHM_K + 2048) + wid * (32 * 36);
#pragma unroll
    for (int d0 = 0; d0 < 2; ++d0) {
      u32x4 gw[2];
#pragma unroll
      for (int i2 = 0; i2 < 2; ++i2) { const size_t qrow = (size_t)(qrow0 + wid * QBLK + 16 * i2 + (lane >> 2)); gw[i2] = *(const u32x4*)(Z + qrow * 1024 + h * 64 + d0 * 32 + 8 * (lane & 3)); }
#pragma unroll
      for (int r = 0; r < 16; ++r) stg[crow(r, hi) * 36 + r32] = o[d0][r] * rli[r];
      asm volatile("s_waitcnt lgkmcnt(0)" ::: "memory");
#pragma unroll
      for (int i2 = 0; i2 < 2; ++i2) { const size_t qrow = (size_t)(qrow0 + wid * QBLK + 16 * i2 + (lane >> 2));
        const LAS f32x4* sp = (const LAS f32x4*)(stg + (16 * i2 + (lane >> 2)) * 36 + 8 * (lane & 3)); const f32x4 a0 = sp[0], a1 = sp[1]; const u32x4 g = gw[i2];
        u32x4 w; w.x = pk2(a0[0] * silu_f(lo16(g.x)), a0[1] * silu_f(hi16(g.x))); w.y = pk2(a0[2] * silu_f(lo16(g.y)), a0[3] * silu_f(hi16(g.y)));
        w.z = pk2(a1[0] * silu_f(lo16(g.z)), a1[1] * silu_f(hi16(g.z))); w.w = pk2(a1[2] * silu_f(lo16(g.w)), a1[3] * silu_f(hi16(g.w)));
        *(u32x4*)(BR + qrow * 1024 + h * 64 + d0 * 32 + 8 * (lane & 3)) = w; }
      asm volatile("s_waitcnt lgkmcnt(0)" ::: "memory");
    } }
#undef ROWB
#undef SLOAD
#undef SWRITE
#undef RESC
}
#undef KSWZ
#undef SBAR
}

namespace mla2 {
using s16x4 = __attribute__((ext_vector_type(4))) short;
using f32x16 = __attribute__((ext_vector_type(16))) float;
typedef short v4i16_t __attribute__((ext_vector_type(4)));
typedef __attribute__((address_space(3))) const char* lds_cptr;
typedef float f32x2_t __attribute__((ext_vector_type(2))); typedef __bf16 bf16x2_t __attribute__((ext_vector_type(2)));
constexpr int NSLOT = 3, KSLOT = 12288, VSLOT = 8192;
constexpr int LDS_K = 0, LDS_V = NSLOT * KSLOT, LDS_WS = LDS_V + NSLOT * VSLOT, LDS_STG = LDS_WS + 2048, LDS_END = LDS_STG + 8 * 4608;
#define SBAR() __builtin_amdgcn_sched_barrier(0)
__device__ __forceinline__ int crow(int r, int hi) { return (r & 3) + 8 * (r >> 2) + 4 * hi; }
__device__ __forceinline__ void glds16(const void* gsrc, unsigned lds_dst) { unsigned keep;
  asm volatile("s_mov_b32 %0, m0\n\ts_mov_b32 m0, %2\n\ts_nop 0\n\tglobal_load_lds_dwordx4 %1, off\n\ts_mov_b32 m0, %0" : "=&s"(keep) : "v"(gsrc), "s"(lds_dst) : "memory"); }
__device__ __forceinline__ float max3f(float a, float b, float c) { float r; asm("v_max3_f32 %0, %1, %2, %3" : "=v"(r) : "v"(a), "v"(b), "v"(c)); return r; }
__device__ __forceinline__ float max2f(float a, float b) { float r; asm("v_max_f32_e32 %0, %1, %2" : "=v"(r) : "v"(a), "v"(b)); return r; }
__device__ __forceinline__ float fadd_s(float a, float b) { float r; asm("v_add_f32_e32 %0, %1, %2" : "=v"(r) : "v"(a), "v"(b)); return r; }
__device__ __forceinline__ float fsub_s(float a, float b) { float r; asm("v_sub_f32_e32 %0, %1, %2" : "=v"(r) : "v"(a), "v"(b)); return r; }
__device__ __forceinline__ unsigned cvtpk_s(float lo, float hi) { f32x2_t v = {lo, hi}; bf16x2_t b = __builtin_convertvector(v, bf16x2_t); return __builtin_bit_cast(unsigned, b); }
#define WAIT_BAR(N) asm volatile("s_waitcnt vmcnt(" #N ") lgkmcnt(0)\n\ts_barrier" ::: "memory")
__device__ __forceinline__ void qkt6(f32x16& p0, f32x16& p1, lds_cptr Kslot, const bf16x8* qr, const f32x16& negm, int r32, int hi) {
  lds_cptr kb = Kslot + hi * 1024 + r32 * 16;
#pragma unroll
  for (int d0 = 0; d0 < 6; ++d0) {
    const bf16x8 b0 = *(const LAS bf16x8*)(kb + d0 * 2048), b1 = *(const LAS bf16x8*)(kb + d0 * 2048 + 512);
    if (d0 == 0) { p0 = __builtin_amdgcn_mfma_f32_32x32x16_bf16(b0, qr[0], negm, 0, 0, 0); p1 = __builtin_amdgcn_mfma_f32_32x32x16_bf16(b1, qr[0], negm, 0, 0, 0); }
    else { p0 = __builtin_amdgcn_mfma_f32_32x32x16_bf16(b0, qr[d0], p0, 0, 0, 0); p1 = __builtin_amdgcn_mfma_f32_32x32x16_bf16(b1, qr[d0], p1, 0, 0, 0); } }
}
__device__ __forceinline__ void kload2(bf16x8* kf, lds_cptr kp, int j) { kf[2 * j] = *(const LAS bf16x8*)(kp + j * 2048); kf[2 * j + 1] = *(const LAS bf16x8*)(kp + j * 2048 + 512); }
__device__ __forceinline__ s16x4 vtr(lds_cptr p) { return __builtin_bit_cast(s16x4, __builtin_amdgcn_ds_read_tr16_b64_v4i16((__attribute__((address_space(3))) v4i16_t*)p)); }
__device__ __forceinline__ float rowmax(const f32x16& p0, const f32x16& p1) {
  float a = max3f(p0[0], p0[1], p1[0]), b = max3f(p0[2], p0[3], p1[1]); a = max3f(a, p1[2], p1[3]);
#pragma unroll
  for (int r = 4; r < 16; r += 4) { a = max3f(a, p0[r], p0[r + 1]); b = max3f(b, p0[r + 2], p0[r + 3]); a = max3f(a, p1[r], p1[r + 1]); b = max3f(b, p1[r + 2], p1[r + 3]); }
  const float m = max2f(a, b);
  auto rr = __builtin_amdgcn_permlane32_swap(__float_as_uint(m), __float_as_uint(m), false, false);
  return max2f(__uint_as_float(rr[0]), __uint_as_float(rr[1]));
}
template <int THRL> __device__ __forceinline__ void unit(const bf16_t* __restrict__ Q0, const bf16_t* __restrict__ KV0, const bf16_t* __restrict__ KR, const bf16_t* __restrict__ GATE, bf16_t* __restrict__ BR,
                                                         int qrow0, int b, int h, int nkeys, LAS unsigned char* lds) {
  int tid_ = threadIdx.x; asm volatile("" : "+v"(tid_));
  const int tid = tid_, lane = tid & 63, r32 = lane & 31, hi = lane >> 5; const int wid = __builtin_amdgcn_readfirstlane(tid >> 6);
  const unsigned lds0 = (unsigned)(uintptr_t)lds;
  LAS float* wsf = (LAS float*)(lds + LDS_WS) + wid * 64;
  const bf16_t* ks0 = KV0 + (size_t)lane * 1024 + h * 128 + wid * 8;
  const bf16_t* ks1 = KR + (size_t)lane * 32 + (wid & 3) * 8;
  const bf16_t* vs = KV0 + (size_t)(16 * (wid & 3) + (lane >> 2)) * 1024 + h * 128 + 64 + (wid >> 2) * 32 + (lane & 3) * 8;
  const unsigned kd0 = lds0 + LDS_K + wid * 1024, kd1 = lds0 + LDS_K + (8 + (wid & 3)) * 1024, vd = lds0 + LDS_V + wid * 1024;
#define ROWB(t) (((t) < 4) ? (MLAT + b * 256 + 64 * (t)) : (b * 4096 + 64 * ((t) - 4)))
#define DMA_K(t, slot) do { const size_t rb_ = (size_t)ROWB(t); glds16(ks0 + rb_ * 1024, (unsigned)__builtin_amdgcn_readfirstlane(kd0 + (slot))); glds16(ks1 + rb_ * 32, (unsigned)__builtin_amdgcn_readfirstlane(kd1 + (slot))); } while (0)
#define DMA_V(t, slot) do { const size_t rb_ = (size_t)ROWB(t); glds16(vs + rb_ * 1024, (unsigned)__builtin_amdgcn_readfirstlane(vd + (slot))); } while (0)
  const lds_cptr shm3 = (lds_cptr)lds; const lds_cptr kp0 = shm3 + LDS_K + hi * 1024 + r32 * 16;
  const lds_cptr vp0 = shm3 + LDS_V + ((lane >> 4) & 1) * 32 + (lane & 3) * 8 + (4 * hi + ((lane & 15) >> 2)) * 64;
  bf16x8 kf[12];
  const int NT = nkeys / 64;
  DMA_K(0, 0); DMA_V(0, 0); DMA_K(1, KSLOT);
  bf16x8 qr[6];
  { const bf16_t* Qw = Q0 + (size_t)(qrow0 + wid * 32 + r32) * 768 + h * 96 + hi * 8;
#pragma unroll
    for (int d0 = 0; d0 < 6; ++d0) qr[d0] = *reinterpret_cast<const bf16x8*>(Qw + d0 * 16); }
  float mhat = 0.f, l_reg = 0.f; f32x16 o[2]; o[0] = f32x16{}; o[1] = f32x16{}; f32x16 negm = f32x16{}; asm volatile("" : "+v"(negm));
  bool resc = false;
#define START(P0, P1) do { const float rm = rowmax(P0, P1); resc = false; \
    { const float dl = rm; mhat = fadd_s(mhat, dl); \
      _Pragma("unroll") for (int r = 0; r < 16; ++r) { P0[r] = fsub_s(P0[r], dl); P1[r] = fsub_s(P1[r], dl); } \
      _Pragma("unroll") for (int r = 0; r < 16; ++r) negm[r] = -mhat; asm volatile("" : "+v"(negm)); } \
    _Pragma("unroll") for (int r = 0; r < 16; ++r) P0[r] = __builtin_amdgcn_exp2f(P0[r]); } while (0)
#define RESC() do { if (resc) { asm volatile("s_waitcnt lgkmcnt(0)" ::: "memory"); \
      _Pragma("unroll") for (int d_ = 0; d_ < 2; ++d_) _Pragma("unroll") for (int r = 0; r < 16; ++r) o[d_][r] *= wsf[crow(r, hi)]; } } while (0)
  f32x16 pA0, pA1, pB0, pB1;
  int ks_cur = 0, ks_next = KSLOT, vs_prev = 0, vs_cur = 0, vs_next = VSLOT;
#define ROT() do { ks_cur = ks_next; ks_next = (ks_next == (NSLOT - 1) * KSLOT) ? 0 : ks_next + KSLOT; vs_prev = vs_cur; vs_cur = vs_next; vs_next = (vs_next == (NSLOT - 1) * VSLOT) ? 0 : vs_next + VSLOT; } while (0)
  DMA_K(2, 2 * KSLOT);
  WAIT_BAR(5);
  qkt6(pA0, pA1, shm3 + LDS_K, qr, negm, r32, hi); asm volatile("s_nop 15\n\ts_nop 7" : "+v"(pA0), "+v"(pA1));
  START(pA0, pA1);
#pragma unroll
  for (int r = 0; r < 16; ++r) pA1[r] = __builtin_amdgcn_exp2f(pA1[r]);
  WAIT_BAR(0);
  DMA_K(3, 0); DMA_V(1, VSLOT);
  ROT();
#pragma unroll
  for (int j = 0; j < 6; ++j) kload2(kf, kp0 + ks_cur, j);
  WAIT_BAR(3);
  s16x4 vlo[8], vhi[8]; u32x4 pw0, pw1, pw2, pw3;
#define PKW(P, B) cvtpk_s(P[B], P[B + 1])
#define PAF(k) __builtin_bit_cast(bf16x8, pw##k)
#define VFR(i) (bf16x8){vlo[i][0], vlo[i][1], vlo[i][2], vlo[i][3], vhi[i][0], vhi[i][1], vhi[i][2], vhi[i][3]}
#define PIN(x) asm volatile("" : "+v"(x))
#define MX3(a, b, c) __builtin_fmaxf(__builtin_fmaxf((a), (b)), (c))
#define GAPA(MF, A0, A1, A2, A3, W0, W1, PW) do { MF; sacc += A0; sacc += A1; sacc += A2; sacc += A3; PIN(sacc); W0; W1; PIN(PW); SBAR(); } while (0)
#define GAPM(MF) do { MF; SBAR(); } while (0)
#define EX(v) __builtin_amdgcn_exp2f(v)
#define GAPB(MF, X, B) do { MF; X[B] = EX(X[B]); X[B + 1] = EX(X[B + 1]); X[B + 2] = EX(X[B + 2]); X[B + 3] = EX(X[B + 3]); PIN(X); SBAR(); } while (0)
#define VRD(i) do { vlo[i] = vtr(vp_ + (((i) >> 2) * 4096 + ((i) & 3) * 1024)); vhi[i] = vtr(vp_ + (((i) >> 2) * 4096 + ((i) & 3) * 1024 + 512)); } while (0)
#define KRD(G, j) do { if (G) { kload2(kf, kp0 + ks_next, j); SBAR(); } } while (0)
#define MF32(A, B, C) __builtin_amdgcn_mfma_f32_32x32x16_bf16(A, B, C, 0, 0, 0)
#define STEP(C0, C1, P0, P1, t, GK, GV, GL) do { SBAR(); \
    const lds_cptr vp_ = vp0 + vs_prev; \
    VRD(0); SBAR(); float sacc = (P0[0] + P0[1]); \
    GAPA(C0 = MF32(kf[0], qr[0], negm), P0[2], P0[3], P0[4], P0[5],     pw0[0] = PKW(P0, 0), pw0[1] = PKW(P0, 2), pw0); \
    VRD(4); SBAR(); GAPA(C1 = MF32(kf[1], qr[0], negm), P0[6], P0[7], P0[8], P0[9],     pw0[2] = PKW(P0, 4), pw0[3] = PKW(P0, 6), pw0); \
    VRD(1); SBAR(); GAPA(C0 = MF32(kf[2], qr[1], C0),   P0[10], P0[11], P0[12], P0[13], pw1[0] = PKW(P0, 8), pw1[1] = PKW(P0, 10), pw1); \
    VRD(5); SBAR(); GAPA(C1 = MF32(kf[3], qr[1], C1),   P0[14], P0[15], P1[0], P1[1],   pw1[2] = PKW(P0, 12), pw1[3] = PKW(P0, 14), pw1); \
    VRD(2); SBAR(); GAPA(C0 = MF32(kf[4], qr[2], C0),   P1[2], P1[3], P1[4], P1[5],     pw2[0] = PKW(P1, 0), pw2[1] = PKW(P1, 2), pw2); \
    VRD(6); SBAR(); GAPA(C1 = MF32(kf[5], qr[2], C1),   P1[6], P1[7], P1[8], P1[9],     pw2[2] = PKW(P1, 4), pw2[3] = PKW(P1, 6), pw2); \
    VRD(3); SBAR(); GAPA(C0 = MF32(kf[6], qr[3], C0),   P1[10], P1[11], P1[12], P1[13], pw3[0] = PKW(P1, 8), pw3[1] = PKW(P1, 10), pw3); \
    VRD(7); SBAR(); GAPA(C1 = MF32(kf[7], qr[3], C1),   P1[14], P1[15], 0.f, 0.f,       pw3[2] = PKW(P1, 12), pw3[3] = PKW(P1, 14), pw3); \
    GAPM(C0 = MF32(kf[8], qr[4], C0)); GAPM(C1 = MF32(kf[9], qr[4], C1)); GAPM(C0 = MF32(kf[10], qr[5], C0)); GAPM(C1 = MF32(kf[11], qr[5], C1)); \
    l_reg += sacc; \
    if (GK) { DMA_K((t) + 3, ks_cur); } if (GV) { DMA_V((t) + 1, vs_next); } \
    { float a = MX3(C0[0], C0[1], C1[0]), bq = MX3(C0[2], C0[3], C1[1]); a = MX3(a, C1[2], C1[3]); \
      _Pragma("unroll") for (int r = 4; r < 16; r += 4) { a = MX3(a, C0[r], C0[r + 1]); bq = MX3(bq, C0[r + 2], C0[r + 3]); a = MX3(a, C1[r], C1[r + 1]); bq = MX3(bq, C1[r + 2], C1[r + 3]); } \
      float rm = __builtin_fmaxf(a, bq); { auto rr = __builtin_amdgcn_permlane32_swap(__float_as_uint(rm), __float_as_uint(rm), false, false); rm = __builtin_fmaxf(__uint_as_float(rr[0]), __uint_as_float(rr[1])); } \
      resc = false; \
      if (__builtin_expect(__any(rm > (float)THRL), 0)) { const float dl = __builtin_fmaxf(rm, 0.f); mhat += dl; \
        _Pragma("unroll") for (int r = 0; r < 16; ++r) { C0[r] -= dl; C1[r] -= dl; } \
        _Pragma("unroll") for (int r = 0; r < 16; ++r) negm[r] = -mhat; asm volatile("" : "+v"(negm)); \
        const float f = __builtin_amdgcn_exp2f(-dl); l_reg *= f; if (hi == 0) wsf[r32] = f; resc = true; } } \
    SBAR(); \
    KRD(GL, 0); GAPB(o[0] = MF32(PAF(0), VFR(0), o[0]), C0, 0); \
    KRD(GL, 1); GAPB(o[1] = MF32(PAF(0), VFR(4), o[1]), C0, 4); \
    KRD(GL, 2); GAPB(o[0] = MF32(PAF(1), VFR(1), o[0]), C0, 8); \
    KRD(GL, 3); GAPB(o[1] = MF32(PAF(1), VFR(5), o[1]), C0, 12); \
    KRD(GL, 4); GAPB(o[0] = MF32(PAF(2), VFR(2), o[0]), C1, 0); \
    KRD(GL, 5); GAPB(o[1] = MF32(PAF(2), VFR(6), o[1]), C1, 4); \
    GAPB(o[0] = MF32(PAF(3), VFR(3), o[0]), C1, 8); \
    GAPB(o[1] = MF32(PAF(3), VFR(7), o[1]), C1, 12); \
  } while (0)
  int t = 1;
  for (; t + 5 < NT; t += 2) {
    STEP(pB0, pB1, pA0, pA1, t, true, true, true);     WAIT_BAR(3); RESC(); ROT();
    STEP(pA0, pA1, pB0, pB1, t + 1, true, true, true); WAIT_BAR(3); RESC(); ROT();
  }
#define ENDW(tt) do { if ((tt) + 3 < NT) { WAIT_BAR(3); } else if ((tt) + 2 < NT) { WAIT_BAR(1); } else { WAIT_BAR(0); } } while (0)
  for (; t + 1 < NT; t += 2) {
    STEP(pB0, pB1, pA0, pA1, t, (t + 3 < NT), (t + 1 < NT), (t + 1 < NT));     ENDW(t);     RESC(); ROT();
    STEP(pA0, pA1, pB0, pB1, t + 1, (t + 4 < NT), (t + 2 < NT), (t + 2 < NT)); ENDW(t + 1); RESC(); ROT();
  }
  STEP(pB0, pB1, pA0, pA1, NT - 1, false, false, false); RESC();
  { float sacc = pB0[0] + pB0[1];
#pragma unroll
    for (int r = 2; r < 16; ++r) sacc += pB0[r];
#pragma unroll
    for (int r = 0; r < 16; ++r) sacc += pB1[r];
    l_reg += sacc;
    pw0 = (u32x4){PKW(pB0, 0), PKW(pB0, 2), PKW(pB0, 4), PKW(pB0, 6)}; pw1 = (u32x4){PKW(pB0, 8), PKW(pB0, 10), PKW(pB0, 12), PKW(pB0, 14)};
    pw2 = (u32x4){PKW(pB1, 0), PKW(pB1, 2), PKW(pB1, 4), PKW(pB1, 6)}; pw3 = (u32x4){PKW(pB1, 8), PKW(pB1, 10), PKW(pB1, 12), PKW(pB1, 14)};
    SBAR();
    const lds_cptr vp_ = vp0 + vs_cur;
    VRD(0); VRD(1); VRD(2); VRD(3); VRD(4); VRD(5); VRD(6); VRD(7);
    o[0] = MF32(PAF(0), VFR(0), o[0]); o[1] = MF32(PAF(0), VFR(4), o[1]); o[0] = MF32(PAF(1), VFR(1), o[0]); o[1] = MF32(PAF(1), VFR(5), o[1]);
    o[0] = MF32(PAF(2), VFR(2), o[0]); o[1] = MF32(PAF(2), VFR(6), o[1]); o[0] = MF32(PAF(3), VFR(3), o[0]); o[1] = MF32(PAF(3), VFR(7), o[1]); }
  { auto rr = __builtin_amdgcn_permlane32_swap(__float_as_uint(l_reg), __float_as_uint(l_reg), false, false); l_reg = __uint_as_float(rr[0]) + __uint_as_float(rr[1]); }
  if (hi == 0) wsf[32 + r32] = l_reg; asm volatile("s_waitcnt lgkmcnt(0)" ::: "memory");
  float rli[16];
#pragma unroll
  for (int r = 0; r < 16; ++r) rli[r] = __builtin_amdgcn_rcpf(wsf[32 + crow(r, hi)]);
  { LAS float* stg = (LAS float*)(lds + LDS_STG) + wid * (32 * 36);
#pragma unroll
    for (int d0 = 0; d0 < 2; ++d0) {
      u32x4 gw[2];
#pragma unroll
      for (int i2 = 0; i2 < 2; ++i2) { const size_t qrow = (size_t)(qrow0 + wid * 32 + 16 * i2 + (lane >> 2)); gw[i2] = *(const u32x4*)(GATE + qrow * 1024 + h * 64 + d0 * 32 + 8 * (lane & 3)); }
#pragma unroll
      for (int r = 0; r < 16; ++r) stg[crow(r, hi) * 36 + r32] = o[d0][r] * rli[r];
      asm volatile("s_waitcnt lgkmcnt(0)" ::: "memory");
#pragma unroll
      for (int i2 = 0; i2 < 2; ++i2) { const size_t qrow = (size_t)(qrow0 + wid * 32 + 16 * i2 + (lane >> 2));
        const LAS f32x4* sp = (const LAS f32x4*)(stg + (16 * i2 + (lane >> 2)) * 36 + 8 * (lane & 3)); const f32x4 a0 = sp[0], a1 = sp[1]; const u32x4 g = gw[i2];
        u32x4 w; w.x = pk2(a0[0] * silu_f(lo16(g.x)), a0[1] * silu_f(hi16(g.x))); w.y = pk2(a0[2] * silu_f(lo16(g.y)), a0[3] * silu_f(hi16(g.y)));
        w.z = pk2(a1[0] * silu_f(lo16(g.z)), a1[1] * silu_f(hi16(g.z))); w.w = pk2(a1[2] * silu_f(lo16(g.w)), a1[3] * silu_f(hi16(g.w)));
        *(u32x4*)(BR + qrow * 1024 + h * 64 + d0 * 32 + 8 * (lane & 3)) = w; }
      asm volatile("s_waitcnt lgkmcnt(0)" ::: "memory");
    } }
  asm volatile("s_waitcnt vmcnt(0) lgkmcnt(0)\n\ts_barrier" ::: "memory");
#undef ROWB
#undef DMA_K
#undef DMA_V
#undef START
#undef RESC
#undef ROT
#undef PKW
#undef PAF
#undef VFR
#undef PIN
#undef MX3
#undef GAPA
#undef GAPM
#undef EX
#undef GAPB
#undef VRD
#undef KRD
#undef MF32
#undef STEP
#undef ENDW
}
#undef SBAR
#undef WAIT_BAR
}

template <int FAKE> __device__ __forceinline__ void phase_mla(KArgs a0, const Fr& F0) {
    const Fr F = launder(F0); const KArgs a = klaunder(a0);
    const bf16_t* Q0 = (const bf16_t*)(WSP(a) + WS_Q0); const bf16_t* KV0 = (const bf16_t*)(WSP(a) + WS_KV0); const bf16_t* KR = (const bf16_t*)(WSP(a) + WS_KR);
    const bf16_t* Z = (const bf16_t*)(WSP(a) + WS_GATE); bf16_t* BR = (bf16_t*)(WSP(a) + WS_HB);
    const int vcu = (gridDim.x % 8 == 0) ? ((int)blockIdx.x % 8) * ((int)gridDim.x / 8) + (int)blockIdx.x / 8 : (int)blockIdx.x;
    for (int u = vcu; u < 1024 + 64; u += gridDim.x) {
        __syncthreads();
        if (u < 1024) { const int bh = u >> 4, qb = u & 15, b = bh >> 3, h = bh & 7; if (MLA_V2 && FAKE == 0) mla2::unit<11>(Q0, KV0, KR, Z, BR, b * 4096 + qb * 256, b, h, 4352, F.lds); else mla::unit<FAKE>(Q0, KV0, KR, Z, BR, b * 4096 + qb * 256, b, h, 4352, (char*)F.lds); }
        else { const int bh = u - 1024, b = bh >> 3, h = bh & 7; if (MLA_V2 && FAKE == 0) mla2::unit<11>(Q0, KV0, KR, Z, BR, MLAT + b * 256, b, h, 256, F.lds); else mla::unit<FAKE>(Q0, KV0, KR, Z, BR, MLAT + b * 256, b, h, 256, (char*)F.lds); }
    }
    __syncthreads();
}

namespace na {
using f32x16 = __attribute__((ext_vector_type(16))) float;
constexpr float C1 = 0.125f * 1.4426950408889634f, L2E = 1.4426950408889634f, THR2 = 11.5f;
__device__ __forceinline__ int crow(int r, int hi) { return (r & 3) + 8 * (r >> 2) + 4 * hi; }
__device__ __forceinline__ unsigned cvtpk(float lo, float hi) { unsigned r; asm volatile("v_cvt_pk_bf16_f32 %0, %1, %2" : "=v"(r) : "v"(lo), "v"(hi)); return r; }
constexpr int RING_OFF = 0, SLOT = 16384, NSLOT = 4, TAB_OFF = 69632, WSF_OFF = 73728, STG_OFF = 81920;
template <int FAKE> __device__ __forceinline__ void item(bf16_t* __restrict__ Z, const bf16_t* __restrict__ VT, LAS unsigned char* lds, int b, int h, bool lat, int q4) {
  int tid_ = threadIdx.x; asm volatile("" : "+v"(tid_));
  const int tid = tid_, lane = tid & 63, r32 = lane & 31, hi = lane >> 5, wid = __builtin_amdgcn_readfirstlane(tid >> 6);
  const LAS float* tab = (const LAS float*)(lds + TAB_OFF); LAS float* wsf = (LAS float*)(lds + WSF_OFF) + wid * 64;
  const int rp = 2 * q4 + (wid >> 2), ct = wid & 3;
  int rq = 0, cq = 0, qtok;
  if (lat) { rq = 2 * rp + (r32 >> 4); cq = 16 * ct + (r32 & 15); qtok = b * 4096 + rq * 64 + cq; } else qtok = MLAT + b * 256 + 32 * wid + r32;
  int rs0 = 2 * rp - 4; rs0 = rs0 < 0 ? 0 : (rs0 > 56 ? 56 : rs0);
  int rs1 = 2 * rp - 3; rs1 = rs1 < 0 ? 0 : (rs1 > 56 ? 56 : rs1);
  int u0 = 16 * ct - 8; u0 = u0 < 0 ? 0 : (u0 > 32 ? 32 : u0);
  int rsq = rq - 4; rsq = rsq < 0 ? 0 : (rsq > 56 ? 56 : rsq);
  int csq = cq - 8; csq = csq < 0 ? 0 : (csq > 48 ? 48 : csq);
  int rsA = 4 * q4 - 4; rsA = rsA < 0 ? 0 : (rsA > 56 ? 56 : rsA);
  int rsB = 4 * q4 - 1; rsB = rsB < 0 ? 0 : (rsB > 56 ? 56 : rsB);
  const int nst = lat ? 4 + (rsB - rsA + 8) : 4;
  bf16x8 qr[4];
  { const bf16_t* qp = Z + (size_t)qtok * 4096 + h * 64 + hi * 8;
#pragma unroll
    for (int d0 = 0; d0 < 4; ++d0) qr[d0] = *reinterpret_cast<const bf16x8*>(qp + d0 * 16); }
  const int srow = 8 * wid + (lane >> 3), sch = (lane & 7) ^ ((srow >> 1) & 7);
  const bf16_t* ksrc = Z + (size_t)srow * 4096 + 1024 + h * 64 + 8 * sch;
  const bf16_t* vsrc = VT + ((size_t)sch * 1024 + h * 64 + srow) * 8;
#define TOKB(s) (((s) < 4) ? (MLAT + b * 256 + 64 * (s)) : (b * 4096 + (rsA + (s) - 4) * 64))
  const unsigned ldsb = (unsigned)(uintptr_t)(lds + RING_OFF) + (unsigned)wid * 1024u;
#define GLDS16(gsrc, dst) do { unsigned keep_; asm volatile("s_mov_b32 %0, m0\n\ts_mov_b32 m0, %2\n\ts_nop 0\n\tglobal_load_lds_dwordx4 %1, off\n\ts_mov_b32 m0, %0" : "=&s"(keep_) : "v"(gsrc), "s"(dst) : "memory"); } while (0)
#define ISSUE(s) do { if (FAKE == 1) break; const int tb_ = TOKB(s); const unsigned sl_ = (unsigned)__builtin_amdgcn_readfirstlane(ldsb + (unsigned)(((s) & 3) * SLOT)); \
    GLDS16(ksrc + (size_t)tb_ * 4096, sl_); GLDS16(vsrc + (size_t)(tb_ >> 3) * 8192, sl_ + 8192u); } while (0)
  const int swz = (r32 >> 1) & 7;
  f32x16 o[2] = {}; float m_reg = 0.f, l_reg = 0.f;
#define PK4(P, BASE, OUT) do { unsigned a0 = cvtpk(P[BASE + 0], P[BASE + 1]), a1 = cvtpk(P[BASE + 2], P[BASE + 3]);   \
    unsigned b0 = cvtpk(P[BASE + 4], P[BASE + 5]), b1 = cvtpk(P[BASE + 6], P[BASE + 7]);                              \
    auto r0 = __builtin_amdgcn_permlane32_swap(a0, b0, false, false); auto r1 = __builtin_amdgcn_permlane32_swap(a1, b1, false, false); \
    u32x4 w = {r0[0], r1[0], r0[1], r1[1]}; OUT = *reinterpret_cast<bf16x8*>(&w); } while (0)
#define BLOCK(SL, krow0, kswz, vch0, WIN, kr, FIRSTB) do { \
    bf16x8 kf[4], vf[2][2]; \
    { const LAS unsigned char* kp_ = (SL) + ((krow0) + r32) * 128; \
      _Pragma("unroll") for (int d0 = 0; d0 < 4; ++d0) kf[d0] = *(const LAS bf16x8*)(kp_ + (((2 * d0 + hi) ^ (kswz)) << 4)); \
      _Pragma("unroll") for (int d0 = 0; d0 < 2; ++d0) _Pragma("unroll") for (int ks = 0; ks < 2; ++ks) \
        vf[d0][ks] = *(const LAS bf16x8*)((SL) + 8192 + (32 * d0 + r32) * 128 + ((((vch0) + 2 * ks + hi) ^ swz) << 4)); } \
    f32x16 p; \
    _Pragma("unroll") for (int r = 0; r < 16; ++r) p[r] = -m_reg;                   \
    if (FAKE != 5) { _Pragma("unroll") for (int d0 = 0; d0 < 4; ++d0) p = __builtin_amdgcn_mfma_f32_32x32x16_bf16(kf[d0], qr[d0], p, 0, 0, 0); } \
    if (FAKE != 2) { \
    if (WIN) { \
      const bool rowok = (unsigned)((kr) - rsq) < 8u; \
      const LAS float* tp = tab + ((kr) - rq + 7) * 31 + (u0 - cq + 15) + 4 * hi; \
      const int kc0 = u0 + 4 * hi - csq; \
      _Pragma("unroll") for (int r = 0; r < 16; ++r) { const int off = (r & 3) + 8 * (r >> 2); const bool ok = rowok && ((unsigned)(kc0 + off) < 16u); \
        const float bv = tp[off]; p[r] = ok ? (p[r] + bv) : -1e30f; } \
    } \
    float bmax = p[0]; \
    _Pragma("unroll") for (int r = 1; r < 16; ++r) bmax = fmaxf(bmax, p[r]); \
    { auto rr = __builtin_amdgcn_permlane32_swap(__float_as_uint(bmax), __float_as_uint(bmax), false, false); bmax = fmaxf(__uint_as_float(rr[0]), __uint_as_float(rr[1])); } \
    if ((FIRSTB) || !__all(bmax <= THR2)) { \
      const float dl = (FIRSTB) ? bmax : fmaxf(bmax, 0.f); m_reg += dl; \
      _Pragma("unroll") for (int r = 0; r < 16; ++r) p[r] -= dl; \
      if (!(FIRSTB)) { const float alpha = __builtin_amdgcn_exp2f(-dl); l_reg *= alpha; \
        if (hi == 0) wsf[r32] = alpha; asm volatile("s_waitcnt lgkmcnt(0)" ::: "memory"); \
        _Pragma("unroll") for (int d = 0; d < 2; ++d) _Pragma("unroll") for (int r = 0; r < 16; ++r) o[d][r] *= wsf[crow(r, hi)]; } \
    } \
    float ps = 0.f; \
    _Pragma("unroll") for (int r = 0; r < 16; ++r) { p[r] = __builtin_amdgcn_exp2f(p[r]); ps += p[r]; } \
    l_reg += ps; \
    } \
    bf16x8 pa0, pa1; PK4(p, 0, pa0); PK4(p, 8, pa1); \
    if (FAKE != 4) { _Pragma("unroll") for (int d0 = 0; d0 < 2; ++d0) { o[d0] = __builtin_amdgcn_mfma_f32_32x32x16_bf16(pa0, vf[d0][0], o[d0], 0, 0, 0); o[d0] = __builtin_amdgcn_mfma_f32_32x32x16_bf16(pa1, vf[d0][1], o[d0], 0, 0, 0); } } \
  } while (0)
  const int kswzw = ((u0 + r32) >> 1) & 7;
  ISSUE(0); ISSUE(1);
  for (int s = 0; s < nst; ++s) {
    if (s + 1 < nst) asm volatile("s_waitcnt vmcnt(2)" ::: "memory"); else asm volatile("s_waitcnt vmcnt(0)" ::: "memory");
    asm volatile("s_waitcnt lgkmcnt(0)" ::: "memory");
    if (FAKE != 3) __builtin_amdgcn_s_barrier();
    if (s + 2 < nst) ISSUE(s + 2);
    const LAS unsigned char* sl = lds + RING_OFF + (s & 3) * SLOT;
    if (s == 0) { BLOCK(sl, 0, swz, 0, false, 0, true); BLOCK(sl, 32, swz, 4, false, 0, false); }
    else if (s < 4) { BLOCK(sl, 0, swz, 0, false, 0, false); BLOCK(sl, 32, swz, 4, false, 0, false); }
    else { const int kr = rsA + s - 4; if (kr >= rs0 && kr <= rs1 + 7) BLOCK(sl, u0, kswzw, (u0 >> 3), true, kr, false); }
  }
#undef BLOCK
#undef PK4
#undef ISSUE
#undef GLDS16
#undef TOKB
  { auto rr = __builtin_amdgcn_permlane32_swap(__float_as_uint(l_reg), __float_as_uint(l_reg), false, false); l_reg = __uint_as_float(rr[0]) + __uint_as_float(rr[1]); }
  if (hi == 0) wsf[32 + r32] = l_reg; asm volatile("s_waitcnt lgkmcnt(0)" ::: "memory");
  if (FAKE == 6) return;
  { LAS float* stg = (LAS float*)(lds + STG_OFF) + wid * (32 * 36);
    float rli[16];
#pragma unroll
    for (int r = 0; r < 16; ++r) rli[r] = __builtin_amdgcn_rcpf(wsf[32 + crow(r, hi)]);
#pragma unroll
    for (int d0 = 0; d0 < 2; ++d0) {
      u32x4 gw[2]; size_t toks[2];
#pragma unroll
      for (int i2 = 0; i2 < 2; ++i2) { const int qi = 16 * i2 + (lane >> 2);
        toks[i2] = lat ? (size_t)(b * 4096 + (2 * rp + (qi >> 4)) * 64 + 16 * ct + (qi & 15)) : (size_t)(MLAT + b * 256 + 32 * wid + qi);
        gw[i2] = *(const u32x4*)(Z + toks[i2] * 4096 + 3072 + h * 64 + d0 * 32 + 8 * (lane & 3)); }
#pragma unroll
      for (int r = 0; r < 16; ++r) stg[crow(r, hi) * 36 + r32] = o[d0][r] * rli[r];
      asm volatile("s_waitcnt lgkmcnt(0)" ::: "memory");
#pragma unroll
      for (int i2 = 0; i2 < 2; ++i2) { const LAS f32x4* sp = (const LAS f32x4*)(stg + (16 * i2 + (lane >> 2)) * 36 + 8 * (lane & 3)); const f32x4 a0 = sp[0], a1 = sp[1]; const u32x4 g = gw[i2];
        u32x4 w; w.x = pk2(a0[0] * silu_f(lo16(g.x)), a0[1] * silu_f(hi16(g.x))); w.y = pk2(a0[2] * silu_f(lo16(g.y)), a0[3] * silu_f(hi16(g.y)));
        w.z = pk2(a1[0] * silu_f(lo16(g.z)), a1[1] * silu_f(hi16(g.z))); w.w = pk2(a1[2] * silu_f(lo16(g.w)), a1[3] * silu_f(hi16(g.w)));
        *(u32x4*)(Z + toks[i2] * 4096 + 2048 + h * 64 + d0 * 32 + 8 * (lane & 3)) = w; }
      asm volatile("s_waitcnt lgkmcnt(0)" ::: "memory");
    } }
}
}

template <int FAKE> __device__ __forceinline__ void phase_na(KArgs a0, const Fr& F0, int i, bool need_ctx) {
    const Fr F = launder(F0); const KArgs a = klaunder(a0);
    bf16_t* Z = (bf16_t*)(WSP(a) + WS_Z); const bf16_t* VT = (const bf16_t*)(WSP(a) + WS_VT);
    const float* rpb = INP(a, 25) + (size_t)i * 16 * 465;
    LAS float* tab = (LAS float*)(F.lds + na::TAB_OFF);
    const int vcu = (gridDim.x % 8 == 0) ? ((int)blockIdx.x % 8) * ((int)gridDim.x / 8) + (int)blockIdx.x / 8 : (int)blockIdx.x;
    const int nitems = 8 * 16 * 16 + (need_ctx ? 8 * 16 : 0);
    for (int it = vcu; it < nitems; it += gridDim.x) {
        const bool lat = it < 2048;
        int b, h, q4 = 0;
        if (lat) { q4 = it & 15; h = (it >> 4) & 15; b = it >> 8; } else { const int j = it - 2048; h = j & 15; b = j >> 4; }
        __syncthreads();
        for (int t = F.tid; t < 465; t += NTHR) tab[t] = rpb[h * 465 + t] * na::L2E;
        __syncthreads();
        na::item<FAKE>(Z, VT, F.lds, b, h, lat, q4);
    }
    __syncthreads();
}

__device__ __forceinline__ void run_gemm(const Fr& F, const pg8::GD& g, void* xl = nullptr, void* xc = nullptr, int site = 31, int rot = 0) {
    pg8::Sched S; S.init(g, (int)gridDim.x, (int)((blockIdx.x + rot) % gridDim.x));
    pg8::EpiBf16 E{g.O, g.ldc, g.split_cols, g.vtb, g.ek, g.p1, g.p2, g.p3, g.p4, g.p5, g.i1, xl, xc};
    if ((PROBE_NOEPI >> site) & 1) { pg8::EpiBf16 E0 = E; E0.ek = 99; pg8::gemm_phase<pg8::EpiBf16>(F.lds, g, S, E0); }
    for (int rep = 0; rep < (((PROBE_SITES >> site) & 1) ? 2 : 1); ++rep) pg8::gemm_phase<pg8::EpiBf16>(F.lds, g, S, E);
}

__global__ void __launch_bounds__(NTHR, 2) mega_fwd(Args a_unused) {
    const KArgs a_k = (KArgs)__builtin_amdgcn_kernarg_segment_ptr(); const KArgs a = a_k;
    extern __shared__ __attribute__((aligned(16))) unsigned char lds_raw[];
    cg::grid_group grid = cg::this_grid();
    Fr F; F.lds = (LAS unsigned char*)lds_raw; F.tid = threadIdx.x; F.lane = F.tid & 63; F.wave = __builtin_amdgcn_readfirstlane(F.tid >> 6);
    F.gw = blockIdx.x * NWAVES + F.wave; F.NGW = gridDim.x * NWAVES; F.gt = blockIdx.x * NTHR + F.tid; F.NGT = gridDim.x * NTHR;
    unsigned char* ws = WSP(klaunder(a));
    volatile LAS unsigned* bst = (volatile LAS unsigned*)(F.lds + LDS_BYTES - 64);
    if (F.tid < 16) bst[F.tid] = 0u;
    __syncthreads();
    const unsigned xcc_x = xcd_barrier_post((unsigned*)(ws + WS_CTL) + 4096, bst).x;
#define GSYNC() do { XcdBarrier xb_; xb_.bar = (unsigned*)(WSP(klaunder(a_k)) + WS_CTL) + 4096; { unsigned x_ = xcc_x; asm volatile("" : "+s"(x_)); xb_.x = x_; } xb_.st = (volatile LAS unsigned*)(F.lds + LDS_BYTES - 64); xcd_barrier(xb_); } while (0)
    for (int rep = 0; rep < PROBE_PRO; ++rep) { phase_mod(a, F); phase_s5_setup(a, F, 0); }
    { u32x4* ux = (u32x4*)(ws + WS_UX);
      for (int t = F.gt; t < 32 * (NCHP - NCHR) * 96; t += F.NGT) { const int g = t / ((NCHP - NCHR) * 96), rem = t % ((NCHP - NCHR) * 96); ux[((size_t)(g * NCHP + NCHR)) * 96 + rem] = (u32x4){0u, 0u, 0u, 0u}; } }
    grid.sync();
    for (int rep = 0; rep < PROBE_PRO; ++rep) { phase_weights(a, F, 0); __syncthreads();
    for (int rep2 = 0; rep2 < PROBE_S5; ++rep2) phase_s5_kt(a, F, 0);
    phase_shw(a, F);
    phase_rn0(a, F); }
    GSYNC();
    for (int l = 0; l < 4; ++l) {
        const int i = l >> 1;
        const KArgs a = klaunder(a_k); unsigned char* ws = WSP(a);
        float* Xctx = (float*)(ws + WS_XCTX);
        const float* MODp = (const float*)(ws + WS_MOD); const float* SSQp = (const float*)(ws + WS_SSQ);
        const float* SHWl = (const float*)(ws + WS_SHW) + (size_t)l * 9 * 4096;
        const float* xol = (l == 0) ? INP(a, 0) : (const float*)OUTP(a); const float* xoc = (l == 0) ? INP(a, 2) : (const float*)Xctx;
        const float* gnext = (l < 3) ? INP(a, 6) + (l + 1) * 1024 : nullptr;
        if (l < 3) for (int rep = 0; rep < PROBE_WGT; ++rep) { phase_weights(a, F, l + 1); if (((l + 1) & 1) == 0) phase_s5_setup(a, F, (l + 1) >> 1); __syncthreads(); }
        if ((l & 1) == 0) {
            if (l == 0) for (int rep = 0; rep < PROBE_S5; ++rep) phase_s5_tables(a, F, i);
            { pg8::GD g{(const bf16_t*)(ws + WS_HB), (const bf16_t*)(ws + WS_WEVIN), nullptr, 1024, 1024, EVEN_INP, MROWS / 256, EVEN_INP / 256, 0, 0, 0, 1, SSQp, SHWl, 0, (const void*)ws}; run_gemm(F, g, nullptr, nullptr, 0); }
            GSYNC();
            phase_krope(a, F);
            for (int j = 0; j < 3; ++j) {
                pg8::GD g;
                if (j == 0) g = pg8::GD{(const bf16_t*)(ws + WS_CQ), (const bf16_t*)(ws + WS_WUQ), (bf16_t*)(ws + WS_Q0), 256, 256, 768, MROWS / 256, 3, 0, 0, 0, 3, (const void*)(ws + WS_SSQQ), (const void*)ws, 0, (const void*)ws, (const void*)ws, (const void*)ws, 256};
                else if (j == 1) g = pg8::GD{(const bf16_t*)(ws + WS_CKV), (const bf16_t*)(ws + WS_WUKV), (bf16_t*)(ws + WS_KV0), 128, 128, 1024, MROWS / 256, 4, 0, 0, 0, 4, (const void*)(ws + WS_SSQKV), (const void*)ws, 0, (const void*)ws, (const void*)ws, (const void*)ws, 128};
                else g = pg8::GD{(const bf16_t*)(ws + WS_UX), (const bf16_t*)(ws + WS_BTA), (bf16_t*)(ws + WS_S), 768, 512, 256, 160, 1, 1, 256, 0, 0, (const void*)ws, (const void*)ws, 0, (const void*)ws, (const void*)ws, (const void*)ws, 0};
                run_gemm(F, g, nullptr, nullptr, 1 + j, (j == 0) ? 0 : (j == 1 ? 152 : 96));
            }
            GSYNC();
            phase_e2b(a, F);
            GSYNC();
            { pg8::GD g{(const bf16_t*)(ws + WS_UX), (const bf16_t*)(ws + WS_BTC), (bf16_t*)(ws + WS_G2), 768, 768, 512, 160, 2, 2, 512, 0, 6, nullptr, nullptr}; run_gemm(F, g, nullptr, nullptr, 4); }
#if PROBE_MLAFAKE
            phase_mla<PROBE_MLAFAKE>(a, F);
#endif
            for (int rep = 0; rep < PROBE_MLA; ++rep) phase_mla<0>(a, F);
            GSYNC();
            { pg8::GD g{(const bf16_t*)(ws + WS_G2), (const bf16_t*)(ws + WS_WGLU), (bf16_t*)(ws + WS_HB) + 512, 512, 512, 1024, MROWS / 256, 4, 0, 0, 0, 7, (const void*)(INP(a, 22) + i * 1024), (const void*)((const bf16_t*)(ws + WS_GATE) + 512), 0, nullptr, nullptr, nullptr, 1024}; run_gemm(F, g, nullptr, nullptr, 5); }
            GSYNC();
            { pg8::GD g{(const bf16_t*)(ws + WS_HB), (const bf16_t*)(ws + WS_WEVOUT), (bf16_t*)(ws + WS_Z) + 2048, 1024, 1024, 4096, MROWS / 256, 4, 0, 0, 0, 8, xol, xoc, 0, MODp, gnext, (void*)(ws + WS_SSQ), l}; run_gemm(F, g, OUTP(a), Xctx); }
            GSYNC();
        } else {
            for (int j = 0; j < 3; ++j) {
                pg8::GD g;
                if (j == 0) g = pg8::GD{(const bf16_t*)(ws + WS_Z) + 2048, (const bf16_t*)(ws + WS_WNAIN), (bf16_t*)(ws + WS_Z), 4096, 1024, 4096, MROWS / 256, 8, 0, 0, 0, 9, SSQp, SHWl, 0, (const void*)ws, (const void*)ws, (const void*)ws, 1024};
                else if (j == 1) g = pg8::GD{(const bf16_t*)(ws + WS_Z) + 2048, (const bf16_t*)(ws + WS_WNAIN) + (size_t)3072 * 1024, (bf16_t*)(ws + WS_Z) + 3072, 4096, 1024, 4096, MROWS / 256, 4, 0, 0, 0, 9, SSQp, SHWl + 3072, 0, (const void*)ws, (const void*)ws, (const void*)ws, 0};
                else g = pg8::GD{(const bf16_t*)(ws + WS_WNAIN) + (size_t)2048 * 1024, (const bf16_t*)(ws + WS_Z) + 2048, (bf16_t*)(ws + WS_VT), 1024, 1024, 1024, 4, MROWS / 256, 0, 0, 1, 10, SSQp, SHWl + 2048, 4096, (const void*)ws, (const void*)ws, (const void*)ws, 0};
                run_gemm(F, g, nullptr, nullptr, 7 + j, (j == 0) ? 0 : (j == 1 ? 64 : 96));
            }
            GSYNC();
            if (l == 1) for (int rep = 0; rep < PROBE_S5; ++rep) phase_s5_kt(a, F, 1);
#if PROBE_NAFAKE
            phase_na<PROBE_NAFAKE>(a, F, i, l < 3);
#endif
            for (int rep = 0; rep < PROBE_NA; ++rep) phase_na<0>(a, F, i, l < 3);
            GSYNC();
            if (l == 1) for (int rep = 0; rep < PROBE_S5; ++rep) phase_s5_tables(a, F, 1);
            { pg8::GD g{(const bf16_t*)(ws + WS_Z) + 2048, (const bf16_t*)(ws + WS_WNAOUT), (bf16_t*)(ws + WS_HB), 4096, 1024, 1024, (l < 3) ? MROWS / 256 : MLAT / 256, 4, 0, 0, 0, 8, xol, xoc, 0, MODp, gnext, (void*)(ws + WS_SSQ), l}; run_gemm(F, g, OUTP(a), Xctx); }
            GSYNC();
        }
    }
    phase_final(a, F);
}

extern "C" void kernel_launch(void* const* d_in, const int* in_sizes, int n_in, void* d_out, int out_size, void* d_ws, size_t ws_size, hipStream_t stream) {
    static int grid = 0;
    if (grid == 0) {
        if (n_in != 27 || ws_size < WS_END) { fprintf(stderr, "kernel_launch: unexpected n_in %d / ws_size %zu\n", n_in, ws_size); grid = -1; return; }
        int dev = 0, cus = 0, per_cu = 0;
        hipGetDevice(&dev);
        hipDeviceGetAttribute(&cus, hipDeviceAttributeMultiprocessorCount, dev);
        hipFuncSetAttribute((const void*)mega_fwd, hipFuncAttributeMaxDynamicSharedMemorySize, LDS_BYTES);
        hipOccupancyMaxActiveBlocksPerMultiprocessor(&per_cu, (const void*)mega_fwd, NTHR, LDS_BYTES);
        if (per_cu < 1) { fprintf(stderr, "kernel_launch: occupancy query says %d blocks per CU\n", per_cu); per_cu = 1; }
        grid = cus * 1;
        (void)hipGetLastError();
    }
    if (grid < 0) return;
    (void)hipMemsetAsync((char*)d_ws + WS_CTL, 0, 64 * 1024, stream);
    Args a{};
    for (int i = 0; i < 27; ++i) a.in[i] = (const float*)d_in[i];
    a.out = (float*)d_out; a.ws = (unsigned char*)d_ws;
    void* params[] = {&a};
    hipError_t e = hipLaunchCooperativeKernel((const void*)mega_fwd, dim3(grid), dim3(NTHR), params, LDS_BYTES, stream);
    if (e != hipSuccess) fprintf(stderr, "cooperative launch failed: %s (grid %d)\n", hipGetErrorString(e), grid);
}
```

```cpp
#include <hip/hip_runtime.h>
#include <hip/hip_cooperative_groups.h>
#include <cstdio>
#include <cstdint>
#include <cmath>
namespace cg = cooperative_groups;

#define LAS __attribute__((address_space(3)))
#define GASP __attribute__((address_space(1)))
template <class T> __device__ __forceinline__ T* gptr(const void* p) { return (T*)(GASP T*)(T*)p; }
typedef unsigned short bf16_t;
typedef short bf16x8 __attribute__((ext_vector_type(8)));
typedef float f32x4 __attribute__((ext_vector_type(4)));
typedef float f32x2 __attribute__((ext_vector_type(2)));
typedef unsigned u32x4 __attribute__((ext_vector_type(4)));
typedef unsigned u32x2 __attribute__((ext_vector_type(2)));

constexpr int DM = 1024, NB = 8, SEQ = 4096, CTXL = 256;
constexpr int MLAT = NB * SEQ, MCTX = NB * CTXL, MROWS = MLAT + MCTX;
constexpr int EVEN_IN = 1952, EVEN_INP = 2048;
constexpr int EV_S1 = 256, EV_S2 = 384, EV_S3 = 416, EV_S4 = 928, EV_S5 = 1440;
constexpr int NCH = 136, NCHP = 1280, NCHR = NB * NCH;
constexpr float EPS = 1e-6f;

constexpr size_t MiB = 1u << 20;
constexpr size_t WS_CTL = 0, WS_MOD = 1 * MiB, WS_BB = 2 * MiB + 256 * 1024, WS_POW = 3 * MiB, WS_KT = 5 * MiB, WS_BTA = 8 * MiB, WS_BTC = 16 * MiB;
constexpr size_t WS_WEVIN = 40 * MiB, WS_WUQ = 44 * MiB, WS_WUKV = 44 * MiB + 512 * 1024, WS_WGLU = 45 * MiB, WS_WEVOUT = 46 * MiB, WS_WNAIN = 48 * MiB, WS_WNAOUT = 56 * MiB;
constexpr size_t WS_XB = 66 * MiB, WS_Z = 134 * MiB;
constexpr size_t WS_GATE = 134 * MiB;
constexpr size_t WS_CQ = 202 * MiB, WS_CKV = 219 * MiB, WS_SSQQ = 228 * MiB, WS_SSQKV = 229 * MiB, WS_KR = 230 * MiB, WS_S = 233 * MiB;
constexpr size_t WS_UX = 289 * MiB, WS_Q0 = 350 * MiB, WS_KV0 = 402 * MiB;
constexpr size_t WS_G2 = 254 * MiB;
constexpr size_t WS_VT = 406 * MiB;
constexpr size_t WS_SSQ = 498 * MiB;
constexpr size_t WS_SHW = 501 * MiB;
constexpr size_t WS_END = 502 * MiB;

struct Args { const float* in[27]; float* out; unsigned char* ws; };
typedef const __attribute__((address_space(4))) Args* KArgs;
__device__ __forceinline__ KArgs klaunder(KArgs a) { asm volatile("" : "+s"(a)); return a; }
__device__ __forceinline__ unsigned char* WSP(KArgs a) { return (unsigned char*)(GASP unsigned char*)a->ws; }
__device__ __forceinline__ const float* INP(KArgs a, int k) { return (const float*)(GASP const float*)a->in[k]; }
__device__ __forceinline__ float* OUTP(KArgs a) { return (float*)(GASP float*)a->out; }
__device__ __forceinline__ unsigned char* HBP(KArgs a) { return (unsigned char*)(GASP unsigned char*)a->out; }

__device__ __forceinline__ float bf2f(bf16_t v) { return __uint_as_float(((unsigned)v) << 16); }
__device__ __forceinline__ unsigned f2bf(float f) { unsigned u = __float_as_uint(f); return (u + 0x7fffu + ((u >> 16) & 1u)) >> 16; }
__device__ __forceinline__ unsigned pk2(float lo, float hi) { return f2bf(lo) | (f2bf(hi) << 16); }
__device__ __forceinline__ float lo16(unsigned w) { return __uint_as_float(w << 16); }
__device__ __forceinline__ float hi16(unsigned w) { return __uint_as_float(w & 0xffff0000u); }
__device__ __forceinline__ float wave_sum(float v) {
#pragma unroll
    for (int o = 1; o < 64; o <<= 1) v += __shfl_xor(v, o);
    return v;
}
__device__ __forceinline__ float silu_f(float v) { return v / (1.f + expf(-v)); }
__device__ __forceinline__ float gelu_tanh_f(float v) { const float u = 0.7978845608028654f * (v + 0.044715f * v * v * v); return v * (1.f - __builtin_amdgcn_rcpf(1.f + __expf(2.f * u))); }

namespace pg8 {
constexpr int BM = 256, BK = 64, HALF = 128, HTB = HALF * BK * 2, STAGE_BYTES = 8 * HTB, NXCD = 8, WGM = 8;
__host__ __device__ __forceinline__ int lds_byte(int r, int c) { const int st = (r >> 4) * 2 + (c >> 5), rr = r & 15, cc = c & 31, ob = rr * 64 + cc * 2; return st * 1024 + (ob ^ (((ob >> 9) & 1) << 5)); }
__host__ __device__ __forceinline__ void stage_rc(int b, int& R, int& C) { const int st = b / 1024, sb = b % 1024, swz = sb ^ (((sb >> 9) & 1) << 5); R = (st >> 1) * 16 + swz / 64; C = (st & 1) * 32 + (swz % 64) / 2; }
__host__ __device__ __forceinline__ int perm32(int rho) { const int n = rho >> 4, i = rho & 15; return 8 * (i >> 2) + 4 * n + (i & 3); }

struct Unit { int pm, pn; };
struct GD { const bf16_t* A; const bf16_t* Bt; bf16_t* O; int lda, K, ldc, nM, nN, mode, split_cols, vtb, ek; const void* p1; const void* p2; int ldb; const void* p3; const void* p4; const void* p5; int i1; };

struct Sched {
    int nM, nN, nwg, G, c, mode;
    __device__ __forceinline__ void init(const GD& g, int G_, int c_) { nM = g.nM; nN = g.nN; mode = g.mode; nwg = (mode == 0) ? nM * nN : (mode == 1 ? 160 : 320); G = G_; c = c_; }
    __device__ __forceinline__ bool next(int i, Unit& u) const {
        const long L = (long)i * G + c; if (L >= nwg) return false;
        int wgid = (int)L;
        if (mode == 1) { u.pm = wgid; u.pn = wgid / 5; return true; }
        if (mode == 2) { const int g = wgid / 10, rem = wgid % 10; u.pm = g * 5 + (rem >> 1); u.pn = 2 * g + (rem & 1); return true; }
        { const int q = nwg / NXCD, r = nwg % NXCD, xcd = wgid % NXCD, off = wgid / NXCD; wgid = (xcd < r ? xcd * (q + 1) : r * (q + 1) + (xcd - r) * q) + off; }
        const int nig = WGM * nN, gid = wgid / nig, fm = gid * WGM, gsz = (nM - fm) < WGM ? (nM - fm) : WGM;
        u.pm = fm + ((wgid % nig) % gsz); u.pn = (wgid % nig) / gsz; return true;
    }
};

__device__ __forceinline__ unsigned cvt_pk_bf16(float lo, float hi) { unsigned r; asm volatile("v_cvt_pk_bf16_f32 %0, %1, %2" : "=v"(r) : "v"(lo), "v"(hi)); return r; }

struct EpiBf16 {
    static constexpr bool PERM = true;
    bf16_t* O_; int ldc; int split_cols; int vtb; int ek; const void* p1; const void* p2; const void* p3; const void* p4; const void* p5; int i1; void* xl_; void* xc_;
    __device__ __forceinline__ void operator()(const f32x4 (&acc)[2][2][4][2], const Unit& u, int wr, int wc, int fr, int fq) const {
        bf16_t* const O = gptr<bf16_t>(this->O_);
        if (ek == 99) {
            f32x4 s = {0.f, 0.f, 0.f, 0.f};
#pragma unroll
            for (int ai = 0; ai < 2; ++ai)
#pragma unroll
                for (int bj = 0; bj < 2; ++bj)
#pragma unroll
                    for (int m = 0; m < 4; ++m) s += acc[ai][bj][m][0] + acc[ai][bj][m][1];
            if (s[0] + s[1] + s[2] + s[3] == 12345.678f) ((float*)p5)[0] = s[0];
            return; }
        const int row0 = u.pm * BM + wr * 64 + fr; int colt = u.pn * BM;
        if (ek == 6) {
            const int g = u.pn >> 1, cl0 = (u.pn & 1) * BM + wc * 32 + 8 * fq;
#pragma unroll
            for (int ai = 0; ai < 2; ++ai)
#pragma unroll
                for (int m = 0; m < 4; ++m) { const int R = row0 + ai * HALF + m * 16 - g * NCHP;
                    if (R < NCHR) { const int b = R / NCH, cc = R - b * NCH; const int tok0 = (cc < 8) ? MLAT + b * 256 + cc * 32 : b * 4096 + (cc - 8) * 32;
#pragma unroll
                        for (int bj = 0; bj < 2; ++bj) { const int cl = cl0 + bj * HALF, t = cl >> 4, h0 = cl & 15; const f32x4 v0 = acc[ai][bj][m][0], v1 = acc[ai][bj][m][1];
                            u32x4 w; w.x = cvt_pk_bf16(gelu_tanh_f(v0[0]), gelu_tanh_f(v0[1])); w.y = cvt_pk_bf16(gelu_tanh_f(v0[2]), gelu_tanh_f(v0[3]));
                            w.z = cvt_pk_bf16(gelu_tanh_f(v1[0]), gelu_tanh_f(v1[1])); w.w = cvt_pk_bf16(gelu_tanh_f(v1[2]), gelu_tanh_f(v1[3]));
                            *(u32x4*)(O + (size_t)(tok0 + t) * 512 + 16 * g + h0) = w; } } }
            return;
        }
        if (ek == 7) {
            const float* bias = gptr<const float>(p1); const bf16_t* zg = gptr<const bf16_t>(p2);
            const int ch0 = u.pn * HALF + wc * 32 + 8 * fq;
            const f32x4 ba0 = *(const f32x4*)(bias + ch0), ba1 = *(const f32x4*)(bias + ch0 + 4), bg0 = *(const f32x4*)(bias + 512 + ch0), bg1 = *(const f32x4*)(bias + 512 + ch0 + 4);
            u32x4 wzv[2][4];
#pragma unroll
            for (int ai = 0; ai < 2; ++ai)
#pragma unroll
                for (int m = 0; m < 4; ++m) wzv[ai][m] = *(const u32x4*)(zg + (size_t)(row0 + ai * HALF + m * 16) * (size_t)i1 + ch0);
#pragma unroll
            for (int ai = 0; ai < 2; ++ai)
#pragma unroll
                for (int m = 0; m < 4; ++m) { const size_t row = (size_t)(row0 + ai * HALF + m * 16);
                    const u32x4 wz = wzv[ai][m];
                    const f32x4 a0 = acc[ai][0][m][0] + ba0, a1 = acc[ai][0][m][1] + ba1, g0 = acc[ai][1][m][0] + bg0, g1 = acc[ai][1][m][1] + bg1;
#define GLX(av, gv, zv) ((av) * __builtin_amdgcn_rcpf(1.f + __expf(-(gv))) * silu_f(zv))
                    u32x4 w; w.x = cvt_pk_bf16(GLX(a0[0], g0[0], lo16(wz.x)), GLX(a0[1], g0[1], hi16(wz.x))); w.y = cvt_pk_bf16(GLX(a0[2], g0[2], lo16(wz.y)), GLX(a0[3], g0[3], hi16(wz.y)));
                    w.z = cvt_pk_bf16(GLX(a1[0], g1[0], lo16(wz.z)), GLX(a1[1], g1[1], hi16(wz.z))); w.w = cvt_pk_bf16(GLX(a1[2], g1[2], lo16(wz.w)), GLX(a1[3], g1[3], hi16(wz.w)));
#undef GLX
                    *(u32x4*)(O + row * ldc + ch0) = w; }
            return;
        }
        if (ek == 1) {
            unsigned char* wsb = gptr<unsigned char>(p3);
            bf16_t* CQ = (bf16_t*)(wsb + WS_CQ); bf16_t* CKV = (bf16_t*)(wsb + WS_CKV); bf16_t* KRo = (bf16_t*)(wsb + WS_KR); bf16_t* GATE = (bf16_t*)(wsb + WS_GATE); bf16_t* UXo = (bf16_t*)(wsb + WS_UX);
            float* SSQQ = (float*)(wsb + WS_SSQQ); float* SSQKV = (float*)(wsb + WS_SSQKV);
            const int bi = (u.pm < 128) ? (u.pm >> 4) : 8;
            const float* ssq = gptr<const float>(p1);
            f32x4 sw[2][2];
#pragma unroll
            for (int bj = 0; bj < 2; ++bj) { const float* shw = gptr<const float>(p2) + (size_t)bi * 4096 + colt + bj * HALF + wc * 32 + 8 * fq; sw[bj][0] = *(const f32x4*)shw; sw[bj][1] = *(const f32x4*)(shw + 4); }
#pragma unroll
            for (int ai = 0; ai < 2; ++ai) {
                float rsv[4];
#pragma unroll
                for (int m = 0; m < 4; ++m) { const f32x4 s0 = *((const f32x4*)(ssq + (size_t)(row0 + ai * HALF + m * 16) * 16) + fq);
                    float tot = (s0[0] + s0[1]) + (s0[2] + s0[3]); tot += __shfl_xor(tot, 16); tot += __shfl_xor(tot, 32);
                    rsv[m] = 1.0f / sqrtf(tot * (1.f / 1024.f) + EPS); }
#pragma unroll
                for (int m = 0; m < 4; ++m) { const int row = row0 + ai * HALF + m * 16;
                    const float rs = rsv[m];
                    float ss = 0.f;
#pragma unroll
                    for (int bj = 0; bj < 2; ++bj) { const int cw = colt + bj * HALF + wc * 32, c0 = cw + 8 * fq;
                        const f32x4 v0 = acc[ai][bj][m][0] * rs + sw[bj][0], v1 = acc[ai][bj][m][1] * rs + sw[bj][1];
                        u32x4 w; w.x = cvt_pk_bf16(v0[0], v0[1]); w.y = cvt_pk_bf16(v0[2], v0[3]); w.z = cvt_pk_bf16(v1[0], v1[1]); w.w = cvt_pk_bf16(v1[2], v1[3]);
                        if (cw < EV_S1) { *(u32x4*)(CQ + (size_t)row * 256 + c0) = w; ss += (v0[0] * v0[0] + v0[1] * v0[1]) + (v0[2] * v0[2] + v0[3] * v0[3]) + (v1[0] * v1[0] + v1[1] * v1[1]) + (v1[2] * v1[2] + v1[3] * v1[3]); }
                        else if (cw < EV_S2) { *(u32x4*)(CKV + (size_t)row * 128 + (c0 - EV_S1)) = w; ss += (v0[0] * v0[0] + v0[1] * v0[1]) + (v0[2] * v0[2] + v0[3] * v0[3]) + (v1[0] * v1[0] + v1[1] * v1[1]) + (v1[2] * v1[2] + v1[3] * v1[3]); }
                        else if (cw < EV_S3) *(u32x4*)(KRo + (size_t)row * 32 + (c0 - EV_S2)) = w;
                        else if (cw < EV_S4) *(u32x4*)(GATE + (size_t)row * 1024 + (c0 - EV_S3)) = w;
                        else if (cw < EV_S5) { const int ch = c0 - EV_S4; int R, s;
                            if (row < MLAT) { const int b = row >> 12, t = row & 4095; R = b * NCH + 8 + (t >> 5); s = t & 31; } else { const int r = row - MLAT, b = r >> 8, t = r & 255; R = b * NCH + (t >> 5); s = t & 31; }
                            *(u32x4*)(UXo + ((size_t)((ch >> 4) * NCHP + R)) * 768 + s * 16 + (ch & 15)) = w; }
                        else if (cw < EVEN_IN) *(u32x4*)(GATE + (size_t)row * 1024 + 512 + (c0 - EV_S5)) = w;
                    }
                    if (u.pn <= 1) { ss += __shfl_xor(ss, 16); ss += __shfl_xor(ss, 32);
                        if (fq == 0) { if (u.pn == 0) SSQQ[(size_t)row * 4 + wc] = ss; else SSQKV[(size_t)row * 4 + wc] = ss; } }
                    asm volatile("" ::: "memory");
                }
            }
            return;
        }
        if (ek == 3 || ek == 4) {
            const float* ssp = gptr<const float>(p1); const float invw = 1.0f / (float)i1;
            const int c00 = colt + wc * 32 + 8 * fq;
            float rstdv[2][4];
#pragma unroll
            for (int ai = 0; ai < 2; ++ai)
#pragma unroll
                for (int m = 0; m < 4; ++m) { const f32x4 s4 = *(const f32x4*)(ssp + (size_t)(row0 + ai * HALF + m * 16) * 4);
                    rstdv[ai][m] = ((ek == 3) ? 0.14724444f : 1.0f) / sqrtf(((s4[0] + s4[1]) + (s4[2] + s4[3])) * invw + EPS); }
#pragma unroll
            for (int ai = 0; ai < 2; ++ai)
#pragma unroll
                for (int m = 0; m < 4; ++m) { const int row = row0 + ai * HALF + m * 16;
                    const float rstd = rstdv[ai][m];
                    const bool lat = row < MLAT; const int t = row & 4095;
#pragma unroll
                    for (int bj = 0; bj < 2; ++bj) { const int c0 = c00 + bj * HALF; f32x4 v0 = acc[ai][bj][m][0] * rstd, v1 = acc[ai][bj][m][1] * rstd;
                        if (ek == 3) { const int d0 = c0 % 96; const bool rope = lat && (d0 >= 64); const int r0 = d0 - 64;
                            float vv[8] = {v0[0], v0[1], v0[2], v0[3], v1[0], v1[1], v1[2], v1[3]}, pv[8];
#pragma unroll
                            for (int e = 0; e < 8; ++e) pv[e] = __shfl_xor(vv[e], 16);
                            if (rope) { const float pos = (float)((r0 >> 4) ? (t & 63) : (t >> 6)); const bool hf = (r0 >> 3) & 1;
#pragma unroll
                                for (int e = 0; e < 8; ++e) { const float ang = pos * exp2f(-(float)e * (13.287712379549449f / 8.f)); const float sn = __sinf(ang), cs = __cosf(ang);
                                    vv[e] = hf ? (vv[e] * cs + pv[e] * sn) : (vv[e] * cs - pv[e] * sn); }
                                v0 = (f32x4){vv[0], vv[1], vv[2], vv[3]}; v1 = (f32x4){vv[4], vv[5], vv[6], vv[7]}; } }
                        u32x4 w; w.x = cvt_pk_bf16(v0[0], v0[1]); w.y = cvt_pk_bf16(v0[2], v0[3]); w.z = cvt_pk_bf16(v1[0], v1[1]); w.w = cvt_pk_bf16(v1[2], v1[3]);
                        *(u32x4*)(O + (size_t)row * ldc + c0) = w; } }
            return;
        }
        if (ek == 8) {
            const int l = i1 & 7; bf16_t* XB = gptr<bf16_t>(xl_);
            const int bi = (u.pm < 128) ? (u.pm >> 4) : 8;
            const float* modl = gptr<const float>(p3) + (size_t)(l * 9 + bi) * 3072; const float* modn = gptr<const float>(p3) + (size_t)((l + 1) * 9 + bi) * 3072;
            const float* gam = p4 ? gptr<const float>(p4) : nullptr; float* ssq = gptr<float>(p5);
            const int c0 = u.pn * BM + wc * 32 + 8 * fq;
            f32x4 gt[2][2], gm[2][2];
#pragma unroll
            for (int bj = 0; bj < 2; ++bj)
#pragma unroll
                for (int n = 0; n < 2; ++n) { const int c = c0 + bj * HALF + 4 * n; gt[bj][n] = *(const f32x4*)(modl + 2048 + c);
                    if (gam) { const f32x4 g4 = *(const f32x4*)(gam + c), s4 = *(const f32x4*)(modn + 1024 + c); gm[bj][n] = g4 * (s4 + 1.0f); } else gm[bj][n] = (f32x4){0.f, 0.f, 0.f, 0.f}; }
#pragma unroll
            for (int ai = 0; ai < 2; ++ai)
#pragma unroll
              for (int mh = 0; mh < 2; ++mh) {
                u32x4 xpre[2][2];
#pragma unroll
                for (int mm = 0; mm < 2; ++mm)
#pragma unroll
                    for (int bj = 0; bj < 2; ++bj) xpre[mm][bj] = *(const u32x4*)(XB + (size_t)(row0 + ai * HALF + (2 * mh + mm) * 16) * 1024 + c0 + bj * HALF);
#pragma unroll
                for (int mm = 0; mm < 2; ++mm) { const int m = 2 * mh + mm; const int row = row0 + ai * HALF + m * 16;
                    float ss = 0.f;
#pragma unroll
                    for (int bj = 0; bj < 2; ++bj) { const u32x4 xv = xpre[mm][bj];
                        const f32x4 xn0 = (f32x4){lo16(xv.x), hi16(xv.x), lo16(xv.y), hi16(xv.y)} + gt[bj][0] * acc[ai][bj][m][0];
                        const f32x4 xn1 = (f32x4){lo16(xv.z), hi16(xv.z), lo16(xv.w), hi16(xv.w)} + gt[bj][1] * acc[ai][bj][m][1];
                        u32x4 xw; xw.x = cvt_pk_bf16(xn0[0], xn0[1]); xw.y = cvt_pk_bf16(xn0[2], xn0[3]); xw.z = cvt_pk_bf16(xn1[0], xn1[1]); xw.w = cvt_pk_bf16(xn1[2], xn1[3]);
                        *(u32x4*)(XB + (size_t)row * 1024 + c0 + bj * HALF) = xw;
                        ss += ((xn0[0] * xn0[0] + xn0[1] * xn0[1]) + (xn0[2] * xn0[2] + xn0[3] * xn0[3])) + ((xn1[0] * xn1[0] + xn1[1] * xn1[1]) + (xn1[2] * xn1[2] + xn1[3] * xn1[3]));
                        if (gam) { const f32x4 a0 = xn0 * gm[bj][0], a1 = xn1 * gm[bj][1];
                            u32x4 w; w.x = cvt_pk_bf16(a0[0], a0[1]); w.y = cvt_pk_bf16(a0[2], a0[3]); w.z = cvt_pk_bf16(a1[0], a1[1]); w.w = cvt_pk_bf16(a1[2], a1[3]);
                            *(u32x4*)(O + (size_t)row * ldc + c0 + bj * HALF) = w; } }
                    ss += __shfl_xor(ss, 16); ss += __shfl_xor(ss, 32);
                    if (fq == 0) ssq[(size_t)row * 16 + u.pn * 4 + wc] = ss; }
            }
            return;
        }
        if (split_cols) { const int t = colt / split_cols; colt -= t * split_cols; }
        const int col0 = colt + wc * 32 + 8 * fq;
        if (ek == 9) {
            const int bi = (u.pm < 128) ? (u.pm >> 4) : 8;
            const float* shw = (const float*)p2 + (size_t)bi * 4096 + col0; const float* ssq = gptr<const float>(p1);
            f32x4 sw[2][2];
#pragma unroll
            for (int bj = 0; bj < 2; ++bj) { sw[bj][0] = *(const f32x4*)(shw + bj * HALF); sw[bj][1] = *(const f32x4*)(shw + bj * HALF + 4); }
            float rsv[2][4];
#pragma unroll
            for (int ai = 0; ai < 2; ++ai)
#pragma unroll
                for (int m = 0; m < 4; ++m) { const f32x4 s0 = *((const f32x4*)(ssq + (size_t)(row0 + ai * HALF + m * 16) * 16) + fq);
                    float tot = (s0[0] + s0[1]) + (s0[2] + s0[3]); tot += __shfl_xor(tot, 16); tot += __shfl_xor(tot, 32);
                    rsv[ai][m] = 1.0f / sqrtf(tot * (1.f / 1024.f) + EPS); }
#pragma unroll
            for (int ai = 0; ai < 2; ++ai)
#pragma unroll
                for (int m = 0; m < 4; ++m) { const int row = row0 + ai * HALF + m * 16;
                    const float rs = rsv[ai][m];
                    bf16_t* rowp = O + (size_t)row * ldc + col0;
#pragma unroll
                    for (int bj = 0; bj < 2; ++bj) { f32x4 v0 = acc[ai][bj][m][0] * rs + sw[bj][0], v1 = acc[ai][bj][m][1] * rs + sw[bj][1];
                        if (colt < i1) { v0 *= 0.18033688f; v1 *= 0.18033688f; }
                        u32x4 w; w.x = cvt_pk_bf16(v0[0], v0[1]); w.y = cvt_pk_bf16(v0[2], v0[3]); w.z = cvt_pk_bf16(v1[0], v1[1]); w.w = cvt_pk_bf16(v1[2], v1[3]);
                        *(u32x4*)(rowp + bj * HALF) = w; } }
            return;
        }
        if (ek == 10) {
            const int bi = (u.pn < 128) ? (u.pn >> 4) : 8;
            const float* shw = (const float*)p2 + (size_t)bi * 4096; const float* ssq = gptr<const float>(p1);
            f32x4 rs4[2][2];
#pragma unroll
            for (int bj = 0; bj < 2; ++bj)
#pragma unroll
                for (int n = 0; n < 2; ++n)
#pragma unroll
                    for (int j = 0; j < 4; ++j) { const f32x4* sp = (const f32x4*)(ssq + (size_t)(col0 + bj * HALF + 4 * n + j) * 16); const f32x4 s0 = sp[0], s1 = sp[1], s2 = sp[2], s3 = sp[3];
                        const float tot = ((s0[0] + s0[1]) + (s0[2] + s0[3])) + ((s1[0] + s1[1]) + (s1[2] + s1[3])) + ((s2[0] + s2[1]) + (s2[2] + s2[3])) + ((s3[0] + s3[1]) + (s3[2] + s3[3]));
                        rs4[bj][n][j] = 1.0f / sqrtf(tot * (1.f / 1024.f) + EPS); }
            float shv[2][4];
#pragma unroll
            for (int ai = 0; ai < 2; ++ai)
#pragma unroll
                for (int m = 0; m < 4; ++m) shv[ai][m] = shw[row0 + ai * HALF + m * 16];
#pragma unroll
            for (int ai = 0; ai < 2; ++ai)
#pragma unroll
                for (int m = 0; m < 4; ++m) { const int row = row0 + ai * HALF + m * 16; const float sh = shv[ai][m];
#pragma unroll
                    for (int bj = 0; bj < 2; ++bj) { const f32x4 v0 = acc[ai][bj][m][0] * rs4[bj][0] + sh, v1 = acc[ai][bj][m][1] * rs4[bj][1] + sh;
                        u32x4 w; w.x = cvt_pk_bf16(v0[0], v0[1]); w.y = cvt_pk_bf16(v0[2], v0[3]); w.z = cvt_pk_bf16(v1[0], v1[1]); w.w = cvt_pk_bf16(v1[2], v1[3]);
                        *(u32x4*)(O + ((size_t)((col0 + bj * HALF) >> 3) * ldc + row) * 8) = w; } }
            return;
        }
#pragma unroll
        for (int ai = 0; ai < 2; ++ai)
#pragma unroll
            for (int m = 0; m < 4; ++m) { bf16_t* rowp = O + (size_t)(row0 + ai * HALF + m * 16) * ldc + col0;
#pragma unroll
                for (int bj = 0; bj < 2; ++bj) { const f32x4 v0 = acc[ai][bj][m][0], v1 = acc[ai][bj][m][1];
                    u32x4 w; w.x = cvt_pk_bf16(v0[0], v0[1]); w.y = cvt_pk_bf16(v0[2], v0[3]); w.z = cvt_pk_bf16(v1[0], v1[1]); w.w = cvt_pk_bf16(v1[2], v1[3]);
                    if (vtb) *(u32x4*)(O + ((size_t)((col0 + bj * HALF) >> 3) * ldc + (row0 + ai * HALF + m * 16)) * 8) = w;
                    else *(u32x4*)(rowp + bj * HALF) = w; } }
    }
};

template <class Epi>
__device__ __forceinline__ void gemm_phase(LAS unsigned char* lds, const GD g, const Sched& S, const Epi& E) {
    int tid_ = threadIdx.x; asm volatile("" : "+v"(tid_));
    const int tid = tid_, wid = __builtin_amdgcn_readfirstlane(tid >> 6), lane = tid & 63, wr = wid >> 2, wc = wid & 3, fr = lane & 15, fq = lane >> 4;
    const int K = g.K, nt = K / BK, lda = g.lda, ldb = g.ldb ? g.ldb : g.K;
    unsigned voffA[2], voffB[2];
#pragma unroll
    for (int i = 0; i < 2; ++i) { int R, C; stage_rc(tid * 16 + i * 8192, R, C); const int Rb = Epi::PERM ? ((R & ~31) + perm32(R & 31)) : R;
        voffA[i] = (unsigned)(R * lda + C) * 2u; voffB[i] = (unsigned)(Rb * ldb + C) * 2u; }
    const size_t kstep = (size_t)(BK * 2);
    const size_t hstepA = (size_t)HALF * lda * 2, hstepB = (size_t)HALF * ldb * 2;
    const size_t tstepA = 2 * hstepA, tstepB = 2 * hstepB;
    const unsigned ldsw = (unsigned)wid * 1024u;
    const int aoff = lds_byte(wr * 64 + fr, fq * 8), boff = lds_byte(wc * 32 + fr, fq * 8);
#define PG8_SA(b, h) (((b) * 2 + (h)) * HTB)
#define PG8_SB(b, h) ((4 + (b) * 2 + (h)) * HTB)
#define PG8_STAGE(bufoff, gbase, voff) do { _Pragma("unroll") for (int _i = 0; _i < 2; ++_i) \
        __builtin_amdgcn_global_load_lds((const unsigned*)((const char*)(gbase) + (voff)[_i]), (LAS unsigned*)(lds + (bufoff) + ldsw + _i * 8192), 16, 0, 0); } while (0)
#define PG8_LDA(dst, b, h) do { _Pragma("unroll") for (int m = 0; m < 4; ++m) _Pragma("unroll") for (int k = 0; k < 2; ++k) dst[m][k] = *(const LAS bf16x8*)(lds + PG8_SA(b, h) + aoff + m * 2048 + k * 1024); } while (0)
#define PG8_LDB(dst, b, h) do { _Pragma("unroll") for (int n = 0; n < 2; ++n) _Pragma("unroll") for (int k = 0; k < 2; ++k) dst[n][k] = *(const LAS bf16x8*)(lds + PG8_SB(b, h) + boff + n * 2048 + k * 1024); } while (0)
#define PG8_MMA(ai, bj, At, Bt) do { __builtin_amdgcn_s_setprio(1); _Pragma("unroll") for (int m = 0; m < 4; ++m) _Pragma("unroll") for (int n = 0; n < 2; ++n) _Pragma("unroll") for (int k = 0; k < 2; ++k) \
        acc[ai][bj][m][n] = __builtin_amdgcn_mfma_f32_16x16x32_bf16(Bt[n][k], At[m][k], acc[ai][bj][m][n], 0, 0, 0); __builtin_amdgcn_s_setprio(0); } while (0)
#define PG8_WAIT_V(n) asm volatile("s_waitcnt vmcnt(" #n ")" ::: "memory")
#define PG8_WAIT_L(n) asm volatile("s_waitcnt lgkmcnt(" #n ")" ::: "memory")
#define PG8_BAR __builtin_amdgcn_s_barrier()
#define PG8_SCHED __builtin_amdgcn_sched_barrier(0)
    Unit cur, nxt; int ui = 0;
    if (!S.next(0, cur)) return;
    f32x4 acc[2][2][4][2];
#pragma unroll
    for (int a = 0; a < 2; ++a)
#pragma unroll
        for (int b = 0; b < 2; ++b)
#pragma unroll
            for (int m = 0; m < 4; ++m)
#pragma unroll
                for (int n = 0; n < 2; ++n) acc[a][b][m][n] = (f32x4){0.f, 0.f, 0.f, 0.f};
    bf16x8 At[4][2], B0[2][2], B1[2][2];
    const char* cA = (const char*)g.A + (size_t)cur.pm * tstepA; const char* cB = (const char*)g.Bt + (size_t)cur.pn * tstepB;
    PG8_STAGE(PG8_SB(0, 0), cB, voffB); PG8_STAGE(PG8_SB(0, 1), cB + hstepB, voffB); PG8_STAGE(PG8_SA(0, 0), cA, voffA); PG8_STAGE(PG8_SA(0, 1), cA + hstepA, voffA);
    if (wr == 1) PG8_BAR;
    PG8_WAIT_V(2); PG8_BAR;
    PG8_STAGE(PG8_SB(1, 0), cB + kstep, voffB); PG8_STAGE(PG8_SA(1, 0), cA + kstep, voffA); PG8_STAGE(PG8_SB(1, 1), cB + hstepB + kstep, voffB);
    PG8_WAIT_V(6); PG8_BAR;
    for (;;) {
        const bool has_next = S.next(ui + 1, nxt);
        const char* nA = has_next ? (const char*)g.A + (size_t)nxt.pm * tstepA : cA; const char* nB = has_next ? (const char*)g.Bt + (size_t)nxt.pn * tstepB : cB;
        for (int t = 0; t < nt; t += 2) {
            const bool last = (t == nt - 2);
            const char* a1 = cA + (size_t)(t + 1) * kstep;
            const char* a2 = last ? nA : cA + (size_t)(t + 2) * kstep; const char* b2 = last ? nB : cB + (size_t)(t + 2) * kstep;
            const char* a3 = a2 + kstep; const char* b3 = b2 + kstep;
            PG8_LDB(B0, 0, 0); PG8_LDB(B1, 0, 1); PG8_SCHED; PG8_LDA(At, 0, 0); PG8_STAGE(PG8_SA(1, 1), a1 + hstepA, voffA);
            PG8_WAIT_V(8); PG8_WAIT_L(0); PG8_BAR; PG8_MMA(0, 0, At, B0); PG8_MMA(0, 1, At, B1); PG8_BAR; PG8_SCHED;
            PG8_LDA(At, 0, 1); PG8_STAGE(PG8_SB(0, 0), b2, voffB); PG8_STAGE(PG8_SB(0, 1), b2 + hstepB, voffB); PG8_STAGE(PG8_SA(0, 0), a2, voffA);
            PG8_WAIT_V(8); PG8_WAIT_L(0); PG8_BAR; PG8_MMA(1, 0, At, B0); PG8_MMA(1, 1, At, B1); PG8_BAR; PG8_SCHED;
            PG8_LDB(B0, 1, 0); PG8_LDB(B1, 1, 1); PG8_SCHED; PG8_LDA(At, 1, 0); PG8_STAGE(PG8_SA(0, 1), a2 + hstepA, voffA);
            PG8_WAIT_V(8); PG8_WAIT_L(0); PG8_BAR; PG8_MMA(0, 0, At, B0); PG8_MMA(0, 1, At, B1); PG8_BAR; PG8_SCHED;
            PG8_LDA(At, 1, 1); PG8_STAGE(PG8_SB(1, 0), b3, voffB); PG8_STAGE(PG8_SB(1, 1), b3 + hstepB, voffB); PG8_STAGE(PG8_SA(1, 0), a3, voffA);
            PG8_WAIT_V(8); PG8_WAIT_L(0); PG8_BAR; PG8_MMA(1, 0, At, B0); PG8_MMA(1, 1, At, B1); PG8_BAR; PG8_SCHED;
        }
        if (wr == 0) PG8_BAR;
        E(acc, cur, wr, wc, fr, fq);
        if (!has_next) break;
#pragma unroll
        for (int a = 0; a < 2; ++a)
#pragma unroll
            for (int b = 0; b < 2; ++b)
#pragma unroll
                for (int m = 0; m < 4; ++m)
#pragma unroll
                    for (int n = 0; n < 2; ++n) acc[a][b][m][n] = (f32x4){0.f, 0.f, 0.f, 0.f};
        cur = nxt; cA = nA; cB = nB; ++ui;
        if (wr == 1) PG8_BAR;
    }
    PG8_WAIT_V(0);
    PG8_BAR;
#undef PG8_SA
#undef PG8_SB
#undef PG8_STAGE
#undef PG8_LDA
#undef PG8_LDB
#undef PG8_MMA
#undef PG8_WAIT_V
#undef PG8_WAIT_L
#undef PG8_BAR
#undef PG8_SCHED
}
}

#define XB_TMO      128
#define XB_XCNT(j)  (256  + 64 * (j))
#define XB_XSUB(j)  (1280 + 64 * (j))
#define XB_XGEN(j)  (2304 + 64 * (j))
#define XB_TOP      3328
#define XB_TOPGEN   3392
#define XCD_BAR_WORDS 3456
#define XB_SPIN_CAP (1u << 22)
__device__ __forceinline__ unsigned xb_ld(unsigned* p)              { return __hip_atomic_load(p, __ATOMIC_RELAXED, __HIP_MEMORY_SCOPE_AGENT); }
__device__ __forceinline__ unsigned xb_add(unsigned* p, unsigned v) { return __hip_atomic_fetch_add(p, v, __ATOMIC_RELAXED, __HIP_MEMORY_SCOPE_AGENT); }
__device__ __forceinline__ unsigned xb_xcc_id() { return (unsigned)__builtin_amdgcn_s_getreg((3 << 11) | 20) & 0xFu; }
#define XB_SPIN(cond, bar) do { unsigned _sp = 0; while (cond) { __builtin_amdgcn_s_sleep(1); \
    if ((++_sp & 255u) == 0u) { if (xb_ld(&(bar)[XB_TMO])) break; if (_sp > XB_SPIN_CAP) { atomicAdd(&(bar)[XB_TMO], 1u); break; } } } } while (0)
struct XcdBarrier { unsigned* bar; unsigned x; volatile LAS unsigned* st; };
__device__ __forceinline__ XcdBarrier xcd_barrier_post(unsigned* bar, volatile LAS unsigned* st) {
    XcdBarrier b; b.bar = bar; b.x = xb_xcc_id(); b.st = st;
    if (threadIdx.x == 0) (void)xb_add(&bar[XB_XCNT(b.x)], 1u);
    return b;
}
__device__ __forceinline__ void xcd_barrier_complete(unsigned* bar, unsigned x, unsigned& nloc, unsigned& nx) {
    const unsigned G = gridDim.x * gridDim.y * gridDim.z;
    unsigned sum, cnt, mine, sp = 0u;
    for (;;) {
        sum = 0u; cnt = 0u; mine = 0u;
#pragma unroll
        for (unsigned j = 0; j < 16; ++j) { const unsigned c = xb_ld(&bar[XB_XCNT(j)]); sum += c; cnt += (c > 0u) ? 1u : 0u; mine = (j == x) ? c : mine; }
        if (sum == G) break;
        __builtin_amdgcn_s_sleep(1);
        if ((++sp & 255u) == 0u) { if (xb_ld(&bar[XB_TMO])) break; if (sp > XB_SPIN_CAP) { atomicAdd(&bar[XB_TMO], 1u); break; } }
    }
    nloc = mine > 0u ? mine : 1u; nx = cnt > 0u ? cnt : 1u;
}
__device__ __forceinline__ void xcd_barrier(const XcdBarrier& b) {
    asm volatile("s_waitcnt vmcnt(0)" ::: "memory");
    __syncthreads();
    if (threadIdx.x == 0) {
        unsigned* bar = b.bar;
        __builtin_amdgcn_s_waitcnt(0);
        unsigned nloc = b.st[0], nx = b.st[1];
        if (nloc == 0u) { xcd_barrier_complete(bar, b.x, nloc, nx); b.st[0] = nloc; b.st[1] = nx; }
        const unsigned old = xb_add(&bar[XB_XSUB(b.x)], 1u);
        const unsigned gen = old / nloc;
        if (old + 1u == (gen + 1u) * nloc) {
            __builtin_amdgcn_fence(__ATOMIC_RELEASE, "agent");
            asm volatile("s_waitcnt vmcnt(0)" ::: "memory");
            const unsigned og = xb_add(&bar[XB_TOP], 1u);
            const unsigned tg = og / nx;
            if (og + 1u == (tg + 1u) * nx) xb_add(&bar[XB_TOPGEN], 1u);
            else XB_SPIN(xb_ld(&bar[XB_TOPGEN]) == tg, bar);
            __builtin_amdgcn_fence(__ATOMIC_ACQUIRE, "agent");
            xb_add(&bar[XB_XGEN(b.x)], 1u);
            asm volatile("s_waitcnt vmcnt(0)" ::: "memory");
        } else {
            XB_SPIN(xb_ld(&bar[XB_XGEN(b.x)]) == gen, bar);
            __builtin_amdgcn_fence(__ATOMIC_ACQUIRE, "agent");
            asm volatile("s_waitcnt vmcnt(0)" ::: "memory");
        }
    }
    __syncthreads();
}

#ifndef PROBE_NOEPI
#define PROBE_NOEPI 0
#endif
#ifndef PROBE_SITES
#define PROBE_SITES 0
#endif
#ifndef PROBE_PRO
#define PROBE_PRO 1
#endif
#ifndef PROBE_WGT
#define PROBE_WGT 1
#endif
#ifndef PROBE_NAFAKE
#define PROBE_NAFAKE 0
#endif
#ifndef MLA_V2
#define MLA_V2 1
#endif
#ifndef PROBE_MLAFAKE
#define PROBE_MLAFAKE 0
#endif
#ifndef PROBE_MLA
#define PROBE_MLA 1
#endif
#ifndef PROBE_NA
#define PROBE_NA 1
#endif
#ifndef PROBE_EW
#define PROBE_EW 1
#endif
#ifndef PROBE_S5
#define PROBE_S5 1
#endif
#ifndef PROBE_CARRY
#define PROBE_CARRY 1
#endif
constexpr int NWAVES = 8, NTHR = 512;
constexpr int LDS_BYTES = 147456;
struct Fr {
    LAS unsigned char* lds; int tid, lane, wave, gw, NGW, gt, NGT;
};
__device__ __forceinline__ Fr launder(Fr F) { asm volatile("" : "+v"(F.tid), "+v"(F.lane), "+v"(F.gt)); asm volatile("" : "+s"(F.wave), "+s"(F.gw)); return F; }

__device__ __forceinline__ void transpose_item(const float* W, int K, int N, bf16_t* WT, LAS float* scr, int item, int lane, int perm = 0, const float* kscale = nullptr) {
    const int nblk = N / 32, kb = item / nblk, nb = item % nblk, k0 = 64 * kb, n0 = 32 * nb;
#pragma unroll 8
    for (int i = 0; i < 32; ++i) { const int kk = 2 * i + (lane >> 5); float wv = W[(size_t)(k0 + kk) * N + n0 + (lane & 31)]; if (kscale) wv *= kscale[k0 + kk]; scr[kk * 33 + (lane & 31)] = wv; }
    asm volatile("s_waitcnt lgkmcnt(0)" ::: "memory");
    const int c = lane & 7;
#pragma unroll
    for (int j = 0; j < 4; ++j) { const int n = (lane >> 3) + 8 * j; const LAS float* s = scr + (8 * c) * 33 + n;
        u32x4 o; o.x = pk2(s[0 * 33], s[1 * 33]); o.y = pk2(s[2 * 33], s[3 * 33]); o.z = pk2(s[4 * 33], s[5 * 33]); o.w = pk2(s[6 * 33], s[7 * 33]);
        int nr = n0 + n; if (perm == 1) { const int cp = nr & 511; nr = 256 * (cp >> 7) + ((nr >> 9) << 7) + (cp & 127); }
        *(u32x4*)(WT + (size_t)nr * K + k0 + 8 * c) = o; }
    asm volatile("s_waitcnt lgkmcnt(0)" ::: "memory");
}

__device__ __forceinline__ void phase_mod(KArgs a0, const Fr& F0) {
    const Fr F = launder(F0); const KArgs a = klaunder(a0);
    LAS float* sc = (LAS float*)F.lds;
    LAS float* red = sc + 9 * 1024;
    float* MOD = (float*)(WSP(a) + WS_MOD);
    const float* c = INP(a, 1); const float* cc = INP(a, 3); const float* ada_w = INP(a, 4); const float* ada_b = INP(a, 5);
    if ((int)blockIdx.x < 192) {
        for (int i = F.tid; i < 9 * 1024; i += NTHR) { const int r = i >> 10, k = i & 1023; const float v = (r < 8) ? c[r * 1024 + k] : cc[k]; sc[i] = silu_f(v); }
    }
    __syncthreads();
    for (int item = blockIdx.x; item < 192; item += gridDim.x) {
        const int l = item / 48, cch = item % 48, col = cch * 64 + F.lane;
        const float* W = ada_w + (size_t)l * 1024 * 3072 + col;
        float acc[9];
#pragma unroll
        for (int r = 0; r < 9; ++r) acc[r] = 0.f;
        const int k0 = F.wave * 128;
#pragma unroll 16
        for (int k = k0; k < k0 + 128; ++k) { const float w = W[(size_t)k * 3072];
#pragma unroll
            for (int r = 0; r < 9; ++r) acc[r] += sc[r * 1024 + k] * w; }
#pragma unroll
        for (int r = 0; r < 9; ++r) red[(F.wave * 9 + r) * 64 + F.lane] = acc[r];
        __syncthreads();
        for (int i = F.tid; i < 576; i += NTHR) { const int r = i >> 6, ln = i & 63; float s = 0.f;
#pragma unroll
            for (int w = 0; w < 8; ++w) s += red[(w * 9 + r) * 64 + ln];
            MOD[(size_t)(l * 9 + r) * 3072 + cch * 64 + ln] = s + ada_b[l * 3072 + cch * 64 + ln]; }
        __syncthreads();
    }
}

__device__ __forceinline__ void phase_weights(KArgs a0, const Fr& F0, int l) {
    const Fr F = launder(F0); const KArgs a = klaunder(a0);
    LAS float* scr = (LAS float*)(F.lds + F.wave * 16384);
    const int i = l >> 1;
    if ((l & 1) == 0) {
        const float* w_in = INP(a, 8) + (size_t)i * 1024 * EVEN_IN; const float* w_uq = INP(a, 11) + (size_t)i * 256 * 768; const float* w_ukv = INP(a, 12) + (size_t)i * 128 * 1024;
        const float* w_glu = INP(a, 21) + (size_t)i * 512 * 1024; const float* w_out = INP(a, 23) + (size_t)i * 1024 * 1024;
        constexpr int I0 = 16 * 61, I1 = 4 * 24, I2 = 2 * 32, I3 = 8 * 32, I4 = 16 * 32, NI = I0 + I1 + I2 + I3 + I4;
        for (int it = F.gw; it < NI; it += F.NGW) {
            int r = it;
            if (r < I0) { transpose_item(w_in, 1024, EVEN_IN, (bf16_t*)(WSP(a) + WS_WEVIN), scr, r, F.lane); continue; } r -= I0;
            if (r < I1) { transpose_item(w_uq, 256, 768, (bf16_t*)(WSP(a) + WS_WUQ), scr, r, F.lane, 0, INP(a, 9) + i * 256); continue; } r -= I1;
            if (r < I2) { transpose_item(w_ukv, 128, 1024, (bf16_t*)(WSP(a) + WS_WUKV), scr, r, F.lane, 0, INP(a, 10) + i * 128); continue; } r -= I2;
            if (r < I3) { transpose_item(w_glu, 512, 1024, (bf16_t*)(WSP(a) + WS_WGLU), scr, r, F.lane, 1); continue; } r -= I3;
            transpose_item(w_out, 1024, 1024, (bf16_t*)(WSP(a) + WS_WEVOUT), scr, r, F.lane);
        }
        u32x4* pad = (u32x4*)((bf16_t*)(WSP(a) + WS_WEVIN) + (size_t)EVEN_IN * 1024);
        for (int t = F.gt; t < (EVEN_INP - EVEN_IN) * 1024 / 8; t += F.NGT) pad[t] = (u32x4){0u, 0u, 0u, 0u};
    } else {
        const float* w_in = INP(a, 24) + (size_t)i * 1024 * 4096; const float* w_out = INP(a, 26) + (size_t)i * 1024 * 1024;
        constexpr int I0 = 16 * 128, I1 = 16 * 32, NI = I0 + I1;
        for (int it = F.gw; it < NI; it += F.NGW) {
            int r = it;
            if (r < I0) { transpose_item(w_in, 1024, 4096, (bf16_t*)(WSP(a) + WS_WNAIN), scr, r, F.lane); continue; } r -= I0;
            transpose_item(w_out, 1024, 1024, (bf16_t*)(WSP(a) + WS_WNAOUT), scr, r, F.lane);
        }
    }
}

__device__ __forceinline__ void phase_s5_setup(KArgs a0, const Fr& F0, int i) {
    const Fr F = launder(F0); const KArgs a = klaunder(a0);
    f32x2* BB = (f32x2*)(WSP(a) + WS_BB); f32x2* POW = (f32x2*)(WSP(a) + WS_POW);
    const float* lam_re = INP(a, 13) + (size_t)i * 4096; const float* lam_im = INP(a, 14) + (size_t)i * 4096; const float* log_dt = INP(a, 15) + i * 64;
    const float* b_re = INP(a, 16) + (size_t)i * 65536; const float* b_im = INP(a, 17) + (size_t)i * 65536;
    for (int t = F.gt; t < 4096; t += F.NGT) {
        const int dg = t >> 6;
        const float dt = expf(log_dt[dg]);
        const float lr = fminf(lam_re[t], -1e-4f), li = lam_im[t];
        const float aa = lr * dt, th = li * dt;
        float sn, cs; sincosf(th, &sn, &cs);
        const float mag = expf(aa);
        const float lbr = mag * cs, lbi = mag * sn;
        const float sh = sinf(0.5f * th);
        const float nr = expm1f(aa) * cs - 2.f * sh * sh;
        const float den = lr * lr + li * li;
        const float kre = (nr * lr + lbi * li) / den, kim = (lbi * lr - nr * li) / den;
#pragma unroll
        for (int h = 0; h < 16; ++h) { const float br = b_re[(size_t)t * 16 + h], bi = b_im[(size_t)t * 16 + h];
            BB[(size_t)t * 16 + h] = (f32x2){kre * br - kim * bi, kre * bi + kim * br}; }
    }
    for (int t = F.gt; t < 4096 * 33; t += F.NGT) {
        const int p = t & 63, tau = (t >> 6) % 33, dg = t / (64 * 33); const int tp = dg * 64 + p;
        const float dt = expf(log_dt[dg]); const float lr = fminf(lam_re[tp], -1e-4f), li = lam_im[tp];
        const float aa = lr * dt, th = li * dt;
        float s2, c2; sincosf(th * (float)tau, &s2, &c2); const float m2 = expf(aa * (float)tau);
        POW[((size_t)dg * 33 + tau) * 64 + p] = (f32x2){m2 * c2, m2 * s2};
    }
}
__device__ __forceinline__ void phase_s5_kt(KArgs a0, const Fr& F0, int i) {
    const Fr F = launder(F0); const KArgs a = klaunder(a0);
    const f32x2* BB = (const f32x2*)(WSP(a) + WS_BB); const f32x2* POW = (const f32x2*)(WSP(a) + WS_POW); float* KT = (float*)(WSP(a) + WS_KT);
    const float* c_re = INP(a, 18) + (size_t)i * 65536; const float* c_im = INP(a, 19) + (size_t)i * 65536;
    for (int t = F.gt; t < 32 * 2 * 8 * 256; t += F.NGT) {
        const int hp = t & 15, h = (t >> 4) & 15, tau = (t >> 8) & 7, di = (t >> 11) & 1, g = t >> 12;
        const int dg = di * 32 + g;
        const float* cr = c_re + ((size_t)dg * 16 + h) * 64; const float* ci = c_im + ((size_t)dg * 16 + h) * 64;
        const f32x2* pw = POW + ((size_t)dg * 33 + tau) * 64; const f32x2* bb = BB + (size_t)dg * 64 * 16 + hp;
        float s0 = 0.f, s1 = 0.f, s2 = 0.f, s3 = 0.f;
#pragma unroll 8
        for (int p = 0; p < 64; ++p) { const f32x2 b = bb[p * 16]; const float c_r = cr[p], c_i = ci[p];
            const float ur = c_r * b.x - c_i * b.y, ui = c_r * b.y + c_i * b.x;
            const f32x2 w0 = pw[p], w1 = pw[8 * 64 + p], w2 = pw[16 * 64 + p], w3 = pw[24 * 64 + p];
            s0 += ur * w0.x - ui * w0.y; s1 += ur * w1.x - ui * w1.y; s2 += ur * w2.x - ui * w2.y; s3 += ur * w3.x - ui * w3.y; }
        float* kt = KT + ((((size_t)(g * 2 + di) * 32 + tau) * 16 + h) * 16 + hp);
        kt[0] = s0; kt[8 * 256] = s1; kt[16 * 256] = s2; kt[24 * 256] = s3;
    }
}
__device__ __forceinline__ void phase_s5_tables(KArgs a0, const Fr& F0, int i) {
    const Fr F = launder(F0); const KArgs a = klaunder(a0);
    const f32x2* BB = (const f32x2*)(WSP(a) + WS_BB); const f32x2* POW = (const f32x2*)(WSP(a) + WS_POW); const float* KT = (const float*)(WSP(a) + WS_KT);
    const float* c_re = INP(a, 18) + (size_t)i * 65536; const float* c_im = INP(a, 19) + (size_t)i * 65536; const float* dsk = INP(a, 20) + i * 512;
    bf16_t* BTA = (bf16_t*)(WSP(a) + WS_BTA); bf16_t* BTC = (bf16_t*)(WSP(a) + WS_BTC);
    for (int t = F.gt; t < 32 * 256 * 64; t += F.NGT) {
        const int c8 = t & 63, row = (t >> 6) & 255, g = t >> 14;
        const int di = row >> 7, ri = (row >> 6) & 1, p = row & 63, s = c8 >> 1, h0 = (c8 & 1) * 8;
        const int dg = di * 32 + g, tau = di ? s : 31 - s;
        const f32x2 w = POW[((size_t)dg * 33 + tau) * 64 + p]; const f32x4* bb4 = (const f32x4*)(BB + ((size_t)dg * 64 + p) * 16 + h0);
        const f32x4 q0 = bb4[0], q1 = bb4[1], q2 = bb4[2], q3 = bb4[3];
        const float bx[8] = {q0[0], q0[2], q1[0], q1[2], q2[0], q2[2], q3[0], q3[2]}, by[8] = {q0[1], q0[3], q1[1], q1[3], q2[1], q2[3], q3[1], q3[3]};
        float v[8];
#pragma unroll
        for (int j = 0; j < 8; ++j) v[j] = ri ? (w.x * by[j] + w.y * bx[j]) : (w.x * bx[j] - w.y * by[j]);
        *(u32x4*)(BTA + ((size_t)(g * 256 + row)) * 512 + c8 * 8) = (u32x4){pk2(v[0], v[1]), pk2(v[2], v[3]), pk2(v[4], v[5]), pk2(v[6], v[7])};
    }
    for (int t = F.gt; t < 32 * 512 * 96; t += F.NGT) {
        const int c8 = t % 96, row = (t / 96) & 511, g = t / (96 * 512);
        const int tt = row >> 4, h = row & 15;
        float v[8];
        if (c8 < 64) {
            const int s = c8 >> 1, h0 = (c8 & 1) * 8;
            const int tau = (tt > s) ? tt - s : s - tt; const int dsel = (tt >= s) ? 0 : 1;
            const f32x4* k0 = (const f32x4*)(KT + ((((size_t)(g * 2 + dsel) * 32 + tau) * 16 + h) * 16 + h0));
            const f32x4 a0 = k0[0], a1 = k0[1];
            v[0] = a0[0]; v[1] = a0[1]; v[2] = a0[2]; v[3] = a0[3]; v[4] = a1[0]; v[5] = a1[1]; v[6] = a1[2]; v[7] = a1[3];
            if (tt == s) {
                const f32x4* k1 = (const f32x4*)(KT + ((((size_t)(g * 2 + 1) * 32) * 16 + h) * 16 + h0)); const f32x4 b0 = k1[0], b1 = k1[1];
                v[0] += b0[0]; v[1] += b0[1]; v[2] += b0[2]; v[3] += b0[3]; v[4] += b1[0]; v[5] += b1[1]; v[6] += b1[2]; v[7] += b1[3];
                const float dk = dsk[g * 16 + h];
#pragma unroll
                for (int j = 0; j < 8; ++j) if (h0 + j == h) v[j] += dk; }
        } else {
            const int cc = (c8 - 64) * 8, di = cc >> 7, ri = (cc >> 6) & 1, p0 = cc & 63;
            const int dg = di * 32 + g, tau = di ? 32 - tt : tt + 1;
            const f32x4* pw4 = (const f32x4*)(POW + ((size_t)dg * 33 + tau) * 64 + p0);
            const f32x4* cr4 = (const f32x4*)(c_re + ((size_t)dg * 16 + h) * 64 + p0); const f32x4* ci4 = (const f32x4*)(c_im + ((size_t)dg * 16 + h) * 64 + p0);
            const f32x4 w0 = pw4[0], w1 = pw4[1], w2 = pw4[2], w3 = pw4[3], r0 = cr4[0], r1 = cr4[1], i0 = ci4[0], i1 = ci4[1];
            const float wx[8] = {w0[0], w0[2], w1[0], w1[2], w2[0], w2[2], w3[0], w3[2]}, wy[8] = {w0[1], w0[3], w1[1], w1[3], w2[1], w2[3], w3[1], w3[3]};
            const float crv[8] = {r0[0], r0[1], r0[2], r0[3], r1[0], r1[1], r1[2], r1[3]}, civ[8] = {i0[0], i0[1], i0[2], i0[3], i1[0], i1[1], i1[2], i1[3]};
#pragma unroll
            for (int j = 0; j < 8; ++j) v[j] = ri ? -(crv[j] * wy[j] + civ[j] * wx[j]) : (crv[j] * wx[j] - civ[j] * wy[j]);
        }
        *(u32x4*)(BTC + ((size_t)(g * 512 + row)) * 768 + c8 * 8) = (u32x4){pk2(v[0], v[1]), pk2(v[2], v[3]), pk2(v[4], v[5]), pk2(v[6], v[7])};
    }
}

__device__ __forceinline__ void phase_rn0(KArgs a0, const Fr& F0) {
    const Fr F = launder(F0); const KArgs a = klaunder(a0);
    const float* MOD = (const float*)(WSP(a) + WS_MOD); bf16_t* H = (bf16_t*)HBP(a); float* SSQ = (float*)(WSP(a) + WS_SSQ);
    const float* gam = INP(a, 6);
    for (int row = F.gw; row < MROWS; row += F.NGW) {
        const bool lat = row < MLAT; const int bi = lat ? (row >> 12) : 8;
        const float* xo = lat ? INP(a, 0) + (size_t)row * 1024 : INP(a, 2) + (size_t)(row - MLAT) * 1024;
        const float* md = MOD + (size_t)bi * 3072;
        f32x4 v[4]; float ss = 0.f;
#pragma unroll
        for (int j = 0; j < 4; ++j) { v[j] = ((const f32x4*)xo)[F.lane + 64 * j]; ss += (v[j].x * v[j].x + v[j].y * v[j].y) + (v[j].z * v[j].z + v[j].w * v[j].w); }
        ss = wave_sum(ss);
        u32x2* hrow = (u32x2*)(H + (size_t)row * 1024); u32x2* xbrow = (u32x2*)((bf16_t*)(WSP(a) + WS_XB) + (size_t)row * 1024);
#pragma unroll
        for (int j = 0; j < 4; ++j) xbrow[F.lane + 64 * j] = (u32x2){pk2(v[j].x, v[j].y), pk2(v[j].z, v[j].w)};
#pragma unroll
        for (int j = 0; j < 4; ++j) { const f32x4 g4 = ((const f32x4*)gam)[F.lane + 64 * j], s4 = ((const f32x4*)(md + 1024))[F.lane + 64 * j];
            hrow[F.lane + 64 * j] = (u32x2){pk2(v[j].x * g4.x * (1.f + s4.x), v[j].y * g4.y * (1.f + s4.y)), pk2(v[j].z * g4.z * (1.f + s4.z), v[j].w * g4.w * (1.f + s4.w))}; }
        if (F.lane < 16) SSQ[(size_t)row * 16 + F.lane] = (F.lane == 0) ? ss : 0.f;
    }
}
__device__ __forceinline__ void phase_shw(KArgs a0, const Fr& F0) {
    const Fr F = launder(F0); const KArgs a = klaunder(a0);
    LAS float* sc = (LAS float*)F.lds; LAS float* red = sc + 9 * 1024;
    const float* MOD = (const float*)(WSP(a) + WS_MOD); float* SHW = (float*)(WSP(a) + WS_SHW);
    for (int item = blockIdx.x; item < 190; item += gridDim.x) {
        int l, cch; if (item < 31) { l = 0; cch = item; } else if (item < 95) { l = 1; cch = item - 31; } else if (item < 126) { l = 2; cch = item - 95; } else { l = 3; cch = item - 126; }
        const int N = (l & 1) ? 4096 : EVEN_IN; const float* W = (l & 1) ? INP(a, 24) + (size_t)(l >> 1) * 1024 * 4096 : INP(a, 8) + (size_t)(l >> 1) * 1024 * EVEN_IN;
        __syncthreads();
        for (int t = F.tid; t < 9 * 1024; t += NTHR) sc[t] = MOD[(size_t)(l * 9 + (t >> 10)) * 3072 + (t & 1023)];
        __syncthreads();
        const int col = cch * 64 + F.lane; const bool ok = col < N; const float* Wc = W + (ok ? col : 0);
        float acc[9];
#pragma unroll
        for (int r = 0; r < 9; ++r) acc[r] = 0.f;
        const int k0 = F.wave * 128;
#pragma unroll 16
        for (int k = k0; k < k0 + 128; ++k) { const float w = Wc[(size_t)k * N];
#pragma unroll
            for (int r = 0; r < 9; ++r) acc[r] += sc[r * 1024 + k] * w; }
#pragma unroll
        for (int r = 0; r < 9; ++r) red[(F.wave * 9 + r) * 64 + F.lane] = acc[r];
        __syncthreads();
        for (int t = F.tid; t < 576; t += NTHR) { const int r = t >> 6, ln = t & 63; float s = 0.f;
#pragma unroll
            for (int w = 0; w < 8; ++w) s += red[(w * 9 + r) * 64 + ln];
            if (cch * 64 + ln < N) SHW[(size_t)(l * 9 + r) * 4096 + cch * 64 + ln] = s; }
    }
    __syncthreads();
}
__device__ __forceinline__ void phase_final(KArgs a0, const Fr& F0) {
    const Fr F = launder(F0); const KArgs a = klaunder(a0);
    const float* gam = INP(a, 7); const bf16_t* XB = (const bf16_t*)(WSP(a) + WS_XB);
    for (int rp = F.gw; rp < MLAT / 2; rp += F.NGW) {
        const bf16_t* xr0 = XB + (size_t)(2 * rp) * 1024; const bf16_t* xr1 = xr0 + 1024; float* o0 = OUTP(a) + (size_t)(2 * rp) * 1024; float* o1 = o0 + 1024;
        u32x4 v[2], w[2]; float s0 = 0.f, s1 = 0.f;
#pragma unroll
        for (int j = 0; j < 2; ++j) { v[j] = ((const u32x4*)xr0)[F.lane + 64 * j]; w[j] = ((const u32x4*)xr1)[F.lane + 64 * j]; }
        f32x4 fv[2][2], fw[2][2];
#pragma unroll
        for (int j = 0; j < 2; ++j) { fv[j][0] = (f32x4){lo16(v[j].x), hi16(v[j].x), lo16(v[j].y), hi16(v[j].y)}; fv[j][1] = (f32x4){lo16(v[j].z), hi16(v[j].z), lo16(v[j].w), hi16(v[j].w)};
            fw[j][0] = (f32x4){lo16(w[j].x), hi16(w[j].x), lo16(w[j].y), hi16(w[j].y)}; fw[j][1] = (f32x4){lo16(w[j].z), hi16(w[j].z), lo16(w[j].w), hi16(w[j].w)}; }
#pragma unroll
        for (int j = 0; j < 2; ++j)
#pragma unroll
            for (int h = 0; h < 2; ++h) { s0 += (fv[j][h].x * fv[j][h].x + fv[j][h].y * fv[j][h].y) + (fv[j][h].z * fv[j][h].z + fv[j][h].w * fv[j][h].w);
                s1 += (fw[j][h].x * fw[j][h].x + fw[j][h].y * fw[j][h].y) + (fw[j][h].z * fw[j][h].z + fw[j][h].w * fw[j][h].w); }
        const float r0 = 1.0f / sqrtf(wave_sum(s0) * (1.f / 1024.f) + EPS), r1 = 1.0f / sqrtf(wave_sum(s1) * (1.f / 1024.f) + EPS);
#pragma unroll
        for (int j = 0; j < 2; ++j)
#pragma unroll
            for (int h = 0; h < 2; ++h) { const int q = 2 * (F.lane + 64 * j) + h; const f32x4 g4 = ((const f32x4*)gam)[q];
                ((f32x4*)o0)[q] = (f32x4){fv[j][h].x * r0 * g4.x, fv[j][h].y * r0 * g4.y, fv[j][h].z * r0 * g4.z, fv[j][h].w * r0 * g4.w};
                ((f32x4*)o1)[q] = (f32x4){fw[j][h].x * r1 * g4.x, fw[j][h].y * r1 * g4.y, fw[j][h].z * r1 * g4.z, fw[j][h].w * r1 * g4.w}; }
    }
}

__device__ __forceinline__ void chunk_of_row(int row, int& R, int& s) {
    if (row < MLAT) { const int b = row >> 12, t = row & 4095; R = b * NCH + 8 + (t >> 5); s = t & 31; }
    else { const int r = row - MLAT, b = r >> 8, t = r & 255; R = b * NCH + (t >> 5); s = t & 31; }
}

__device__ __forceinline__ void phase_e2b(KArgs a0, const Fr& F0) {
    const Fr F = launder(F0); const KArgs a = klaunder(a0);
    const bf16_t* S = (const bf16_t*)(WSP(a) + WS_S); bf16_t* UX = (bf16_t*)(WSP(a) + WS_UX); const f32x2* POW = (const f32x2*)(WSP(a) + WS_POW);
    LAS bf16_t* T = (LAS bf16_t*)F.lds;
    for (int rep = 0; rep < PROBE_CARRY; ++rep)
    for (int it = blockIdx.x; it < NB * 32; it += gridDim.x) {
        const int b = it >> 5, g = it & 31;
        const size_t row0 = (size_t)g * NCHP + b * NCH;
        __syncthreads();
        { const u32x4* src4 = (const u32x4*)(S + row0 * 256); LAS u32x4* t4 = (LAS u32x4*)T;
          for (int t = F.tid; t < NCH * 32; t += NTHR) t4[t] = src4[t]; }
        __syncthreads();
        if (F.tid < 128) {
            const int di = F.tid >> 6, p = F.tid & 63;
            const f32x2 lt = POW[((size_t)(di * 32 + g) * 33 + 32) * 64 + p];
            float xr = 0.f, xi = 0.f;
#pragma unroll 8
            for (int k = 0; k < NCH; ++k) { const int cc = (di == 0) ? k : ((k < 8) ? 7 - k : 143 - k);
                LAS bf16_t* e = T + cc * 256 + di * 128 + p;
                const float sr = bf2f(e[0]), si = bf2f(e[64]);
                e[0] = (bf16_t)f2bf(xr); e[64] = (bf16_t)f2bf(xi);
                const float nr = lt.x * xr - lt.y * xi + sr, ni = lt.x * xi + lt.y * xr + si; xr = nr; xi = ni; }
        }
        __syncthreads();
        { const LAS u32x4* t4 = (const LAS u32x4*)T;
          for (int t = F.tid; t < NCH * 32; t += NTHR) { const int cc = t >> 5, c16 = t & 31; *(u32x4*)(UX + (row0 + cc) * 768 + 512 + c16 * 8) = t4[t]; } }
    }
    __syncthreads();
}

__device__ __forceinline__ void phase_krope(KArgs a0, const Fr& F0) {
    const Fr F = launder(F0); const KArgs a = klaunder(a0);
    bf16_t* KR = (bf16_t*)(WSP(a) + WS_KR);
    for (int t = F.gt; t < MLAT * 16; t += F.NGT) {
        const int row = t >> 4, axis = (t >> 3) & 1, ii = t & 7; const int tk = row & 4095;
        bf16_t* p0 = KR + (size_t)row * 32 + axis * 16 + ii;
        const float x0 = bf2f(p0[0]), x1 = bf2f(p0[8]);
        const float pos = (float)(axis ? (tk & 63) : (tk >> 6)); const float ang = pos * exp2f(-(float)ii * (13.287712379549449f / 8.f));
        float sn, cs; sincosf(ang, &sn, &cs);
        p0[0] = (bf16_t)f2bf(x0 * cs - x1 * sn); p0[8] = (bf16_t)f2bf(x1 * cs + x0 * sn);
    }
}

namespace mla {
using s16x4 = __attribute__((ext_vector_type(4))) short;
using f32x16 = __attribute__((ext_vector_type(16))) float;
constexpr int QBLK = 32, KVBLK = 64;
constexpr float SCALE = 0.10206207261596577f, THR = 8.f;
constexpr int SHM_V = 16384, SHM_K = 16384;
#define KSWZ(row, colB) ((row) * 256 + ((colB) ^ (((row) & 15) << 4)))
#define SBAR() __builtin_amdgcn_sched_barrier(0)
__device__ __forceinline__ int crow(int r, int hi) { return (r & 3) + 8 * (r >> 2) + 4 * hi; }
__device__ __forceinline__ unsigned cvtpk(float lo, float hi) { unsigned r; asm volatile("v_cvt_pk_bf16_f32 %0, %1, %2" : "=v"(r) : "v"(lo), "v"(hi)); return r; }
template <bool FIRST> __device__ __forceinline__ void partialSM(f32x16& p0, f32x16& p1, float& m_reg, float& alpha) {
  constexpr float THR2 = THR * 1.4426950408889634f;
  float pmax = p0[0];
#pragma unroll
  for (int r = 1; r < 16; ++r) pmax = fmaxf(pmax, p0[r]);
#pragma unroll
  for (int r = 0; r < 16; ++r) pmax = fmaxf(pmax, p1[r]);
  { auto rr = __builtin_amdgcn_permlane32_swap(__float_as_uint(pmax), __float_as_uint(pmax), false, false);
    pmax = fmaxf(__uint_as_float(rr[0]), __uint_as_float(rr[1])); }
  alpha = 1.f;
  if (FIRST || !__builtin_expect(__all(pmax <= THR2), 1)) {
    const float dl = FIRST ? pmax : fmaxf(pmax, 0.f);
    if (!FIRST) alpha = __builtin_amdgcn_exp2f(-dl);
    m_reg += dl;
#pragma unroll
    for (int r = 0; r < 16; ++r) { p0[r] -= dl; p1[r] -= dl; }
  }
#pragma unroll
  for (int r = 0; r < 16; ++r) p0[r] = __builtin_amdgcn_exp2f(p0[r]);
}
__device__ __forceinline__ void finishSM(f32x16& p0, f32x16& p1, float alpha, float& l_reg, bf16x8& pa0, bf16x8& pa1, bf16x8& pa2, bf16x8& pa3) {
#pragma unroll
  for (int r = 0; r < 16; ++r) p1[r] = __builtin_amdgcn_exp2f(p1[r]);
  float ps = 0;
#pragma unroll
  for (int r = 0; r < 16; ++r) ps += p0[r];
#pragma unroll
  for (int r = 0; r < 16; ++r) ps += p1[r];
  { auto rr = __builtin_amdgcn_permlane32_swap(__float_as_uint(ps), __float_as_uint(ps), false, false);
    ps = __uint_as_float(rr[0]) + __uint_as_float(rr[1]); }
  l_reg = l_reg * alpha + ps;
#define PK4(P, BASE, OUT) do { unsigned a0 = cvtpk(P[BASE + 0], P[BASE + 1]), a1 = cvtpk(P[BASE + 2], P[BASE + 3]);   \
    unsigned b0 = cvtpk(P[BASE + 4], P[BASE + 5]), b1 = cvtpk(P[BASE + 6], P[BASE + 7]);                              \
    auto r0 = __builtin_amdgcn_permlane32_swap(a0, b0, false, false); auto r1 = __builtin_amdgcn_permlane32_swap(a1, b1, false, false); \
    u32x4 w = {r0[0], r1[0], r0[1], r1[1]}; OUT = *reinterpret_cast<bf16x8*>(&w); } while (0)
  PK4(p0, 0, pa0); PK4(p0, 8, pa1); PK4(p1, 0, pa2); PK4(p1, 8, pa3);
#undef PK4
}
__device__ __forceinline__ void qkt(f32x16& p0, f32x16& p1, const char* Ks, const bf16x8* qr, int r32, int hi, float m_ref) {
#pragma unroll
  for (int r = 0; r < 16; ++r) { p0[r] = -m_ref; p1[r] = -m_ref; }
#pragma unroll
  for (int d0 = 0; d0 < 6; ++d0) { const int cb = (d0 * 16 + hi * 8) * 2;
    const bf16x8 b0 = *reinterpret_cast<const bf16x8*>(Ks + KSWZ(r32, cb));
    const bf16x8 b1 = *reinterpret_cast<const bf16x8*>(Ks + KSWZ(32 + r32, cb));
    p0 = __builtin_amdgcn_mfma_f32_32x32x16_bf16(b0, qr[d0], p0, 0, 0, 0);
    p1 = __builtin_amdgcn_mfma_f32_32x32x16_bf16(b1, qr[d0], p1, 0, 0, 0); }
}
__device__ __forceinline__ int v_st(int k, int c) { const int kk = (k & ~0xC) | ((k & 4) << 1) | ((k & 8) >> 1); return ((kk >> 3) * 4 + (c >> 5)) * 512 + ((kk & 7) * 32 + (c & 31)) * 2; }
__device__ __forceinline__ int v_rd_base(int lane) { return ((lane & 3) << 3) | (((lane >> 2) & 3) << 6) | (((lane >> 4) & 1) << 5) | (((lane >> 5) & 1) << 8); }
constexpr int v_rd_off(int d0, int ks, int half) { return d0 * 512 + ks * 4096 + half * 2048; }
template <int OFF> __device__ __forceinline__ s16x4 tr_read(int vb) { s16x4 r; asm volatile("ds_read_b64_tr_b16 %0, %1 offset:%2" : "=&v"(r) : "v"(vb), "i"(OFF) : "memory"); return r; }
template <int D0> __device__ __forceinline__ void pv_one(f32x16& od, int vb, bf16x8 pa0, bf16x8 pa1, bf16x8 pa2, bf16x8 pa3) {
  const s16x4 l0 = tr_read<v_rd_off(D0, 0, 0)>(vb), h0 = tr_read<v_rd_off(D0, 0, 1)>(vb), l1 = tr_read<v_rd_off(D0, 1, 0)>(vb), h1 = tr_read<v_rd_off(D0, 1, 1)>(vb);
  const s16x4 l2 = tr_read<v_rd_off(D0, 2, 0)>(vb), h2 = tr_read<v_rd_off(D0, 2, 1)>(vb), l3 = tr_read<v_rd_off(D0, 3, 0)>(vb), h3 = tr_read<v_rd_off(D0, 3, 1)>(vb);
  asm volatile("s_waitcnt lgkmcnt(0)" ::: "memory"); SBAR();
#define PK(L, H) (bf16x8){L[0], L[1], L[2], L[3], H[0], H[1], H[2], H[3]}
  od = __builtin_amdgcn_mfma_f32_32x32x16_bf16(pa0, PK(l0, h0), od, 0, 0, 0);
  od = __builtin_amdgcn_mfma_f32_32x32x16_bf16(pa1, PK(l1, h1), od, 0, 0, 0);
  od = __builtin_amdgcn_mfma_f32_32x32x16_bf16(pa2, PK(l2, h2), od, 0, 0, 0);
  od = __builtin_amdgcn_mfma_f32_32x32x16_bf16(pa3, PK(l3, h3), od, 0, 0, 0);
#undef PK
}
__device__ __forceinline__ void pv_d0(f32x16* o, int vb, bf16x8 pa0, bf16x8 pa1, bf16x8 pa2, bf16x8 pa3) { pv_one<0>(o[0], vb, pa0, pa1, pa2, pa3); pv_one<1>(o[1], vb, pa0, pa1, pa2, pa3); }

template <int FAKE> __device__ __forceinline__ void unit(const bf16_t* __restrict__ Q0, const bf16_t* __restrict__ KV0, const bf16_t* __restrict__ KR, const bf16_t* __restrict__ Z, bf16_t* __restrict__ BR,
                                     int qrow0, int b, int h, int nkeys, char* lds) {
  int tid_ = threadIdx.x; asm volatile("" : "+v"(tid_));
  const int tid = tid_, wid = tid >> 6, lane = tid & 63, r32 = lane & 31, hi = lane >> 5;
  char* V_lds = lds; char* K_lds = lds + 3 * SHM_V;
  float* ws = (float*)(lds + 3 * SHM_V + 3 * SHM_K) + wid * 64; float* li_l = ws; float* al_l = ws + 32;
  float m_reg = 0.f, l_reg = 0; f32x16 o[2] = {}; bf16x8 qr[6];
  const bf16_t* Qw = Q0 + (size_t)(qrow0 + wid * QBLK + r32) * 768 + h * 96 + hi * 8;
#pragma unroll
  for (int d0 = 0; d0 < 6; ++d0) qr[d0] = *reinterpret_cast<const bf16x8*>(Qw + d0 * 16);
  const int vrow = tid >> 3, vc = (tid & 7) * 8, vst = v_st(vrow, vc);
  const int kr0 = tid / 12, kc0 = tid % 12, kr1 = (512 + (tid & 255)) / 12, kc1 = (512 + (tid & 255)) % 12;
  const bf16_t* vsrc = KV0 + (size_t)vrow * 1024 + h * 128 + 64 + vc;
  const bf16_t* ksrc0 = (kc0 < 8) ? KV0 + (size_t)kr0 * 1024 + h * 128 + 8 * kc0 : KR + (size_t)kr0 * 32 + 8 * (kc0 - 8);
  const bf16_t* ksrc1 = (kc1 < 8) ? KV0 + (size_t)kr1 * 1024 + h * 128 + 8 * kc1 : KR + (size_t)kr1 * 32 + 8 * (kc1 - 8);
  const int kstr0 = (kc0 < 8) ? 1024 : 32, kstr1 = (kc1 < 8) ? 1024 : 32;
  const int kst0 = KSWZ(kr0, kc0 * 16), kst1 = KSWZ(kr1, kc1 * 16);
  const int vb0 = (int)(uintptr_t)V_lds + v_rd_base(lane);
  struct { bf16x8 vs, ks0, ks1; } sr_[2];
#define ROWB(k0) (((k0) < 256) ? (MLAT + b * 256 + (k0)) : (b * 4096 + (k0) - 256))
#define SLOAD(i, k0) do { if (FAKE == 1) break; const size_t rb_ = (size_t)ROWB(k0); sr_[i].vs = *reinterpret_cast<const bf16x8*>(vsrc + rb_ * 1024); \
    sr_[i].ks0 = *reinterpret_cast<const bf16x8*>(ksrc0 + rb_ * kstr0); sr_[i].ks1 = *reinterpret_cast<const bf16x8*>(ksrc1 + rb_ * kstr1); } while (0)
#define SWRITE(bf, i) do { *(bf16x8*)(V_lds + (bf) * SHM_V + vst) = sr_[i].vs; *(bf16x8*)(K_lds + (bf) * SHM_K + kst0) = sr_[i].ks0; \
    *(bf16x8*)(K_lds + (bf) * SHM_K + kst1) = sr_[i].ks1; } while (0)
#define RESC(a) do { if (__any((a) < 1.f)) { if (hi == 0) al_l[r32] = (a); asm volatile("s_waitcnt lgkmcnt(0)" ::: "memory"); \
    _Pragma("unroll") for (int d = 0; d < 2; ++d) _Pragma("unroll") for (int r = 0; r < 16; ++r) o[d][r] *= al_l[crow(r, hi)]; } } while (0)
#define BARX() do { if (FAKE != 3) __syncthreads(); } while (0)
#define QKT(P0, P1, KS) do { if (FAKE == 5) { P0 = f32x16{}; P1 = f32x16{}; } else qkt(P0, P1, KS, qr, r32, hi, m_reg); } while (0)
#define PSM(P0, P1, MN, AL) do { if (FAKE == 2) { AL = 1.f; } else partialSM<false>(P0, P1, m_reg, AL); } while (0)
#define PSM0(P0, P1, AL) do { if (FAKE == 2) { AL = 1.f; } else partialSM<true>(P0, P1, m_reg, AL); } while (0)
#define FSM(P0, P1, AL) do { if (FAKE == 2) { u32x4 w_ = {__float_as_uint(P0[0]), __float_as_uint(P0[1]), __float_as_uint(P1[0]), __float_as_uint(P1[1])}; pa0 = pa1 = pa2 = pa3 = *reinterpret_cast<bf16x8*>(&w_); } else finishSM(P0, P1, AL, l_reg, pa0, pa1, pa2, pa3); } while (0)
#define PVD(VB) do { if (FAKE != 4) pv_d0(o, VB, pa0, pa1, pa2, pa3); } while (0)
  f32x16 pA0, pA1, pB0, pB1; float mnA, mnB, alA, alB; bf16x8 pa0, pa1, pa2, pa3; const int NT = nkeys / KVBLK;
  int bo_prev = 0, bo_cur = 0, bo_next = SHM_V;
#define ROT3() do { bo_prev = bo_cur; bo_cur = bo_next; bo_next = (bo_next == 2 * SHM_V) ? 0 : bo_next + SHM_V; } while (0)
#define SWRITE3(off, i) do { if (FAKE == 1) break; *(bf16x8*)(V_lds + (off) + vst) = sr_[i].vs; *(bf16x8*)(K_lds + (off) + kst0) = sr_[i].ks0; *(bf16x8*)(K_lds + (off) + kst1) = sr_[i].ks1; } while (0)
  SLOAD(0, 0); SLOAD(1, KVBLK); SWRITE3(0, 0); SLOAD(0, 2 * KVBLK);
  BARX();
  SWRITE3(bo_next, 1); SLOAD(1, 3 * KVBLK);
  QKT(pA0, pA1, K_lds + bo_cur); PSM0(pA0, pA1, alA); RESC(alA);
  ROT3();
  for (int j = 1; j + 1 < NT; j += 2) {
    BARX();
    SWRITE3(bo_next, 0); { const int tn = (j + 3 < NT) ? j + 3 : NT - 1; SLOAD(0, tn * KVBLK); }
    QKT(pB0, pB1, K_lds + bo_cur);
    FSM(pA0, pA1, alA);
    PVD(vb0 + bo_prev); PSM(pB0, pB1, mnB, alB); RESC(alB);
    ROT3();
    BARX();
    SWRITE3(bo_next, 1); { const int tn = (j + 4 < NT) ? j + 4 : NT - 1; SLOAD(1, tn * KVBLK); }
    QKT(pA0, pA1, K_lds + bo_cur);
    FSM(pB0, pB1, alB);
    PVD(vb0 + bo_prev); PSM(pA0, pA1, mnA, alA); RESC(alA);
    ROT3();
  }
  BARX();
  QKT(pB0, pB1, K_lds + bo_cur);
  FSM(pA0, pA1, alA);
  PVD(vb0 + bo_prev); PSM(pB0, pB1, mnB, alB); RESC(alB);
  FSM(pB0, pB1, alB);
  PVD(vb0 + bo_cur);
#undef ROT3
#undef BARX
#undef QKT
#undef PSM
#undef PSM0
#undef FSM
#undef PVD
#undef SWRITE3
  if (hi == 0) li_l[r32] = l_reg; asm volatile("s_waitcnt lgkmcnt(0)" ::: "memory");
  float rli[16];
#pragma unroll
  for (int r = 0; r < 16; ++r) rli[r] = __builtin_amdgcn_rcpf(li_l[crow(r, hi)]);
  { LAS float* stg = (LAS float*)(unsigned)(uintptr_t)(lds + 3 * SHM_V + 3 * SHM_K + 2048) + wid * (32 * 36);
#pragma unroll
    for (int d0 = 0; d0 < 2; ++d0) {
      u32x4 gw[2];
#pragma unroll
      for (int i2 = 0; i2 < 2; ++i2) { const size_t qrow = (size_t)(qrow0 + wid * QBLK + 16 * i2 + (lane >> 2)); gw[i2] = *(const u32x4*)(Z + qrow * 1024 + h * 64 + d0 * 32 + 8 * (lane & 3)); }
#pragma unroll
      for (int r = 0; r < 16; ++r) stg[crow(r, hi) * 36 + r32] = o[d0][r] * rli[r];
      asm volatile("s_waitcnt lgkmcnt(0)" ::: "memory");
#pragma unroll
      for (int i2 = 0; i2 < 2; ++i2) { const size_t qrow = (size_t)(qrow0 + wid * QBLK + 16 * i2 + (lane >> 2));
        const LAS f32x4* sp = (const LAS f32x4*)(stg + (16 * i2 + (lane >> 2)) * 36 + 8 * (lane & 3)); const f32x4 a0 = sp[0], a1 = sp[1]; const u32x4 g = gw[i2];
        u32x4 w; w.x = pk2(a0[0] * silu_f(lo16(g.x)), a0[1] * silu_f(hi16(g.x))); w.y = pk2(a0[2] * silu_f(lo16(g.y)), a0[3] * silu_f(hi16(g.y)));
        w.z = pk2(a1[0] * silu_f(lo16(g.z)), a1[1] * silu_f(hi16(g.z))); w.w = pk2(a1[2] * silu_f(lo16(g.w)), a1[3] * silu_f(hi16(g.w)));
        *(u32x4*)(BR + qrow * 1024 + h * 64 + d0 * 32 + 8 * (lane & 3)) = w; }
      asm volatile("s_waitcnt lgkmcnt(0)" ::: "memory");
    } }
#undef ROWB
#undef SLOAD
#undef SWRITE
#undef RESC
}
#undef KSWZ
#undef SBAR
}

namespace mla2 {
using s16x4 = __attribute__((ext_vector_type(4))) short;
using f32x16 = __attribute__((ext_vector_type(16))) float;
typedef short v4i16_t __attribute__((ext_vector_type(4)));
typedef __attribute__((address_space(3))) const char* lds_cptr;
typedef float f32x2_t __attribute__((ext_vector_type(2))); typedef __bf16 bf16x2_t __attribute__((ext_vector_type(2)));
constexpr int NSLOT = 3, KSLOT = 12288, VSLOT = 8192;
constexpr int LDS_K = 0, LDS_V = NSLOT * KSLOT, LDS_WS = LDS_V + NSLOT * VSLOT, LDS_STG = LDS_WS + 2048, LDS_END = LDS_STG + 8 * 4608;
#define SBAR() __builtin_amdgcn_sched_barrier(0)
__device__ __forceinline__ int crow(int r, int hi) { return (r & 3) + 8 * (r >> 2) + 4 * hi; }
__device__ __forceinline__ void glds16(const void* gsrc, unsigned lds_dst) { unsigned keep;
  asm volatile("s_mov_b32 %0, m0\n\ts_mov_b32 m0, %2\n\ts_nop 0\n\tglobal_load_lds_dwordx4 %1, off\n\ts_mov_b32 m0, %0" : "=&s"(keep) : "v"(gsrc), "s"(lds_dst) : "memory"); }
__device__ __forceinline__ float max3f(float a, float b, float c) { float r; asm("v_max3_f32 %0, %1, %2, %3" : "=v"(r) : "v"(a), "v"(b), "v"(c)); return r; }
__device__ __forceinline__ float max2f(float a, float b) { float r; asm("v_max_f32_e32 %0, %1, %2" : "=v"(r) : "v"(a), "v"(b)); return r; }
__device__ __forceinline__ float fadd_s(float a, float b) { float r; asm("v_add_f32_e32 %0, %1, %2" : "=v"(r) : "v"(a), "v"(b)); return r; }
__device__ __forceinline__ float fsub_s(float a, float b) { float r; asm("v_sub_f32_e32 %0, %1, %2" : "=v"(r) : "v"(a), "v"(b)); return r; }
__device__ __forceinline__ unsigned cvtpk_s(float lo, float hi) { f32x2_t v = {lo, hi}; bf16x2_t b = __builtin_convertvector(v, bf16x2_t); return __builtin_bit_cast(unsigned, b); }
#define WAIT_BAR(N) asm volatile("s_waitcnt vmcnt(" #N ") lgkmcnt(0)\n\ts_barrier" ::: "memory")
__device__ __forceinline__ void qkt6(f32x16& p0, f32x16& p1, lds_cptr Kslot, const bf16x8* qr, const f32x16& negm, int r32, int hi) {
  lds_cptr kb = Kslot + hi * 1024 + r32 * 16;
#pragma unroll
  for (int d0 = 0; d0 < 6; ++d0) {
    const bf16x8 b0 = *(const LAS bf16x8*)(kb + d0 * 2048), b1 = *(const LAS bf16x8*)(kb + d0 * 2048 + 512);
    if (d0 == 0) { p0 = __builtin_amdgcn_mfma_f32_32x32x16_bf16(b0, qr[0], negm, 0, 0, 0); p1 = __builtin_amdgcn_mfma_f32_32x32x16_bf16(b1, qr[0], negm, 0, 0, 0); }
    else { p0 = __builtin_amdgcn_mfma_f32_32x32x16_bf16(b0, qr[d0], p0, 0, 0, 0); p1 = __builtin_amdgcn_mfma_f32_32x32x16_bf16(b1, qr[d0], p1, 0, 0, 0); } }
}
__device__ __forceinline__ void kload2(bf16x8* kf, lds_cptr kp, int j) { kf[2 * j] = *(const LAS bf16x8*)(kp + j * 2048); kf[2 * j + 1] = *(const LAS bf16x8*)(kp + j * 2048 + 512); }
__device__ __forceinline__ s16x4 vtr(lds_cptr p) { return __builtin_bit_cast(s16x4, __builtin_amdgcn_ds_read_tr16_b64_v4i16((__attribute__((address_space(3))) v4i16_t*)p)); }
__device__ __forceinline__ float rowmax(const f32x16& p0, const f32x16& p1) {
  float a = max3f(p0[0], p0[1], p1[0]), b = max3f(p0[2], p0[3], p1[1]); a = max3f(a, p1[2], p1[3]);
#pragma unroll
  for (int r = 4; r < 16; r += 4) { a = max3f(a, p0[r], p0[r + 1]); b = max3f(b, p0[r + 2], p0[r + 3]); a = max3f(a, p1[r], p1[r + 1]); b = max3f(b, p1[r + 2], p1[r + 3]); }
  const float m = max2f(a, b);
  auto rr = __builtin_amdgcn_permlane32_swap(__float_as_uint(m), __float_as_uint(m), false, false);
  return max2f(__uint_as_float(rr[0]), __uint_as_float(rr[1]));
}
template <int THRL> __device__ __forceinline__ void unit(const bf16_t* __restrict__ Q0, const bf16_t* __restrict__ KV0, const bf16_t* __restrict__ KR, const bf16_t* __restrict__ GATE, bf16_t* __restrict__ BR,
                                                         int qrow0, int b, int h, int nkeys, LAS unsigned char* lds) {
  int tid_ = threadIdx.x; asm volatile("" : "+v"(tid_));
  const int tid = tid_, lane = tid & 63, r32 = lane & 31, hi = lane >> 5; const int wid = __builtin_amdgcn_readfirstlane(tid >> 6);
  const unsigned lds0 = (unsigned)(uintptr_t)lds;
  LAS float* wsf = (LAS float*)(lds + LDS_WS) + wid * 64;
  const bf16_t* ks0 = KV0 + (size_t)lane * 1024 + h * 128 + wid * 8;
  const bf16_t* ks1 = KR + (size_t)lane * 32 + (wid & 3) * 8;
  const bf16_t* vs = KV0 + (size_t)(16 * (wid & 3) + (lane >> 2)) * 1024 + h * 128 + 64 + (wid >> 2) * 32 + (lane & 3) * 8;
  const unsigned kd0 = lds0 + LDS_K + wid * 1024, kd1 = lds0 + LDS_K + (8 + (wid & 3)) * 1024, vd = lds0 + LDS_V + wid * 1024;
#define ROWB(t) (((t) < 4) ? (MLAT + b * 256 + 64 * (t)) : (b * 4096 + 64 * ((t) - 4)))
#define DMA_K(t, slot) do { const size_t rb_ = (size_t)ROWB(t); glds16(ks0 + rb_ * 1024, (unsigned)__builtin_amdgcn_readfirstlane(kd0 + (slot))); glds16(ks1 + rb_ * 32, (unsigned)__builtin_amdgcn_readfirstlane(kd1 + (slot))); } while (0)
#define DMA_V(t, slot) do { const size_t rb_ = (size_t)ROWB(t); glds16(vs + rb_ * 1024, (unsigned)__builtin_amdgcn_readfirstlane(vd + (slot))); } while (0)
  const lds_cptr shm3 = (lds_cptr)lds; const lds_cptr kp0 = shm3 + LDS_K + hi * 1024 + r32 * 16;
  const lds_cptr vp0 = shm3 + LDS_V + ((lane >> 4) & 1) * 32 + (lane & 3) * 8 + (4 * hi + ((lane & 15) >> 2)) * 64;
  bf16x8 kf[12];
  const int NT = nkeys / 64;
  DMA_K(0, 0); DMA_V(0, 0); DMA_K(1, KSLOT);
  bf16x8 qr[6];
  { const bf16_t* Qw = Q0 + (size_t)(qrow0 + wid * 32 + r32) * 768 + h * 96 + hi * 8;
#pragma unroll
    for (int d0 = 0; d0 < 6; ++d0) qr[d0] = *reinterpret_cast<const bf16x8*>(Qw + d0 * 16); }
  float mhat = 0.f, l_reg = 0.f; f32x16 o[2]; o[0] = f32x16{}; o[1] = f32x16{}; f32x16 negm = f32x16{}; asm volatile("" : "+v"(negm));
  bool resc = false;
#define START(P0, P1) do { const float rm = rowmax(P0, P1); resc = false; \
    { const float dl = rm; mhat = fadd_s(mhat, dl); \
      _Pragma("unroll") for (int r = 0; r < 16; ++r) { P0[r] = fsub_s(P0[r], dl); P1[r] = fsub_s(P1[r], dl); } \
      _Pragma("unroll") for (int r = 0; r < 16; ++r) negm[r] = -mhat; asm volatile("" : "+v"(negm)); } \
    _Pragma("unroll") for (int r = 0; r < 16; ++r) P0[r] = __builtin_amdgcn_exp2f(P0[r]); } while (0)
#define RESC() do { if (resc) { asm volatile("s_waitcnt lgkmcnt(0)" ::: "memory"); \
      _Pragma("unroll") for (int d_ = 0; d_ < 2; ++d_) _Pragma("unroll") for (int r = 0; r < 16; ++r) o[d_][r] *= wsf[crow(r, hi)]; } } while (0)
  f32x16 pA0, pA1, pB0, pB1;
  int ks_cur = 0, ks_next = KSLOT, vs_prev = 0, vs_cur = 0, vs_next = VSLOT;
#define ROT() do { ks_cur = ks_next; ks_next = (ks_next == (NSLOT - 1) * KSLOT) ? 0 : ks_next + KSLOT; vs_prev = vs_cur; vs_cur = vs_next; vs_next = (vs_next == (NSLOT - 1) * VSLOT) ? 0 : vs_next + VSLOT; } while (0)
  DMA_K(2, 2 * KSLOT);
  WAIT_BAR(5);
  qkt6(pA0, pA1, shm3 + LDS_K, qr, negm, r32, hi); asm volatile("s_nop 15\n\ts_nop 7" : "+v"(pA0), "+v"(pA1));
  START(pA0, pA1);
#pragma unroll
  for (int r = 0; r < 16; ++r) pA1[r] = __builtin_amdgcn_exp2f(pA1[r]);
  WAIT_BAR(0);
  DMA_K(3, 0); DMA_V(1, VSLOT);
  ROT();
#pragma unroll
  for (int j = 0; j < 6; ++j) kload2(kf, kp0 + ks_cur, j);
  WAIT_BAR(3);
  s16x4 vlo[8], vhi[8]; u32x4 pw0, pw1, pw2, pw3;
#define PKW(P, B) cvtpk_s(P[B], P[B + 1])
#define PAF(k) __builtin_bit_cast(bf16x8, pw##k)
#define VFR(i) (bf16x8){vlo[i][0], vlo[i][1], vlo[i][2], vlo[i][3], vhi[i][0], vhi[i][1], vhi[i][2], vhi[i][3]}
#define PIN(x) asm volatile("" : "+v"(x))
#define MX3(a, b, c) __builtin_fmaxf(__builtin_fmaxf((a), (b)), (c))
#define GAPA(MF, A0, A1, A2, A3, W0, W1, PW) do { MF; sacc += A0; sacc += A1; sacc += A2; sacc += A3; PIN(sacc); W0; W1; PIN(PW); SBAR(); } while (0)
#define GAPM(MF) do { MF; SBAR(); } while (0)
#define EX(v) __builtin_amdgcn_exp2f(v)
#define GAPB(MF, X, B) do { MF; X[B] = EX(X[B]); X[B + 1] = EX(X[B + 1]); X[B + 2] = EX(X[B + 2]); X[B + 3] = EX(X[B + 3]); PIN(X); SBAR(); } while (0)
#define VRD(i) do { vlo[i] = vtr(vp_ + (((i) >> 2) * 4096 + ((i) & 3) * 1024)); vhi[i] = vtr(vp_ + (((i) >> 2) * 4096 + ((i) & 3) * 1024 + 512)); } while (0)
#define KRD(G, j) do { if (G) { kload2(kf, kp0 + ks_next, j); SBAR(); } } while (0)
#define MF32(A, B, C) __builtin_amdgcn_mfma_f32_32x32x16_bf16(A, B, C, 0, 0, 0)
#define STEP(C0, C1, P0, P1, t, GK, GV, GL) do { SBAR(); \
    const lds_cptr vp_ = vp0 + vs_prev; \
    VRD(0); SBAR(); float sacc = (P0[0] + P0[1]); \
    GAPA(C0 = MF32(kf[0], qr[0], negm), P0[2], P0[3], P0[4], P0[5],     pw0[0] = PKW(P0, 0), pw0[1] = PKW(P0, 2), pw0); \
    VRD(4); SBAR(); GAPA(C1 = MF32(kf[1], qr[0], negm), P0[6], P0[7], P0[8], P0[9],     pw0[2] = PKW(P0, 4), pw0[3] = PKW(P0, 6), pw0); \
    VRD(1); SBAR(); GAPA(C0 = MF32(kf[2], qr[1], C0),   P0[10], P0[11], P0[12], P0[13], pw1[0] = PKW(P0, 8), pw1[1] = PKW(P0, 10), pw1); \
    VRD(5); SBAR(); GAPA(C1 = MF32(kf[3], qr[1], C1),   P0[14], P0[15], P1[0], P1[1],   pw1[2] = PKW(P0, 12), pw1[3] = PKW(P0, 14), pw1); \
    VRD(2); SBAR(); GAPA(C0 = MF32(kf[4], qr[2], C0),   P1[2], P1[3], P1[4], P1[5],     pw2[0] = PKW(P1, 0), pw2[1] = PKW(P1, 2), pw2); \
    VRD(6); SBAR(); GAPA(C1 = MF32(kf[5], qr[2], C1),   P1[6], P1[7], P1[8], P1[9],     pw2[2] = PKW(P1, 4), pw2[3] = PKW(P1, 6), pw2); \
    VRD(3); SBAR(); GAPA(C0 = MF32(kf[6], qr[3], C0),   P1[10], P1[11], P1[12], P1[13], pw3[0] = PKW(P1, 8), pw3[1] = PKW(P1, 10), pw3); \
    VRD(7); SBAR(); GAPA(C1 = MF32(kf[7], qr[3], C1),   P1[14], P1[15], 0.f, 0.f,       pw3[2] = PKW(P1, 12), pw3[3] = PKW(P1, 14), pw3); \
    GAPM(C0 = MF32(kf[8], qr[4], C0)); GAPM(C1 = MF32(kf[9], qr[4], C1)); GAPM(C0 = MF32(kf[10], qr[5], C0)); GAPM(C1 = MF32(kf[11], qr[5], C1)); \
    l_reg += sacc; \
    if (GK) { DMA_K((t) + 3, ks_cur); } if (GV) { DMA_V((t) + 1, vs_next); } \
    { float a = MX3(C0[0], C0[1], C1[0]), bq = MX3(C0[2], C0[3], C1[1]); a = MX3(a, C1[2], C1[3]); \
      _Pragma("unroll") for (int r = 4; r < 16; r += 4) { a = MX3(a, C0[r], C0[r + 1]); bq = MX3(bq, C0[r + 2], C0[r + 3]); a = MX3(a, C1[r], C1[r + 1]); bq = MX3(bq, C1[r + 2], C1[r + 3]); } \
      float rm = __builtin_fmaxf(a, bq); { auto rr = __builtin_amdgcn_permlane32_swap(__float_as_uint(rm), __float_as_uint(rm), false, false); rm = __builtin_fmaxf(__uint_as_float(rr[0]), __uint_as_float(rr[1])); } \
      resc = false; \
      if (__builtin_expect(__any(rm > (float)THRL), 0)) { const float dl = __builtin_fmaxf(rm, 0.f); mhat += dl; \
        _Pragma("unroll") for (int r = 0; r < 16; ++r) { C0[r] -= dl; C1[r] -= dl; } \
        _Pragma("unroll") for (int r = 0; r < 16; ++r) negm[r] = -mhat; asm volatile("" : "+v"(negm)); \
        const float f = __builtin_amdgcn_exp2f(-dl); l_reg *= f; if (hi == 0) wsf[r32] = f; resc = true; } } \
    SBAR(); \
    KRD(GL, 0); GAPB(o[0] = MF32(PAF(0), VFR(0), o[0]), C0, 0); \
    KRD(GL, 1); GAPB(o[1] = MF32(PAF(0), VFR(4), o[1]), C0, 4); \
    KRD(GL, 2); GAPB(o[0] = MF32(PAF(1), VFR(1), o[0]), C0, 8); \
    KRD(GL, 3); GAPB(o[1] = MF32(PAF(1), VFR(5), o[1]), C0, 12); \
    KRD(GL, 4); GAPB(o[0] = MF32(PAF(2), VFR(2), o[0]), C1, 0); \
    KRD(GL, 5); GAPB(o[1] = MF32(PAF(2), VFR(6), o[1]), C1, 4); \
    GAPB(o[0] = MF32(PAF(3), VFR(3), o[0]), C1, 8); \
    GAPB(o[1] = MF32(PAF(3), VFR(7), o[1]), C1, 12); \
  } while (0)
  int t = 1;
  for (; t + 5 < NT; t += 2) {
    STEP(pB0, pB1, pA0, pA1, t, true, true, true);     WAIT_BAR(3); RESC(); ROT();
    STEP(pA0, pA1, pB0, pB1, t + 1, true, true, true); WAIT_BAR(3); RESC(); ROT();
  }
#define ENDW(tt) do { if ((tt) + 3 < NT) { WAIT_BAR(3); } else if ((tt) + 2 < NT) { WAIT_BAR(1); } else { WAIT_BAR(0); } } while (0)
  for (; t + 1 < NT; t += 2) {
    STEP(pB0, pB1, pA0, pA1, t, (t + 3 < NT), (t + 1 < NT), (t + 1 < NT));     ENDW(t);     RESC(); ROT();
    STEP(pA0, pA1, pB0, pB1, t + 1, (t + 4 < NT), (t + 2 < NT), (t + 2 < NT)); ENDW(t + 1); RESC(); ROT();
  }
  STEP(pB0, pB1, pA0, pA1, NT - 1, false, false, false); RESC();
  { float sacc = pB0[0] + pB0[1];
#pragma unroll
    for (int r = 2; r < 16; ++r) sacc += pB0[r];
#pragma unroll
    for (int r = 0; r < 16; ++r) sacc += pB1[r];
    l_reg += sacc;
    pw0 = (u32x4){PKW(pB0, 0), PKW(pB0, 2), PKW(pB0, 4), PKW(pB0, 6)}; pw1 = (u32x4){PKW(pB0, 8), PKW(pB0, 10), PKW(pB0, 12), PKW(pB0, 14)};
    pw2 = (u32x4){PKW(pB1, 0), PKW(pB1, 2), PKW(pB1, 4), PKW(pB1, 6)}; pw3 = (u32x4){PKW(pB1, 8), PKW(pB1, 10), PKW(pB1, 12), PKW(pB1, 14)};
    SBAR();
    const lds_cptr vp_ = vp0 + vs_cur;
    VRD(0); VRD(1); VRD(2); VRD(3); VRD(4); VRD(5); VRD(6); VRD(7);
    o[0] = MF32(PAF(0), VFR(0), o[0]); o[1] = MF32(PAF(0), VFR(4), o[1]); o[0] = MF32(PAF(1), VFR(1), o[0]); o[1] = MF32(PAF(1), VFR(5), o[1]);
    o[0] = MF32(PAF(2), VFR(2), o[0]); o[1] = MF32(PAF(2), VFR(6), o[1]); o[0] = MF32(PAF(3), VFR(3), o[0]); o[1] = MF32(PAF(3), VFR(7), o[1]); }
  { auto rr = __builtin_amdgcn_permlane32_swap(__float_as_uint(l_reg), __float_as_uint(l_reg), false, false); l_reg = __uint_as_float(rr[0]) + __uint_as_float(rr[1]); }
  if (hi == 0) wsf[32 + r32] = l_reg; asm volatile("s_waitcnt lgkmcnt(0)" ::: "memory");
  float rli[16];
#pragma unroll
  for (int r = 0; r < 16; ++r) rli[r] = __builtin_amdgcn_rcpf(wsf[32 + crow(r, hi)]);
  { LAS float* stg = (LAS float*)(lds + LDS_STG) + wid * (32 * 36);
#pragma unroll
    for (int d0 = 0; d0 < 2; ++d0) {
      u32x4 gw[2];
#pragma unroll
      for (int i2 = 0; i2 < 2; ++i2) { const size_t qrow = (size_t)(qrow0 + wid * 32 + 16 * i2 + (lane >> 2)); gw[i2] = *(const u32x4*)(GATE + qrow * 1024 + h * 64 + d0 * 32 + 8 * (lane & 3)); }
#pragma unroll
      for (int r = 0; r < 16; ++r) stg[crow(r, hi) * 36 + r32] = o[d0][r] * rli[r];
      asm volatile("s_waitcnt lgkmcnt(0)" ::: "memory");
#pragma unroll
      for (int i2 = 0; i2 < 2; ++i2) { const size_t qrow = (size_t)(qrow0 + wid * 32 + 16 * i2 + (lane >> 2));
        const LAS f32x4* sp = (const LAS f32x4*)(stg + (16 * i2 + (lane >> 2)) * 36 + 8 * (lane & 3)); const f32x4 a0 = sp[0], a1 = sp[1]; const u32x4 g = gw[i2];
        u32x4 w; w.x = pk2(a0[0] * silu_f(lo16(g.x)), a0[1] * silu_f(hi16(g.x))); w.y = pk2(a0[2] * silu_f(lo16(g.y)), a0[3] * silu_f(hi16(g.y)));
        w.z = pk2(a1[0] * silu_f(lo16(g.z)), a1[1] * silu_f(hi16(g.z))); w.w = pk2(a1[2] * silu_f(lo16(g.w)), a1[3] * silu_f(hi16(g.w)));
        *(u32x4*)(BR + qrow * 1024 + h * 64 + d0 * 32 + 8 * (lane & 3)) = w; }
      asm volatile("s_waitcnt lgkmcnt(0)" ::: "memory");
    } }
  asm volatile("s_waitcnt vmcnt(0) lgkmcnt(0)\n\ts_barrier" ::: "memory");
#undef ROWB
#undef DMA_K
#undef DMA_V
#undef START
#undef RESC
#undef ROT
#undef PKW
#undef PAF
#undef VFR
#undef PIN
#undef MX3
#undef GAPA
#undef GAPM
#undef EX
#undef GAPB
#undef VRD
#undef KRD
#undef MF32
#undef STEP
#undef ENDW
}
#undef SBAR
#undef WAIT_BAR
}

template <int FAKE> __device__ __forceinline__ void phase_mla(KArgs a0, const Fr& F0) {
    const Fr F = launder(F0); const KArgs a = klaunder(a0);
    const bf16_t* Q0 = (const bf16_t*)(WSP(a) + WS_Q0); const bf16_t* KV0 = (const bf16_t*)(WSP(a) + WS_KV0); const bf16_t* KR = (const bf16_t*)(WSP(a) + WS_KR);
    const bf16_t* Z = (const bf16_t*)(WSP(a) + WS_GATE); bf16_t* BR = (bf16_t*)HBP(a);
    const int vcu = (gridDim.x % 8 == 0) ? ((int)blockIdx.x % 8) * ((int)gridDim.x / 8) + (int)blockIdx.x / 8 : (int)blockIdx.x;
    for (int u = vcu; u < 1024 + 64; u += gridDim.x) {
        __syncthreads();
        if (u < 1024) { const int bh = u >> 4, qb = u & 15, b = bh >> 3, h = bh & 7; if (MLA_V2 && FAKE == 0) mla2::unit<11>(Q0, KV0, KR, Z, BR, b * 4096 + qb * 256, b, h, 4352, F.lds); else mla::unit<FAKE>(Q0, KV0, KR, Z, BR, b * 4096 + qb * 256, b, h, 4352, (char*)F.lds); }
        else { const int bh = u - 1024, b = bh >> 3, h = bh & 7; if (MLA_V2 && FAKE == 0) mla2::unit<11>(Q0, KV0, KR, Z, BR, MLAT + b * 256, b, h, 256, F.lds); else mla::unit<FAKE>(Q0, KV0, KR, Z, BR, MLAT + b * 256, b, h, 256, (char*)F.lds); }
    }
    __syncthreads();
}

namespace na {
using f32x16 = __attribute__((ext_vector_type(16))) float;
constexpr float C1 = 0.125f * 1.4426950408889634f, L2E = 1.4426950408889634f, THR2 = 11.5f;
__device__ __forceinline__ int crow(int r, int hi) { return (r & 3) + 8 * (r >> 2) + 4 * hi; }
__device__ __forceinline__ unsigned cvtpk(float lo, float hi) { unsigned r; asm volatile("v_cvt_pk_bf16_f32 %0, %1, %2" : "=v"(r) : "v"(lo), "v"(hi)); return r; }
constexpr int RING_OFF = 0, SLOT = 16384, NSLOT = 4, TAB_OFF = 69632, WSF_OFF = 73728, STG_OFF = 81920;
template <int FAKE> __device__ __forceinline__ void item(bf16_t* __restrict__ Z, const bf16_t* __restrict__ VT, LAS unsigned char* lds, int b, int h, bool lat, int q4) {
  int tid_ = threadIdx.x; asm volatile("" : "+v"(tid_));
  const int tid = tid_, lane = tid & 63, r32 = lane & 31, hi = lane >> 5, wid = __builtin_amdgcn_readfirstlane(tid >> 6);
  const LAS float* tab = (const LAS float*)(lds + TAB_OFF); LAS float* wsf = (LAS float*)(lds + WSF_OFF) + wid * 64;
  const int rp = 2 * q4 + (wid >> 2), ct = wid & 3;
  int rq = 0, cq = 0, qtok;
  if (lat) { rq = 2 * rp + (r32 >> 4); cq = 16 * ct + (r32 & 15); qtok = b * 4096 + rq * 64 + cq; } else qtok = MLAT + b * 256 + 32 * wid + r32;
  int rs0 = 2 * rp - 4; rs0 = rs0 < 0 ? 0 : (rs0 > 56 ? 56 : rs0);
  int rs1 = 2 * rp - 3; rs1 = rs1 < 0 ? 0 : (rs1 > 56 ? 56 : rs1);
  int u0 = 16 * ct - 8; u0 = u0 < 0 ? 0 : (u0 > 32 ? 32 : u0);
  int rsq = rq - 4; rsq = rsq < 0 ? 0 : (rsq > 56 ? 56 : rsq);
  int csq = cq - 8; csq = csq < 0 ? 0 : (csq > 48 ? 48 : csq);
  int rsA = 4 * q4 - 4; rsA = rsA < 0 ? 0 : (rsA > 56 ? 56 : rsA);
  int rsB = 4 * q4 - 1; rsB = rsB < 0 ? 0 : (rsB > 56 ? 56 : rsB);
  const int nst = lat ? 4 + (rsB - rsA + 8) : 4;
  bf16x8 qr[4];
  { const bf16_t* qp = Z + (size_t)qtok * 4096 + h * 64 + hi * 8;
#pragma unroll
    for (int d0 = 0; d0 < 4; ++d0) qr[d0] = *reinterpret_cast<const bf16x8*>(qp + d0 * 16); }
  const int srow = 8 * wid + (lane >> 3), sch = (lane & 7) ^ ((srow >> 1) & 7);
  const bf16_t* ksrc = Z + (size_t)srow * 4096 + 1024 + h * 64 + 8 * sch;
  const bf16_t* vsrc = VT + ((size_t)sch * 1024 + h * 64 + srow) * 8;
#define TOKB(s) (((s) < 4) ? (MLAT + b * 256 + 64 * (s)) : (b * 4096 + (rsA + (s) - 4) * 64))
  const unsigned ldsb = (unsigned)(uintptr_t)(lds + RING_OFF) + (unsigned)wid * 1024u;
#define GLDS16(gsrc, dst) do { unsigned keep_; asm volatile("s_mov_b32 %0, m0\n\ts_mov_b32 m0, %2\n\ts_nop 0\n\tglobal_load_lds_dwordx4 %1, off\n\ts_mov_b32 m0, %0" : "=&s"(keep_) : "v"(gsrc), "s"(dst) : "memory"); } while (0)
#define ISSUE(s) do { if (FAKE == 1) break; const int tb_ = TOKB(s); const unsigned sl_ = (unsigned)__builtin_amdgcn_readfirstlane(ldsb + (unsigned)(((s) & 3) * SLOT)); \
    GLDS16(ksrc + (size_t)tb_ * 4096, sl_); GLDS16(vsrc + (size_t)(tb_ >> 3) * 8192, sl_ + 8192u); } while (0)
  const int swz = (r32 >> 1) & 7;
  f32x16 o[2] = {}; float m_reg = 0.f, l_reg = 0.f;
#define PK4(P, BASE, OUT) do { unsigned a0 = cvtpk(P[BASE + 0], P[BASE + 1]), a1 = cvtpk(P[BASE + 2], P[BASE + 3]);   \
    unsigned b0 = cvtpk(P[BASE + 4], P[BASE + 5]), b1 = cvtpk(P[BASE + 6], P[BASE + 7]);                              \
    auto r0 = __builtin_amdgcn_permlane32_swap(a0, b0, false, false); auto r1 = __builtin_amdgcn_permlane32_swap(a1, b1, false, false); \
    u32x4 w = {r0[0], r1[0], r0[1], r1[1]}; OUT = *reinterpret_cast<bf16x8*>(&w); } while (0)
#define BLOCK(SL, krow0, kswz, vch0, WIN, kr, FIRSTB) do { \
    bf16x8 kf[4], vf[2][2]; \
    { const LAS unsigned char* kp_ = (SL) + ((krow0) + r32) * 128; \
      _Pragma("unroll") for (int d0 = 0; d0 < 4; ++d0) kf[d0] = *(const LAS bf16x8*)(kp_ + (((2 * d0 + hi) ^ (kswz)) << 4)); \
      _Pragma("unroll") for (int d0 = 0; d0 < 2; ++d0) _Pragma("unroll") for (int ks = 0; ks < 2; ++ks) \
        vf[d0][ks] = *(const LAS bf16x8*)((SL) + 8192 + (32 * d0 + r32) * 128 + ((((vch0) + 2 * ks + hi) ^ swz) << 4)); } \
    f32x16 p; \
    _Pragma("unroll") for (int r = 0; r < 16; ++r) p[r] = -m_reg;                   \
    if (FAKE != 5) { _Pragma("unroll") for (int d0 = 0; d0 < 4; ++d0) p = __builtin_amdgcn_mfma_f32_32x32x16_bf16(kf[d0], qr[d0], p, 0, 0, 0); } \
    if (FAKE != 2) { \
    if (WIN) { \
      const bool rowok = (unsigned)((kr) - rsq) < 8u; \
      const LAS float* tp = tab + ((kr) - rq + 7) * 31 + (u0 - cq + 15) + 4 * hi; \
      const int kc0 = u0 + 4 * hi - csq; \
      _Pragma("unroll") for (int r = 0; r < 16; ++r) { const int off = (r & 3) + 8 * (r >> 2); const bool ok = rowok && ((unsigned)(kc0 + off) < 16u); \
        const float bv = tp[off]; p[r] = ok ? (p[r] + bv) : -1e30f; } \
    } \
    float bmax = p[0]; \
    _Pragma("unroll") for (int r = 1; r < 16; ++r) bmax = fmaxf(bmax, p[r]); \
    { auto rr = __builtin_amdgcn_permlane32_swap(__float_as_uint(bmax), __float_as_uint(bmax), false, false); bmax = fmaxf(__uint_as_float(rr[0]), __uint_as_float(rr[1])); } \
    if ((FIRSTB) || !__all(bmax <= THR2)) { \
      const float dl = (FIRSTB) ? bmax : fmaxf(bmax, 0.f); m_reg += dl; \
      _Pragma("unroll") for (int r = 0; r < 16; ++r) p[r] -= dl; \
      if (!(FIRSTB)) { const float alpha = __builtin_amdgcn_exp2f(-dl); l_reg *= alpha; \
        if (hi == 0) wsf[r32] = alpha; asm volatile("s_waitcnt lgkmcnt(0)" ::: "memory"); \
        _Pragma("unroll") for (int d = 0; d < 2; ++d) _Pragma("unroll") for (int r = 0; r < 16; ++r) o[d][r] *= wsf[crow(r, hi)]; } \
    } \
    float ps = 0.f; \
    _Pragma("unroll") for (int r = 0; r < 16; ++r) { p[r] = __builtin_amdgcn_exp2f(p[r]); ps += p[r]; } \
    l_reg += ps; \
    } \
    bf16x8 pa0, pa1; PK4(p, 0, pa0); PK4(p, 8, pa1); \
    if (FAKE != 4) { _Pragma("unroll") for (int d0 = 0; d0 < 2; ++d0) { o[d0] = __builtin_amdgcn_mfma_f32_32x32x16_bf16(pa0, vf[d0][0], o[d0], 0, 0, 0); o[d0] = __builtin_amdgcn_mfma_f32_32x32x16_bf16(pa1, vf[d0][1], o[d0], 0, 0, 0); } } \
  } while (0)
  const int kswzw = ((u0 + r32) >> 1) & 7;
  ISSUE(0); ISSUE(1);
  for (int s = 0; s < nst; ++s) {
    if (s + 1 < nst) asm volatile("s_waitcnt vmcnt(2)" ::: "memory"); else asm volatile("s_waitcnt vmcnt(0)" ::: "memory");
    asm volatile("s_waitcnt lgkmcnt(0)" ::: "memory");
    if (FAKE != 3) __builtin_amdgcn_s_barrier();
    if (s + 2 < nst) ISSUE(s + 2);
    const LAS unsigned char* sl = lds + RING_OFF + (s & 3) * SLOT;
    if (s == 0) { BLOCK(sl, 0, swz, 0, false, 0, true); BLOCK(sl, 32, swz, 4, false, 0, false); }
    else if (s < 4) { BLOCK(sl, 0, swz, 0, false, 0, false); BLOCK(sl, 32, swz, 4, false, 0, false); }
    else { const int kr = rsA + s - 4; if (kr >= rs0 && kr <= rs1 + 7) BLOCK(sl, u0, kswzw, (u0 >> 3), true, kr, false); }
  }
#undef BLOCK
#undef PK4
#undef ISSUE
#undef GLDS16
#undef TOKB
  { auto rr = __builtin_amdgcn_permlane32_swap(__float_as_uint(l_reg), __float_as_uint(l_reg), false, false); l_reg = __uint_as_float(rr[0]) + __uint_as_float(rr[1]); }
  if (hi == 0) wsf[32 + r32] = l_reg; asm volatile("s_waitcnt lgkmcnt(0)" ::: "memory");
  if (FAKE == 6) return;
  { LAS float* stg = (LAS float*)(lds + STG_OFF) + wid * (32 * 36);
    float rli[16];
#pragma unroll
    for (int r = 0; r < 16; ++r) rli[r] = __builtin_amdgcn_rcpf(wsf[32 + crow(r, hi)]);
#pragma unroll
    for (int d0 = 0; d0 < 2; ++d0) {
      u32x4 gw[2]; size_t toks[2];
#pragma unroll
      for (int i2 = 0; i2 < 2; ++i2) { const int qi = 16 * i2 + (lane >> 2);
        toks[i2] = lat ? (size_t)(b * 4096 + (2 * rp + (qi >> 4)) * 64 + 16 * ct + (qi & 15)) : (size_t)(MLAT + b * 256 + 32 * wid + qi);
        gw[i2] = *(const u32x4*)(Z + toks[i2] * 4096 + 3072 + h * 64 + d0 * 32 + 8 * (lane & 3)); }
#pragma unroll
      for (int r = 0; r < 16; ++r) stg[crow(r, hi) * 36 + r32] = o[d0][r] * rli[r];
      asm volatile("s_waitcnt lgkmcnt(0)" ::: "memory");
#pragma unroll
      for (int i2 = 0; i2 < 2; ++i2) { const LAS f32x4* sp = (const LAS f32x4*)(stg + (16 * i2 + (lane >> 2)) * 36 + 8 * (lane & 3)); const f32x4 a0 = sp[0], a1 = sp[1]; const u32x4 g = gw[i2];
        u32x4 w; w.x = pk2(a0[0] * silu_f(lo16(g.x)), a0[1] * silu_f(hi16(g.x))); w.y = pk2(a0[2] * silu_f(lo16(g.y)), a0[3] * silu_f(hi16(g.y)));
        w.z = pk2(a1[0] * silu_f(lo16(g.z)), a1[1] * silu_f(hi16(g.z))); w.w = pk2(a1[2] * silu_f(lo16(g.w)), a1[3] * silu_f(hi16(g.w)));
        *(u32x4*)(Z + toks[i2] * 4096 + 2048 + h * 64 + d0 * 32 + 8 * (lane & 3)) = w; }
      asm volatile("s_waitcnt lgkmcnt(0)" ::: "memory");
    } }
}
}

template <int FAKE> __device__ __forceinline__ void phase_na(KArgs a0, const Fr& F0, int i, bool need_ctx) {
    const Fr F = launder(F0); const KArgs a = klaunder(a0);
    bf16_t* Z = (bf16_t*)(WSP(a) + WS_Z); const bf16_t* VT = (const bf16_t*)(WSP(a) + WS_VT);
    const float* rpb = INP(a, 25) + (size_t)i * 16 * 465;
    LAS float* tab = (LAS float*)(F.lds + na::TAB_OFF);
    const int vcu = (gridDim.x % 8 == 0) ? ((int)blockIdx.x % 8) * ((int)gridDim.x / 8) + (int)blockIdx.x / 8 : (int)blockIdx.x;
    const int nitems = 8 * 16 * 16 + (need_ctx ? 8 * 16 : 0);
    for (int it = vcu; it < nitems; it += gridDim.x) {
        const bool lat = it < 2048;
        int b, h, q4 = 0;
        if (lat) { q4 = it & 15; h = (it >> 4) & 15; b = it >> 8; } else { const int j = it - 2048; h = j & 15; b = j >> 4; }
        __syncthreads();
        for (int t = F.tid; t < 465; t += NTHR) tab[t] = rpb[h * 465 + t] * na::L2E;
        __syncthreads();
        na::item<FAKE>(Z, VT, F.lds, b, h, lat, q4);
    }
    __syncthreads();
}

__device__ __forceinline__ void run_gemm(const Fr& F, const pg8::GD& g, void* xl = nullptr, void* xc = nullptr, int site = 31, int rot = 0) {
    pg8::Sched S; S.init(g, (int)gridDim.x, (int)((blockIdx.x + rot) % gridDim.x));
    pg8::EpiBf16 E{g.O, g.ldc, g.split_cols, g.vtb, g.ek, g.p1, g.p2, g.p3, g.p4, g.p5, g.i1, xl, xc};
    if ((PROBE_NOEPI >> site) & 1) { pg8::EpiBf16 E0 = E; E0.ek = 99; pg8::gemm_phase<pg8::EpiBf16>(F.lds, g, S, E0); }
    for (int rep = 0; rep < (((PROBE_SITES >> site) & 1) ? 2 : 1); ++rep) pg8::gemm_phase<pg8::EpiBf16>(F.lds, g, S, E);
}

__global__ void __launch_bounds__(NTHR, 2) mega_fwd(Args a_unused) {
    const KArgs a_k = (KArgs)__builtin_amdgcn_kernarg_segment_ptr(); const KArgs a = a_k;
    extern __shared__ __attribute__((aligned(16))) unsigned char lds_raw[];
    cg::grid_group grid = cg::this_grid();
    Fr F; F.lds = (LAS unsigned char*)lds_raw; F.tid = threadIdx.x; F.lane = F.tid & 63; F.wave = __builtin_amdgcn_readfirstlane(F.tid >> 6);
    F.gw = blockIdx.x * NWAVES + F.wave; F.NGW = gridDim.x * NWAVES; F.gt = blockIdx.x * NTHR + F.tid; F.NGT = gridDim.x * NTHR;
    unsigned char* ws = WSP(klaunder(a));
    volatile LAS unsigned* bst = (volatile LAS unsigned*)(F.lds + LDS_BYTES - 64);
    if (F.tid < 16) bst[F.tid] = 0u;
    __syncthreads();
    const unsigned xcc_x = xcd_barrier_post((unsigned*)(ws + WS_CTL) + 4096, bst).x;
#define GSYNC() do { XcdBarrier xb_; xb_.bar = (unsigned*)(WSP(klaunder(a_k)) + WS_CTL) + 4096; { unsigned x_ = xcc_x; asm volatile("" : "+s"(x_)); xb_.x = x_; } xb_.st = (volatile LAS unsigned*)(F.lds + LDS_BYTES - 64); xcd_barrier(xb_); } while (0)
    for (int rep = 0; rep < PROBE_PRO; ++rep) { phase_mod(a, F); phase_s5_setup(a, F, 0); }
    { u32x4* ux = (u32x4*)(ws + WS_UX);
      for (int t = F.gt; t < 32 * (NCHP - NCHR) * 96; t += F.NGT) { const int g = t / ((NCHP - NCHR) * 96), rem = t % ((NCHP - NCHR) * 96); ux[((size_t)(g * NCHP + NCHR)) * 96 + rem] = (u32x4){0u, 0u, 0u, 0u}; } }
    grid.sync();
    for (int rep = 0; rep < PROBE_PRO; ++rep) { phase_weights(a, F, 0); __syncthreads();
    for (int rep2 = 0; rep2 < PROBE_S5; ++rep2) phase_s5_kt(a, F, 0);
    phase_shw(a, F);
    phase_rn0(a, F); }
    GSYNC();
    for (int l = 0; l < 4; ++l) {
        const int i = l >> 1;
        const KArgs a = klaunder(a_k); unsigned char* ws = WSP(a);
        const float* MODp = (const float*)(ws + WS_MOD); const float* SSQp = (const float*)(ws + WS_SSQ);
        const float* SHWl = (const float*)(ws + WS_SHW) + (size_t)l * 9 * 4096;
        const float* gnext = (l < 3) ? INP(a, 6) + (l + 1) * 1024 : nullptr;
        if (l < 3) for (int rep = 0; rep < PROBE_WGT; ++rep) { phase_weights(a, F, l + 1); if (((l + 1) & 1) == 0) phase_s5_setup(a, F, (l + 1) >> 1); __syncthreads(); }
        if ((l & 1) == 0) {
            if (l == 0) for (int rep = 0; rep < PROBE_S5; ++rep) phase_s5_tables(a, F, i);
            { pg8::GD g{(const bf16_t*)HBP(a), (const bf16_t*)(ws + WS_WEVIN), nullptr, 1024, 1024, EVEN_INP, MROWS / 256, EVEN_INP / 256, 0, 0, 0, 1, SSQp, SHWl, 0, (const void*)ws}; run_gemm(F, g, nullptr, nullptr, 0); }
            GSYNC();
            phase_krope(a, F);
            for (int j = 0; j < 3; ++j) {
                pg8::GD g;
                if (j == 0) g = pg8::GD{(const bf16_t*)(ws + WS_CQ), (const bf16_t*)(ws + WS_WUQ), (bf16_t*)(ws + WS_Q0), 256, 256, 768, MROWS / 256, 3, 0, 0, 0, 3, (const void*)(ws + WS_SSQQ), (const void*)ws, 0, (const void*)ws, (const void*)ws, (const void*)ws, 256};
                else if (j == 1) g = pg8::GD{(const bf16_t*)(ws + WS_CKV), (const bf16_t*)(ws + WS_WUKV), (bf16_t*)(ws + WS_KV0), 128, 128, 1024, MROWS / 256, 4, 0, 0, 0, 4, (const void*)(ws + WS_SSQKV), (const void*)ws, 0, (const void*)ws, (const void*)ws, (const void*)ws, 128};
                else g = pg8::GD{(const bf16_t*)(ws + WS_UX), (const bf16_t*)(ws + WS_BTA), (bf16_t*)(ws + WS_S), 768, 512, 256, 160, 1, 1, 256, 0, 0, (const void*)ws, (const void*)ws, 0, (const void*)ws, (const void*)ws, (const void*)ws, 0};
                run_gemm(F, g, nullptr, nullptr, 1 + j, (j == 0) ? 0 : (j == 1 ? 152 : 96));
            }
            GSYNC();
            phase_e2b(a, F);
            GSYNC();
            { pg8::GD g{(const bf16_t*)(ws + WS_UX), (const bf16_t*)(ws + WS_BTC), (bf16_t*)(ws + WS_G2), 768, 768, 512, 160, 2, 2, 512, 0, 6, nullptr, nullptr}; run_gemm(F, g, nullptr, nullptr, 4); }
#if PROBE_MLAFAKE
            phase_mla<PROBE_MLAFAKE>(a, F);
#endif
            for (int rep = 0; rep < PROBE_MLA; ++rep) phase_mla<0>(a, F);
            GSYNC();
            { pg8::GD g{(const bf16_t*)(ws + WS_G2), (const bf16_t*)(ws + WS_WGLU), (bf16_t*)HBP(a) + 512, 512, 512, 1024, MROWS / 256, 4, 0, 0, 0, 7, (const void*)(INP(a, 22) + i * 1024), (const void*)((const bf16_t*)(ws + WS_GATE) + 512), 0, nullptr, nullptr, nullptr, 1024}; run_gemm(F, g, nullptr, nullptr, 5); }
            GSYNC();
            { pg8::GD g{(const bf16_t*)HBP(a), (const bf16_t*)(ws + WS_WEVOUT), (bf16_t*)(ws + WS_Z) + 2048, 1024, 1024, 4096, MROWS / 256, 4, 0, 0, 0, 8, (const void*)ws, (const void*)ws, 0, MODp, gnext, (void*)(ws + WS_SSQ), l}; run_gemm(F, g, (void*)(ws + WS_XB), nullptr); }
            GSYNC();
        } else {
            for (int j = 0; j < 3; ++j) {
                pg8::GD g;
                if (j == 0) g = pg8::GD{(const bf16_t*)(ws + WS_Z) + 2048, (const bf16_t*)(ws + WS_WNAIN), (bf16_t*)(ws + WS_Z), 4096, 1024, 4096, MROWS / 256, 8, 0, 0, 0, 9, SSQp, SHWl, 0, (const void*)ws, (const void*)ws, (const void*)ws, 1024};
                else if (j == 1) g = pg8::GD{(const bf16_t*)(ws + WS_Z) + 2048, (const bf16_t*)(ws + WS_WNAIN) + (size_t)3072 * 1024, (bf16_t*)(ws + WS_Z) + 3072, 4096, 1024, 4096, MROWS / 256, 4, 0, 0, 0, 9, SSQp, SHWl + 3072, 0, (const void*)ws, (const void*)ws, (const void*)ws, 0};
                else g = pg8::GD{(const bf16_t*)(ws + WS_WNAIN) + (size_t)2048 * 1024, (const bf16_t*)(ws + WS_Z) + 2048, (bf16_t*)(ws + WS_VT), 1024, 1024, 1024, 4, MROWS / 256, 0, 0, 1, 10, SSQp, SHWl + 2048, 4096, (const void*)ws, (const void*)ws, (const void*)ws, 0};
                run_gemm(F, g, nullptr, nullptr, 7 + j, (j == 0) ? 0 : (j == 1 ? 64 : 96));
            }
            GSYNC();
            if (l == 1) for (int rep = 0; rep < PROBE_S5; ++rep) phase_s5_kt(a, F, 1);
#if PROBE_NAFAKE
            phase_na<PROBE_NAFAKE>(a, F, i, l < 3);
#endif
            for (int rep = 0; rep < PROBE_NA; ++rep) phase_na<0>(a, F, i, l < 3);
            GSYNC();
            if (l == 1) for (int rep = 0; rep < PROBE_S5; ++rep) phase_s5_tables(a, F, 1);
            { pg8::GD g{(const bf16_t*)(ws + WS_Z) + 2048, (const bf16_t*)(ws + WS_WNAOUT), (bf16_t*)HBP(a), 4096, 1024, 1024, (l < 3) ? MROWS / 256 : MLAT / 256, 4, 0, 0, 0, 8, (const void*)ws, (const void*)ws, 0, MODp, gnext, (void*)(ws + WS_SSQ), l}; run_gemm(F, g, (void*)(ws + WS_XB), nullptr); }
            GSYNC();
        }
    }
    phase_final(a, F);
}

extern "C" void kernel_launch(void* const* d_in, const int* in_sizes, int n_in, void* d_out, int out_size, void* d_ws, size_t ws_size, hipStream_t stream) {
    static int grid = 0;
    if (grid == 0) {
        if (n_in != 27 || ws_size < WS_END) { fprintf(stderr, "kernel_launch: unexpected n_in %d / ws_size %zu\n", n_in, ws_size); grid = -1; return; }
        int dev = 0, cus = 0, per_cu = 0;
        hipGetDevice(&dev);
        hipDeviceGetAttribute(&cus, hipDeviceAttributeMultiprocessorCount, dev);
        hipFuncSetAttribute((const void*)mega_fwd, hipFuncAttributeMaxDynamicSharedMemorySize, LDS_BYTES);
        hipOccupancyMaxActiveBlocksPerMultiprocessor(&per_cu, (const void*)mega_fwd, NTHR, LDS_BYTES);
        if (per_cu < 1) { fprintf(stderr, "kernel_launch: occupancy query says %d blocks per CU\n", per_cu); per_cu = 1; }
        grid = cus * 1;
        (void)hipGetLastError();
    }
    if (grid < 0) return;
    (void)hipMemsetAsync((char*)d_ws + WS_CTL, 0, 64 * 1024, stream);
    Args a{};
    for (int i = 0; i < 27; ++i) a.in[i] = (const float*)d_in[i];
    a.out = (float*)d_out; a.ws = (unsigned char*)d_ws;
    void* params[] = {&a};
    hipError_t e = hipLaunchCooperativeKernel((const void*)mega_fwd, dim3(grid), dim3(NTHR), params, LDS_BYTES, stream);
    if (e != hipSuccess) fprintf(stderr, "cooperative launch failed: %s (grid %d)\n", hipGetErrorString(e), grid);
}
```
